# Optimizing an MI355X kernel written in HIP

```python
import math
import jax, jax.numpy as jnp
from jax import lax
import numpy as np

D_MODEL = 4096
BATCH = 2
SEQ = 8192
DEPTH = 2

N_BRANCH = 4
BRANCH_W = D_MODEL // 4
DA_HEADS = 8
DA_QK = BRANCH_W // (2 * DA_HEADS)
DA_V = 2 * DA_QK
RET_HEADS = 8
RET_V = BRANCH_W // RET_HEADS
RET_QK = RET_V // 2
RET_CHUNK = 128
RET_DECAY_BASE = 5.0
HG_HEADS = 8
HG_K = BRANCH_W // HG_HEADS
HG_V = 128
HG_CHUNK = 64
DIL_HEADS = 8
DIL_HD = BRANCH_W // DIL_HEADS
DIL_WINDOWS = (128, 512, 2048)
DIL_RATES = (1, 4, 16)
DIL_GROUPS = 3
Q_BLOCK = 128
D_FF = 11008
CONV_W = 3
EPS = 1e-5
ALPHA = (2 * DEPTH) ** 0.25
BETA = (8 * DEPTH) ** -0.25
IN_SPLIT = (
    DA_HEADS * 2 * DA_QK, DA_HEADS * 2 * DA_QK, DA_HEADS * DA_V,
    RET_HEADS * RET_QK, RET_HEADS * RET_QK, RET_HEADS * RET_V, RET_HEADS * RET_V,
    HG_HEADS * HG_K, HG_HEADS * HG_K, HG_HEADS * HG_V, HG_HEADS * HG_V,
    DIL_GROUPS * DIL_HEADS * DIL_HD, DIL_GROUPS * DIL_HEADS * DIL_HD, DIL_GROUPS * DIL_HEADS * DIL_HD,
    N_BRANCH * D_MODEL,
)
N_IN = sum(IN_SPLIT)

kernel_name = 'hybrid_gated_four_mixer_deepnorm'


def _layernorm(x, g, b):
    xf = x.astype(jnp.float32)
    mu = jnp.mean(xf, -1, keepdims=True)
    var = jnp.mean(jnp.square(xf - mu), -1, keepdims=True)
    return ((xf - mu) * lax.rsqrt(var + EPS) * g + b).astype(x.dtype)


def _rmsnorm(x, g):
    xf = x.astype(jnp.float32)
    return xf * lax.rsqrt(jnp.mean(xf * xf, -1, keepdims=True) + EPS) * g.astype(jnp.float32)


def _groupnorm(t):
    mu = jnp.mean(t, -1, keepdims=True)
    var = jnp.mean(jnp.square(t - mu), -1, keepdims=True)
    return (t - mu) * lax.rsqrt(var + EPS)


def _heads(t, h):
    b, s, _ = t.shape
    return t.reshape(b, s, h, -1).transpose(0, 2, 1, 3)


def _merge_heads(t):
    b, h, s, d = t.shape
    return t.transpose(0, 2, 1, 3).reshape(b, s, h * d)


def _to_chunks(t, c):
    b, h, s, d = t.shape
    return t.reshape(b, h, s // c, c, d).transpose(2, 0, 1, 3, 4)


def _from_chunks(t):
    n, b, h, c, d = t.shape
    return t.transpose(1, 2, 0, 3, 4).reshape(b, h, n * c, d)


def _alibi_slopes():
    n = DA_HEADS + DIL_GROUPS * DIL_HEADS
    slopes = 2.0 ** (-8.0 * jnp.arange(1, n + 1, dtype=jnp.float32) / n)
    return slopes.reshape(DIL_HEADS, 1 + DIL_GROUPS)


def _diff_attention(q, k, v, lam, slopes):
    b, h, s, _ = q.shape
    q1, q2 = jnp.split(q * (DA_QK ** -0.5), 2, axis=-1)
    k1, k2 = jnp.split(k, 2, axis=-1)
    kpos = jnp.arange(s)

    def block(args):
        a1, a2, n = args
        qpos = n * Q_BLOCK + jnp.arange(Q_BLOCK)
        dist = (qpos[:, None] - kpos[None, :]).astype(jnp.float32)
        bias = jnp.where(dist >= 0, -slopes[:, None, None] * dist, -jnp.inf)
        s1 = jnp.einsum('bhqd,bhkd->bhqk', a1, k1).astype(jnp.float32) + bias
        s2 = jnp.einsum('bhqd,bhkd->bhqk', a2, k2).astype(jnp.float32) + bias
        p = jax.nn.softmax(s1, axis=-1) - lam * jax.nn.softmax(s2, axis=-1)
        return jnp.einsum('bhqk,bhkd->bhqd', p.astype(v.dtype), v)

    out = lax.map(block, (_to_chunks(q1, Q_BLOCK), _to_chunks(q2, Q_BLOCK), jnp.arange(s // Q_BLOCK)))
    return _from_chunks(out)


def _retention(q, k, v):
    b, h, s, _ = q.shape
    c = RET_CHUNK
    log_g = jnp.log1p(-(2.0 ** (-RET_DECAY_BASE - jnp.arange(h, dtype=jnp.float32))))
    idx = jnp.arange(c, dtype=jnp.float32)
    rel = idx[:, None] - idx[None, :]
    inner_decay = jnp.where(rel >= 0, jnp.exp(log_g[:, None, None] * jnp.maximum(rel, 0.0)), 0.0)
    q_decay = jnp.exp(log_g[:, None] * (idx + 1.0))[:, :, None]
    k_decay = jnp.exp(log_g[:, None] * (c - 1.0 - idx))[:, :, None]
    chunk_decay = jnp.exp(log_g * c)[:, None, None]
    q = q * (RET_QK ** -0.5)

    def step(state, inp):
        qc, kc, vc = inp
        att = jnp.einsum('bhid,bhjd->bhij', qc, kc) * inner_decay
        o = jnp.einsum('bhij,bhje->bhie', att, vc) + jnp.einsum('bhid,bhde->bhie', qc, state) * q_decay
        state = chunk_decay * state + jnp.einsum('bhjd,bhje->bhde', kc * k_decay, vc)
        return state, o

    state0 = jnp.zeros((b, h, q.shape[-1], v.shape[-1]), jnp.float32)
    _, o = lax.scan(step, state0, (_to_chunks(q, c), _to_chunks(k, c), _to_chunks(v, c)))
    return _from_chunks(o)


def _hgrn2(q, k, v, log_f):
    b, h, s, dk = q.shape
    c = HG_CHUNK
    mask = jnp.tril(jnp.ones((c, c), bool))[:, :, None]

    def step(state, inp):
        qc, kc, vc, lf = inp
        bcum = jnp.cumsum(lf, axis=2)
        diff = bcum[:, :, :, None, :] - bcum[:, :, None, :, :]
        decay = jnp.exp(jnp.where(mask, diff, -jnp.inf))
        att = jnp.einsum('bhijc,bhjc->bhij', qc[:, :, :, None, :] * decay, kc)
        o = jnp.einsum('bhij,bhje->bhie', att, vc) + jnp.einsum('bhic,bhce->bhie', qc * jnp.exp(bcum), state)
        blast = bcum[:, :, -1:, :]
        state = jnp.exp(blast[:, :, 0, :])[..., None] * state + jnp.einsum('bhjc,bhje->bhce', kc * jnp.exp(blast - bcum), vc)
        return state, o

    state0 = jnp.zeros((b, h, dk, v.shape[-1]), jnp.float32)
    _, o = lax.scan(step, state0, (_to_chunks(q, c), _to_chunks(k, c), _to_chunks(v, c), _to_chunks(log_f, c)))
    return _from_chunks(o)


def _dilated_group(q, k, v, slopes, window, rate):
    b, h, s, dh = q.shape
    n_keys = window // rate + 1
    steps = jnp.arange(n_keys)
    bias = -slopes[:, None] * (steps * rate).astype(jnp.float32)

    def block(args):
        qc, n = args
        qpos = n * Q_BLOCK + jnp.arange(Q_BLOCK)
        kpos = qpos[:, None] - rate * steps[None, :]
        kidx = jnp.maximum(kpos, 0).reshape(-1)
        kg = jnp.take(k, kidx, axis=2).reshape(b, h, Q_BLOCK, n_keys, dh)
        vg = jnp.take(v, kidx, axis=2).reshape(b, h, Q_BLOCK, n_keys, dh)
        sc = jnp.einsum('bhqd,bhqjd->bhqj', qc, kg).astype(jnp.float32) + bias[:, None, :]
        sc = jnp.where(kpos >= 0, sc, -jnp.inf)
        lse = jax.nn.logsumexp(sc, axis=-1)
        p = jnp.exp(sc - lse[..., None])
        o = jnp.einsum('bhqj,bhqjd->bhqd', p.astype(vg.dtype), vg)
        return o, lse

    o, lse = lax.map(block, (_to_chunks(q * (dh ** -0.5), Q_BLOCK), jnp.arange(s // Q_BLOCK)))
    return _from_chunks(o), lse.transpose(1, 2, 0, 3).reshape(b, h, s)


def _hybrid_mixer(x, w_in, lam_vec, da_g, lb, hg_g, w_branch, w_o, layer):
    f32 = jnp.float32
    b, s, _ = x.shape
    (da_q, da_k, da_v, rt_q, rt_k, rt_v, rt_g, hg_q, hg_f, hg_i, hg_gt,
     dl_q, dl_k, dl_v, gates) = jnp.split(x @ w_in, np.cumsum(IN_SPLIT)[:-1].tolist(), axis=-1)
    slopes = _alibi_slopes()

    lam_init = 0.8 - 0.6 * math.exp(-0.3 * layer)
    lv = lam_vec.astype(f32)
    lam = jnp.exp(jnp.sum(lv[0] * lv[1])) - jnp.exp(jnp.sum(lv[2] * lv[3])) + lam_init
    ya = _diff_attention(_heads(da_q, DA_HEADS), _heads(da_k, DA_HEADS), _heads(da_v, DA_HEADS), lam, slopes[:, 0])
    ya = _merge_heads(_rmsnorm(ya, da_g) * (1.0 - lam_init)).astype(x.dtype)

    yr = _retention(_heads(rt_q, RET_HEADS).astype(f32), _heads(rt_k, RET_HEADS).astype(f32), _heads(rt_v, RET_HEADS).astype(f32))
    yr = (_merge_heads(_groupnorm(yr)) * jax.nn.silu(rt_g.astype(f32))).astype(x.dtype)

    fr = _heads(hg_f, HG_HEADS).astype(f32)
    lbh = lb.reshape(HG_HEADS, 1, HG_K)
    log_f = jnp.log(lbh + (1.0 - lbh) * jax.nn.sigmoid(fr))
    k_in = (1.0 - lbh) * jax.nn.sigmoid(-fr)
    yc = _hgrn2(jax.nn.silu(_heads(hg_q, HG_HEADS).astype(f32)), k_in, _heads(hg_i, HG_HEADS).astype(f32), log_f)
    yc = (_merge_heads(_rmsnorm(yc, hg_g)) * jax.nn.silu(hg_gt.astype(f32))).astype(x.dtype)

    def grp(t):
        return t.reshape(b, s, DIL_GROUPS, DIL_HEADS, DIL_HD).transpose(2, 0, 3, 1, 4)
    qd, kd, vd = grp(dl_q), grp(dl_k), grp(dl_v)
    outs, lses = [], []
    for g in range(DIL_GROUPS):
        o, l = _dilated_group(qd[g], kd[g], vd[g], slopes[:, 1 + g], DIL_WINDOWS[g], DIL_RATES[g])
        outs.append(o)
        lses.append(l)
    wts = jax.nn.softmax(jnp.stack(lses), axis=0)
    yd = jnp.sum(wts[..., None] * jnp.stack(outs).astype(f32), axis=0)
    yd = _merge_heads(yd).astype(x.dtype)

    gt = jax.nn.sigmoid(gates.reshape(b, s, N_BRANCH, D_MODEL).astype(f32))
    branches = (ya, yr, yc, yd)
    merged = gt[:, :, 0] * (branches[0] @ w_branch[0]).astype(f32)
    for n in range(1, N_BRANCH):
        merged = merged + gt[:, :, n] * (branches[n] @ w_branch[n]).astype(f32)
    return merged.astype(x.dtype) @ w_o


def _conv_ffn(x, w_up, conv_w, conv_b, w_down):
    a, gl = jnp.split(x @ w_up, 2, axis=-1)
    s = a.shape[1]
    ap = jnp.pad(a, ((0, 0), (CONV_W - 1, 0), (0, 0)))
    conv = conv_b + conv_w[0] * ap[:, 0:s]
    for j in range(1, CONV_W):
        conv = conv + conv_w[j] * ap[:, j:j + s]
    return (jax.nn.gelu(conv, approximate=False) * gl) @ w_down


def setup_inputs(seed: int = 0) -> dict:
    key = jax.random.key(seed)
    ks = jax.random.split(key, 16)
    f32 = jnp.float32

    def nrm(k, shape, scale):
        return jax.random.normal(k, shape, f32) * scale

    return {
        'x': nrm(ks[0], (BATCH, SEQ, D_MODEL), 1.0),
        'w_in': nrm(ks[1], (DEPTH, D_MODEL, N_IN), D_MODEL ** -0.5),
        'diff_lambda': nrm(ks[2], (DEPTH, 4, DA_QK), 0.1),
        'diff_norm_g': 1.0 + nrm(ks[3], (DEPTH, DA_V), 0.02),
        'hgrn_lb_logits': nrm(ks[4], (DEPTH, HG_HEADS * HG_K), 0.5),
        'hgrn_norm_g': 1.0 + nrm(ks[5], (DEPTH, HG_V), 0.02),
        'w_branch': nrm(ks[6], (DEPTH, N_BRANCH, BRANCH_W, D_MODEL), BRANCH_W ** -0.5),
        'w_o': nrm(ks[7], (DEPTH, D_MODEL, D_MODEL), BETA * D_MODEL ** -0.5),
        'ln1_g': 1.0 + nrm(ks[8], (DEPTH, D_MODEL), 0.02),
        'ln1_b': nrm(ks[9], (DEPTH, D_MODEL), 0.02),
        'w_up': nrm(ks[10], (DEPTH, D_MODEL, 2 * D_FF), D_MODEL ** -0.5),
        'conv_w': nrm(ks[11], (DEPTH, CONV_W, D_FF), CONV_W ** -0.5),
        'conv_b': nrm(ks[12], (DEPTH, D_FF), 0.02),
        'w_down': nrm(ks[13], (DEPTH, D_FF, D_MODEL), BETA * D_FF ** -0.5),
        'ln2_g': 1.0 + nrm(ks[14], (DEPTH, D_MODEL), 0.02),
        'ln2_b': nrm(ks[15], (DEPTH, D_MODEL), 0.02),
    }


def reference(x, w_in, diff_lambda, diff_norm_g, hgrn_lb_logits, hgrn_norm_g, w_branch, w_o,
              ln1_g, ln1_b, w_up, conv_w, conv_b, w_down, ln2_g, ln2_b):
    p = jax.nn.softmax(hgrn_lb_logits.astype(jnp.float32), axis=0)
    lower_bounds = jnp.cumsum(p, axis=0) - p[0]
    h = x
    for l in range(DEPTH):
        mix = _hybrid_mixer(h, w_in[l], diff_lambda[l], diff_norm_g[l], lower_bounds[l],
                            hgrn_norm_g[l], w_branch[l], w_o[l], l)
        h = _layernorm(ALPHA * h + mix, ln1_g[l], ln1_b[l])
        h = _layernorm(ALPHA * h + _conv_ffn(h, w_up[l], conv_w[l], conv_b[l], w_down[l]), ln2_g[l], ln2_b[l])
    return h
```

```cpp
#include <hip/hip_runtime.h>
#include <cstdio>
#include <cstdint>

#ifndef MK_PER_PHASE
#define MK_PER_PHASE 0
#endif
#ifndef PH_MASK
#define PH_MASK 0x1fff
#endif
#define PHEN(k) (((PH_MASK) >> (k)) & 1)
#ifndef REP_MASK
#define REP_MASK 0
#endif
#define NREP(k) ((((REP_MASK) >> (k)) & 1) ? 2 : 1)
#ifndef MIX_REP
#define MIX_REP 0
#endif
#define NMIX(k) ((((MIX_REP) >> (k)) & 1) ? 2 : 1)
#ifndef DUP_BAR
#define DUP_BAR 0
#endif
#ifndef DUP_EPI
#define DUP_EPI 0
#endif

namespace pg8 {
#define PG8_LAS __attribute__((address_space(3)))
typedef unsigned short bf16_t;
typedef short bf16x8 __attribute__((ext_vector_type(8)));
typedef float f32x4 __attribute__((ext_vector_type(4)));
typedef unsigned u32x4 __attribute__((ext_vector_type(4)));
typedef unsigned u32x2 __attribute__((ext_vector_type(2)));
typedef float f32x2 __attribute__((ext_vector_type(2)));
constexpr int BM = 256, BK = 64, HALF = 128, HTB = HALF * BK * 2, STAGE_BYTES = 8 * HTB, NXCD = 8, WGM = 4;

__host__ __device__ __forceinline__ int lds_byte(int r, int c) { const int st = (r >> 4) * 2 + (c >> 5), rr = r & 15, cc = c & 31, ob = rr * 64 + cc * 2; return st * 1024 + (ob ^ (((ob >> 9) & 1) << 5)); }
__host__ __device__ __forceinline__ void stage_rc(int b, int& R, int& C) { const int st = b / 1024, sb = b % 1024, swz = sb ^ (((sb >> 9) & 1) << 5); R = (st >> 1) * 16 + swz / 64; C = (st & 1) * 32 + (swz % 64) / 2; }
__host__ __device__ __forceinline__ int perm32(int rho) { const int n = rho >> 4, i = rho & 15; return 8 * (i >> 2) + 4 * n + (i & 3); }

struct Unit { int pm, pn, kind; };

__device__ __forceinline__ void tile_map(int wgid, int nM, int nN, int& pm, int& pn) {
    const int nwg = nM * nN;
    { const int q = nwg / NXCD, r = nwg % NXCD, xcd = wgid % NXCD, off = wgid / NXCD; wgid = (xcd < r ? xcd * (q + 1) : r * (q + 1) + (xcd - r) * q) + off; }
    const int nig = WGM * nN, gid = wgid / nig, fm = gid * WGM, gsz = (nM - fm) < WGM ? (nM - fm) : WGM;
    pm = fm + ((wgid % nig) % gsz); pn = (wgid % nig) / gsz;
}

__device__ __forceinline__ unsigned cvt_pk_bf16(float lo, float hi) { unsigned r; asm volatile("v_cvt_pk_bf16_f32 %0, %1, %2" : "=v"(r) : "v"(lo), "v"(hi)); return r; }

template <class Epi, class Sched, bool ALIGN_EPI, bool SP2, int BSTRIDE = 1>
__device__ __forceinline__ void gemm_phase(PG8_LAS unsigned char* lds, const int K, const Sched& S, const Epi& E, const int tid) {
    constexpr int bstride = BSTRIDE;
    const int wid = __builtin_amdgcn_readfirstlane(tid >> 6), lane = tid & 63, wr = wid >> 2, wc = wid & 3, fr = lane & 15, fq = lane >> 4;
    const int nt = K / BK;
    unsigned voffA[2], voffB[2];
#pragma unroll
    for (int i = 0; i < 2; ++i) { int R, C; stage_rc(tid * 16 + i * 8192, R, C); const int Rb = Epi::PERM ? ((R & ~31) + perm32(R & 31)) : R;
        const int Ra = Epi::APERM ? (128 * (R >> 6) + 8 * (R & 15) + ((R >> 4) & 3)) : R;
        voffA[i] = (unsigned)(Ra * K + C) * 2u; voffB[i] = (unsigned)(Rb * bstride * K + C) * 2u; }
    const size_t kstep = (size_t)(BK * 2);
    const size_t hstepB = (size_t)HALF * K * 2 * bstride, hstepA = Epi::APERM ? (size_t)4 * K * 2 : (size_t)HALF * K * 2;
    const unsigned ldsw = (unsigned)wid * 1024u;
    const int aoff = lds_byte(wr * 64 + fr, fq * 8), boff = lds_byte(wc * 32 + fr, fq * 8);
#define PG8_SA(b, h) (((b) * 2 + (h)) * HTB)
#define PG8_SB(b, h) ((4 + (b) * 2 + (h)) * HTB)
#define PG8_STAGE(bufoff, gbase, voff) do { _Pragma("unroll") for (int _i = 0; _i < 2; ++_i) \
        __builtin_amdgcn_global_load_lds((const unsigned*)((const char*)(gbase) + (voff)[_i]), (PG8_LAS unsigned*)(lds + (bufoff) + ldsw + _i * 8192), 16, 0, 0); } while (0)
#define PG8_LDA(dst, b, h) do { _Pragma("unroll") for (int m = 0; m < 4; ++m) _Pragma("unroll") for (int k = 0; k < 2; ++k) dst[m][k] = *(const PG8_LAS bf16x8*)(lds + PG8_SA(b, h) + aoff + m * 2048 + k * 1024); } while (0)
#define PG8_LDB(dst, b, h) do { _Pragma("unroll") for (int n = 0; n < 2; ++n) _Pragma("unroll") for (int k = 0; k < 2; ++k) dst[n][k] = *(const PG8_LAS bf16x8*)(lds + PG8_SB(b, h) + boff + n * 2048 + k * 1024); } while (0)
#define PG8_MMA(ai, bj, At, Bt) do { __builtin_amdgcn_s_setprio(1); _Pragma("unroll") for (int m = 0; m < 4; ++m) _Pragma("unroll") for (int n = 0; n < 2; ++n) _Pragma("unroll") for (int k = 0; k < 2; ++k) \
        acc[ai][bj][m][n] = __builtin_amdgcn_mfma_f32_16x16x32_bf16(Bt[n][k], At[m][k], acc[ai][bj][m][n], 0, 0, 0); __builtin_amdgcn_s_setprio(0); } while (0)
#define PG8_WAIT_V(n) asm volatile("s_waitcnt vmcnt(" #n ")" ::: "memory")
#define PG8_WAIT_L(n) asm volatile("s_waitcnt lgkmcnt(" #n ")" ::: "memory")
#define PG8_BAR __builtin_amdgcn_s_barrier()
#define PG8_SCHED __builtin_amdgcn_sched_barrier(0)
    Unit cur, nxt; int ui = 0;
    if (!S.next(0, cur)) return;
    f32x4 acc[2][2][4][2];
#pragma unroll
    for (int a = 0; a < 2; ++a)
#pragma unroll
        for (int b = 0; b < 2; ++b)
#pragma unroll
            for (int m = 0; m < 4; ++m)
#pragma unroll
                for (int n = 0; n < 2; ++n) acc[a][b][m][n] = (f32x4){0.f, 0.f, 0.f, 0.f};
    bf16x8 At[4][2], B0[2][2], B1[2][2];
    const char* cA; const char* cB; S.ptrs(cur, cA, cB);
    if constexpr (SP2) {
        PG8_STAGE(PG8_SB(0, 0), cB, voffB); PG8_STAGE(PG8_SB(0, 1), cB + hstepB, voffB); PG8_STAGE(PG8_SA(0, 0), cA, voffA); PG8_STAGE(PG8_SA(0, 1), cA + hstepA, voffA);
        if (wr == 1) PG8_BAR;
        PG8_WAIT_V(2); PG8_BAR;
        PG8_STAGE(PG8_SB(1, 0), cB + kstep, voffB); PG8_STAGE(PG8_SA(1, 0), cA + kstep, voffA); PG8_STAGE(PG8_SB(1, 1), cB + hstepB + kstep, voffB);
        PG8_WAIT_V(6); PG8_BAR;
    } else {
        PG8_STAGE(PG8_SB(0, 0), cB, voffB); PG8_STAGE(PG8_SA(0, 0), cA, voffA); PG8_STAGE(PG8_SB(0, 1), cB + hstepB, voffB); PG8_STAGE(PG8_SA(0, 1), cA + hstepA, voffA);
        if (wr == 1) PG8_BAR;
        PG8_WAIT_V(4); PG8_BAR;
        PG8_STAGE(PG8_SB(1, 0), cB + kstep, voffB); PG8_STAGE(PG8_SA(1, 0), cA + kstep, voffA); PG8_STAGE(PG8_SB(1, 1), cB + hstepB + kstep, voffB);
        PG8_WAIT_V(6); PG8_BAR;
    }
    for (;;) {
        const bool has_next = S.next(ui + 1, nxt);
        const char* nA = cA; const char* nB = cB; if (has_next) S.ptrs(nxt, nA, nB);
        for (int t = 0; t < nt; t += 2) {
            const bool last = (t == nt - 2);
            const char* a1 = cA + (size_t)(t + 1) * kstep;
            const char* a2 = last ? nA : cA + (size_t)(t + 2) * kstep; const char* b2 = last ? nB : cB + (size_t)(t + 2) * kstep;
            const char* a3 = a2 + kstep; const char* b3 = b2 + kstep;
            if constexpr (SP2) {
            PG8_LDB(B0, 0, 0); PG8_LDB(B1, 0, 1); PG8_SCHED; PG8_LDA(At, 0, 0); PG8_STAGE(PG8_SA(1, 1), a1 + hstepA, voffA);
            PG8_WAIT_V(8); PG8_WAIT_L(0); PG8_BAR; PG8_MMA(0, 0, At, B0); PG8_MMA(0, 1, At, B1); PG8_BAR; PG8_SCHED;
            PG8_LDA(At, 0, 1); PG8_STAGE(PG8_SB(0, 0), b2, voffB); PG8_STAGE(PG8_SB(0, 1), b2 + hstepB, voffB); PG8_STAGE(PG8_SA(0, 0), a2, voffA);
            PG8_WAIT_V(8); PG8_WAIT_L(0); PG8_BAR; PG8_MMA(1, 0, At, B0); PG8_MMA(1, 1, At, B1); PG8_BAR; PG8_SCHED;
            PG8_LDB(B0, 1, 0); PG8_LDB(B1, 1, 1); PG8_SCHED; PG8_LDA(At, 1, 0); PG8_STAGE(PG8_SA(0, 1), a2 + hstepA, voffA);
            PG8_WAIT_V(8); PG8_WAIT_L(0); PG8_BAR; PG8_MMA(0, 0, At, B0); PG8_MMA(0, 1, At, B1); PG8_BAR; PG8_SCHED;
            PG8_LDA(At, 1, 1); PG8_STAGE(PG8_SB(1, 0), b3, voffB); PG8_STAGE(PG8_SB(1, 1), b3 + hstepB, voffB); PG8_STAGE(PG8_SA(1, 0), a3, voffA);
            PG8_WAIT_V(8); PG8_WAIT_L(0); PG8_BAR; PG8_MMA(1, 0, At, B0); PG8_MMA(1, 1, At, B1); PG8_BAR; PG8_SCHED;
            } else {
            PG8_LDB(B0, 0, 0); PG8_SCHED; PG8_LDA(At, 0, 0); PG8_STAGE(PG8_SA(1, 1), a1 + hstepA, voffA);
            PG8_WAIT_L(8); PG8_BAR; PG8_WAIT_L(0); PG8_MMA(0, 0, At, B0); PG8_BAR; PG8_SCHED;
            PG8_LDB(B1, 0, 1); PG8_STAGE(PG8_SB(0, 0), b2, voffB);
            PG8_BAR; PG8_WAIT_L(0); PG8_MMA(0, 1, At, B1); PG8_BAR;
            PG8_LDA(At, 0, 1); PG8_STAGE(PG8_SA(0, 0), a2, voffA);
            PG8_BAR; PG8_WAIT_L(0); PG8_MMA(1, 0, At, B0); PG8_BAR; PG8_SCHED;
            PG8_STAGE(PG8_SB(0, 1), b2 + hstepB, voffB);
            PG8_WAIT_V(6); PG8_BAR; PG8_MMA(1, 1, At, B1); PG8_BAR;
            PG8_LDB(B0, 1, 0); PG8_SCHED; PG8_LDA(At, 1, 0); PG8_STAGE(PG8_SA(0, 1), a2 + hstepA, voffA);
            PG8_WAIT_L(8); PG8_BAR; PG8_WAIT_L(0); PG8_MMA(0, 0, At, B0); PG8_BAR; PG8_SCHED;
            PG8_LDB(B1, 1, 1); PG8_STAGE(PG8_SB(1, 0), b3, voffB);
            PG8_BAR; PG8_WAIT_L(0); PG8_MMA(0, 1, At, B1); PG8_BAR;
            PG8_LDA(At, 1, 1); PG8_STAGE(PG8_SA(1, 0), a3, voffA);
            PG8_BAR; PG8_WAIT_L(0); PG8_MMA(1, 0, At, B0); PG8_BAR; PG8_SCHED;
            PG8_STAGE(PG8_SB(1, 1), b3 + hstepB, voffB);
            PG8_WAIT_V(6); PG8_BAR; PG8_MMA(1, 1, At, B1); PG8_BAR;
            }
        }
        if constexpr (ALIGN_EPI) { if (wr == 0) PG8_BAR; }
        {
            int t2 = threadIdx.x; asm volatile("" : "+v"(t2)); const int l2 = t2 & 63;
            E(acc, cur, wr, wc, l2 & 15, l2 >> 4);
            if constexpr (DUP_EPI && Epi::IDEMP) E(acc, cur, wr, wc, l2 & 15, l2 >> 4);
        }
        if (!has_next) break;
#pragma unroll
        for (int a = 0; a < 2; ++a)
#pragma unroll
            for (int b = 0; b < 2; ++b)
#pragma unroll
                for (int m = 0; m < 4; ++m)
#pragma unroll
                    for (int n = 0; n < 2; ++n) acc[a][b][m][n] = (f32x4){0.f, 0.f, 0.f, 0.f};
        cur = nxt; cA = nA; cB = nB; ++ui;
        if constexpr (ALIGN_EPI) { if (wr == 1) PG8_BAR; }
    }
    PG8_WAIT_V(0);
    if constexpr (!ALIGN_EPI) { if (wr == 0) PG8_BAR; }
    PG8_BAR;
#undef PG8_SA
#undef PG8_SB
#undef PG8_STAGE
#undef PG8_LDA
#undef PG8_LDB
#undef PG8_MMA
#undef PG8_WAIT_V
#undef PG8_WAIT_L
#undef PG8_BAR
#undef PG8_SCHED
}
}

constexpr int NWAVES = 8;
constexpr int BATCH = 2, SEQ = 8192, DM = 4096, M = BATCH * SEQ, NIN = 35840, DFF = 11008, NUP = 2 * DFF, DEPTH = 2;
constexpr float EPS = 1e-5f, LOG2E = 1.4426950408889634f;
constexpr float ALPHA = 1.4142135623730951f;
constexpr int C_DAQ = 0, C_DAK = 1024, C_DAV = 2048, C_RTQ = 3072, C_RTK = 3584, C_RTV = 4096, C_RTG = 5120, C_HGQ = 6144, C_HGF = 7168, C_HGI = 8192, C_HGG = 9216,
              C_DLQ = 10240, C_DLK = 13312, C_DLV = 16384, C_GATE = 19456;
constexpr int VT_DAV = 0, VT_RTV = 1024, VT_HGI = 2048, VT_DLV = 3072, VT_ROWS = 6144;
constexpr int NAT_TILES = 116, SWP_TILES = 16;
constexpr float QS_DA = 0.125f * LOG2E;
constexpr float QS_DL = 0.08838834764831845f * LOG2E;

constexpr size_t MiB = 1u << 20;
constexpr size_t WS_CTL = 0, CTL_ZERO_BYTES = 1 * MiB;
constexpr size_t WS_WIN = 16 * MiB, WIN_L = (size_t)NIN * DM * 2;
constexpr size_t WS_WBR = 576 * MiB, WBR_L = (size_t)4 * DM * 1024 * 2;
constexpr size_t WS_WO = 640 * MiB, WO_L = (size_t)DM * DM * 2;
constexpr size_t WS_WUP = 704 * MiB, WUP_L = (size_t)NUP * DM * 2;
constexpr size_t WS_WDN = 1048 * MiB, WDN_L = (size_t)DM * DFF * 2;
constexpr size_t WS_AB = 1220 * MiB, WS_XP4 = 1348 * MiB, WS_XP16 = 1476 * MiB;
constexpr size_t WS_NAT = 1604 * MiB;
constexpr size_t WS_UUP = WS_NAT, WS_ACT = WS_NAT + 688 * MiB;
constexpr size_t WS_VT = 2724 * MiB;
constexpr size_t WS_HQT = 2932 * MiB, WS_HKT = 2964 * MiB, WS_HQC = 2996 * MiB, WS_HKH = 3028 * MiB, WS_DEC = 3060 * MiB;
constexpr size_t WS_UR = 3062 * MiB, WS_UH = 3094 * MiB, WS_SR = 3222 * MiB, WS_SH = 3238 * MiB;
constexpr size_t WS_Y = 3302 * MiB;
constexpr size_t WS_MRG = 3430 * MiB, WS_MRGB = 3686 * MiB, WS_H1 = 3814 * MiB, WS_H2 = 4070 * MiB, WS_DAK = 4326 * MiB, WS_DLK = 4358 * MiB, WS_END = 4454 * MiB;
static_assert(WS_WIN + 2 * WIN_L <= WS_WBR && WS_WUP + 2 * WUP_L <= WS_WDN && WS_WDN + 2 * WDN_L <= WS_AB, "ws map");
static_assert(WS_NAT + (size_t)M * NIN * 2 <= WS_VT && WS_ACT + (size_t)M * DFF * 2 <= WS_VT && WS_UUP + (size_t)M * NUP * 2 <= WS_ACT, "ws map");
static_assert(WS_VT + (size_t)VT_ROWS * M * 2 <= WS_HQT, "ws map");
static_assert(WS_XP16 - WS_XP4 == WS_XP4 - WS_AB, "the permuted activation copies are equally spaced");
constexpr int CW_TMO = 0, CW_CODE = 1, CW_BAR = 4096, CW_WQ = 16384, CW_NRM = 20480;

constexpr int LDS_BYTES = 147456, LDSCTL_OFF = LDS_BYTES - 512, MISC_OFF = LDSCTL_OFF + 320;

#define GAS __attribute__((address_space(1)))
#define LAS __attribute__((address_space(3)))
typedef unsigned short bf16;
typedef unsigned v4u __attribute__((ext_vector_type(4)));
typedef unsigned v2u __attribute__((ext_vector_type(2)));
typedef float f32x4 __attribute__((ext_vector_type(4)));
typedef float f32x16 __attribute__((ext_vector_type(16)));
typedef short bf16x8 __attribute__((ext_vector_type(8)));
typedef short bf16x4 __attribute__((ext_vector_type(4)));
typedef GAS unsigned gu32;
#define RLX_AGENT __ATOMIC_RELAXED, __HIP_MEMORY_SCOPE_AGENT
#define LDS_WAIT() asm volatile("s_waitcnt lgkmcnt(0)" ::: "memory")
#define VM_WAIT() asm volatile("s_waitcnt vmcnt(0)" ::: "memory")
__device__ __forceinline__ unsigned f2bf(float f) { unsigned u = __builtin_bit_cast(unsigned, f); return (u + 0x7fffu + ((u >> 16) & 1u)) >> 16; }
__device__ __forceinline__ unsigned pk2(float lo, float hi) { return f2bf(lo) | (f2bf(hi) << 16); }
__device__ __forceinline__ float bflo(unsigned u) { return __uint_as_float(u << 16); }
__device__ __forceinline__ float bfhi(unsigned u) { return __uint_as_float(u & 0xffff0000u); }
__device__ __forceinline__ float bf1(bf16 b) { return __uint_as_float((unsigned)b << 16); }
__device__ __forceinline__ float fsigmoid(float x) { return __builtin_amdgcn_rcpf(1.f + __builtin_amdgcn_exp2f(-x * LOG2E)); }

#define XB_TMO      128
#define XB_XCNT(j)  (256  + 64 * (j))
#define XB_XSUB(j)  (1280 + 64 * (j))
#define XB_XGEN(j)  (2304 + 64 * (j))
#define XB_TOP      3328
#define XB_TOPGEN   3392
#define XCD_BAR_WORDS 3456
#define XB_SPIN_CAP (1u << 18)
__device__ __forceinline__ unsigned xb_ld(unsigned* p)              { return __hip_atomic_load(p, __ATOMIC_RELAXED, __HIP_MEMORY_SCOPE_AGENT); }
__device__ __forceinline__ unsigned xb_add(unsigned* p, unsigned v) { return __hip_atomic_fetch_add(p, v, __ATOMIC_RELAXED, __HIP_MEMORY_SCOPE_AGENT); }
__device__ __forceinline__ unsigned xb_xcc_id() { return (unsigned)__builtin_amdgcn_s_getreg((3 << 11) | 20) & 0xFu; }
#define XB_SPIN(cond, bar) do { unsigned _sp = 0; while (cond) { __builtin_amdgcn_s_sleep(1); \
    if ((++_sp & 255u) == 0u) { if (xb_ld(&(bar)[XB_TMO])) break; if (_sp > XB_SPIN_CAP) { atomicAdd(&(bar)[XB_TMO], 1u); break; } } } } while (0)
struct XcdBarrier { unsigned* bar; unsigned x; volatile LAS unsigned* st; };
__device__ __forceinline__ XcdBarrier xcd_barrier_post(unsigned* bar, volatile LAS unsigned* st) {
    XcdBarrier b; b.bar = bar; b.x = xb_xcc_id(); b.st = st;
    if (threadIdx.x == 0) (void)xb_add(&bar[XB_XCNT(b.x)], 1u);
    return b;
}
__device__ __forceinline__ void xcd_barrier_complete(unsigned* bar, unsigned x, unsigned& nloc, unsigned& nx) {
    const unsigned G = gridDim.x * gridDim.y * gridDim.z;
    unsigned sum, cnt, mine, sp = 0u;
    for (;;) {
        sum = 0u; cnt = 0u; mine = 0u;
#pragma unroll
        for (unsigned j = 0; j < 16; ++j) { const unsigned c = xb_ld(&bar[XB_XCNT(j)]); sum += c; cnt += (c > 0u) ? 1u : 0u; mine = (j == x) ? c : mine; }
        if (sum == G) break;
        __builtin_amdgcn_s_sleep(1);
        if ((++sp & 255u) == 0u) { if (xb_ld(&bar[XB_TMO])) break; if (sp > XB_SPIN_CAP) { atomicAdd(&bar[XB_TMO], 1u); break; } }
    }
    nloc = mine > 0u ? mine : 1u; nx = cnt > 0u ? cnt : 1u;
}
__device__ __forceinline__ void xcd_barrier(const XcdBarrier& b) {
    asm volatile("s_waitcnt vmcnt(0)" ::: "memory");
    __syncthreads();
    if (threadIdx.x == 0) {
        unsigned* bar = b.bar;
        __builtin_amdgcn_s_waitcnt(0);
        unsigned nloc = b.st[0], nx = b.st[1];
        if (nloc == 0u) { xcd_barrier_complete(bar, b.x, nloc, nx); b.st[0] = nloc; b.st[1] = nx; }
        const unsigned old = xb_add(&bar[XB_XSUB(b.x)], 1u);
        const unsigned gen = old / nloc;
        if (old + 1u == (gen + 1u) * nloc) {
            __builtin_amdgcn_fence(__ATOMIC_RELEASE, "agent");
            asm volatile("s_waitcnt vmcnt(0)" ::: "memory");
            const unsigned og = xb_add(&bar[XB_TOP], 1u);
            const unsigned tg = og / nx;
            if (og + 1u == (tg + 1u) * nx) xb_add(&bar[XB_TOPGEN], 1u);
            else XB_SPIN(xb_ld(&bar[XB_TOPGEN]) == tg, bar);
            __builtin_amdgcn_fence(__ATOMIC_ACQUIRE, "agent");
            xb_add(&bar[XB_XGEN(b.x)], 1u);
            asm volatile("s_waitcnt vmcnt(0)" ::: "memory");
        } else {
            XB_SPIN(xb_ld(&bar[XB_XGEN(b.x)]) == gen, bar);
            __builtin_amdgcn_fence(__ATOMIC_ACQUIRE, "agent");
            asm volatile("s_waitcnt vmcnt(0)" ::: "memory");
        }
    }
    __syncthreads();
}

struct Frame {
    LAS unsigned char* lds;
    gu32* ctl;
    unsigned char* ws;
    int tid, lane, wave, vcu, G;
};

__device__ __forceinline__ float wave_sum(float v) {
#pragma unroll
    for (int o = 1; o < 64; o <<= 1) v += __shfl_xor(v, o);
    return v;
}
__device__ __forceinline__ float half_sum(float v) { const auto rr = __builtin_amdgcn_permlane32_swap(__float_as_uint(v), __float_as_uint(v), false, false); return __uint_as_float(rr[0]) + __uint_as_float(rr[1]); }
__device__ __forceinline__ float half_max(float v) { const auto rr = __builtin_amdgcn_permlane32_swap(__float_as_uint(v), __float_as_uint(v), false, false); return fmaxf(__uint_as_float(rr[0]), __uint_as_float(rr[1])); }

__device__ __forceinline__ f32x16 mfma32(bf16x8 a, bf16x8 b, f32x16 c) { return __builtin_amdgcn_mfma_f32_32x32x16_bf16(a, b, c, 0, 0, 0); }
__device__ __forceinline__ bf16x8 ld8(const bf16* p) { return *(const bf16x8*)p; }
__device__ __forceinline__ bf16x8 ld44(const bf16* p) { const bf16x4 a = *(const bf16x4*)p, b = *(const bf16x4*)(p + 8); return __builtin_shufflevector(a, b, 0, 1, 2, 3, 4, 5, 6, 7); }
template <int S> __device__ __forceinline__ bf16x8 pack8(const f32x16& p) {
    v4u w; w.x = pg8::cvt_pk_bf16(p[8 * S + 0], p[8 * S + 1]); w.y = pg8::cvt_pk_bf16(p[8 * S + 2], p[8 * S + 3]); w.z = pg8::cvt_pk_bf16(p[8 * S + 4], p[8 * S + 5]); w.w = pg8::cvt_pk_bf16(p[8 * S + 6], p[8 * S + 7]);
    return __builtin_bit_cast(bf16x8, w);
}
__device__ __forceinline__ f32x16 zero16() { f32x16 z; _Pragma("unroll") for (int i = 0; i < 16; ++i) z[i] = 0.f; return z; }
#define ROWOFF(i) (((i) & 3) + 8 * ((i) >> 2))

template <bool UPIL = false>
__device__ __forceinline__ void p0_transpose_item(const float* W, int K, int N, bf16* WT, LAS float* scr, int item, int lane) {
    const int nblk = N / 32, kb = item / nblk, nb = item % nblk, k0 = 64 * kb, n0 = 32 * nb;
    const int cu = n0 < DFF ? n0 : n0 - DFF, d0 = UPIL ? (256 * (cu >> 7) + (n0 < DFF ? 0 : 128) + (cu & 127)) : n0;
    const int lr = lane >> 3, lc = 4 * (lane & 7);
    const GAS f32x4* src = (const GAS f32x4*)(W + (size_t)(k0 + lr) * N + n0 + lc);
    f32x4 v[8];
#pragma unroll
    for (int j = 0; j < 8; ++j) v[j] = src[(size_t)j * 2 * N];
#pragma unroll
    for (int j = 0; j < 8; ++j) { LAS float* d = scr + (8 * j + lr) * 33 + lc; d[0] = v[j].x; d[1] = v[j].y; d[2] = v[j].z; d[3] = v[j].w; }
    LDS_WAIT(); asm volatile("" ::: "memory");
    const int c = lane & 7;
#pragma unroll
    for (int j = 0; j < 4; ++j) { const int n = (lane >> 3) + 8 * j; const LAS float* s = scr + (8 * c) * 33 + n;
        v4u o; o.x = pk2(s[0 * 33], s[1 * 33]); o.y = pk2(s[2 * 33], s[3 * 33]); o.z = pk2(s[4 * 33], s[5 * 33]); o.w = pk2(s[6 * 33], s[7 * 33]);
        *(GAS v4u*)(WT + (size_t)(d0 + n) * K + k0 + 8 * c) = o; }
    LDS_WAIT(); asm volatile("" ::: "memory");
}
__device__ __forceinline__ int perm_row(int m, int sh) { const int b = m / SEQ, t = m % SEQ; return b * SEQ + (t & ((1 << sh) - 1)) * (SEQ >> sh) + (t >> sh); }

struct Args { const float* in[16]; float* out; unsigned char* ws; int ph_lo, ph_hi; };
template <int K_> __device__ __forceinline__ const float* karg() {
    const float* p; asm volatile("s_load_dwordx2 %0, %1, %2\n\ts_waitcnt lgkmcnt(0)" : "=s"(p) : "s"(__builtin_amdgcn_kernarg_segment_ptr()), "i"(K_ * 8) : "memory"); return p; }
#define INP(k) (karg<(k)>())

__device__ __forceinline__ void p0_prologue(Frame& F) {
    LAS float* scr = (LAS float*)(F.lds + F.wave * 16384);
    const int gw = F.vcu * NWAVES + F.wave, NGW = F.G * NWAVES;
    constexpr int I_IN = (DM / 64) * (NIN / 32), I_BR = (1024 / 64) * (DM / 32), I_O = (DM / 64) * (DM / 32), I_UP = (DM / 64) * (NUP / 32), I_DN = (DFF / 64) * (DM / 32);
    constexpr int I_L = I_IN + 4 * I_BR + I_O + I_UP + I_DN;
    for (int it = gw; it < DEPTH * I_L; it += NGW) {
        const int l = it / I_L; int r = it % I_L;
        if (r < I_IN) { p0_transpose_item(INP(1) + (size_t)l * DM * NIN, DM, NIN, (bf16*)(F.ws + WS_WIN + l * WIN_L), scr, r, F.lane); continue; } r -= I_IN;
        if (r < 4 * I_BR) { const int b = r / I_BR; p0_transpose_item(INP(6) + ((size_t)l * 4 + b) * 1024 * DM, 1024, DM, (bf16*)(F.ws + WS_WBR + l * WBR_L) + (size_t)b * DM * 1024, scr, r % I_BR, F.lane); continue; } r -= 4 * I_BR;
        if (r < I_O) { p0_transpose_item(INP(7) + (size_t)l * DM * DM, DM, DM, (bf16*)(F.ws + WS_WO + l * WO_L), scr, r, F.lane); continue; } r -= I_O;
        if (r < I_UP) { p0_transpose_item<true>(INP(10) + (size_t)l * DM * NUP, DM, NUP, (bf16*)(F.ws + WS_WUP + l * WUP_L), scr, r, F.lane); continue; } r -= I_UP;
        p0_transpose_item(INP(13) + (size_t)l * DFF * DM, DFF, DM, (bf16*)(F.ws + WS_WDN + l * WDN_L), scr, r, F.lane);
    }
    const float* x = INP(0);
    for (int m = gw; m < M; m += NGW) {
        const GAS f32x4* xr = (const GAS f32x4*)(x + (size_t)m * DM) + F.lane;
        GAS v2u* o0 = (GAS v2u*)((bf16*)(F.ws + WS_AB) + (size_t)m * DM) + F.lane;
#pragma unroll 4
        for (int j = 0; j < 16; ++j) { const f32x4 v = xr[64 * j]; v2u w; w.x = pk2(v.x, v.y); w.y = pk2(v.z, v.w); o0[64 * j] = w; }
    }
}

using pg8::Unit;
template <int mode> struct InProjSched {
    int G, c; const bf16* X; const bf16* Wt;
    __device__ __forceinline__ bool next(int i, Unit& u) const {
        const int L = i * G + c;
        if constexpr (mode == 0) {
            if (L < 64 * NAT_TILES) {
                int pm, pn; pg8::tile_map(L, 64, NAT_TILES, pm, pn);
                u.pm = pm; u.pn = pn < 8 ? pn : pn < 12 ? pn + 4 : pn < 24 ? pn + 8 : pn < 52 ? pn + 12 : pn + 24; u.kind = 0; return true;
            }
            const int L2 = L - 64 * NAT_TILES;
            if (L2 >= SWP_TILES * 64) return false;
            int ft, tt; pg8::tile_map(L2, SWP_TILES, 64, ft, tt);
            u.pm = ft; u.pn = tt; u.kind = 1; return true;
        } else {
            if (L >= 4 * 64) return false;
            int ft, tt; pg8::tile_map(L, 4, 64, ft, tt);
            u.pm = 12 + 4 * mode + ft; u.pn = tt; u.kind = 1; return true;
        }
    }
    __device__ __forceinline__ void ptrs(const Unit& u, const char*& A, const char*& B) const {
        if (u.kind == 0) { A = (const char*)(X + (size_t)u.pm * 256 * DM); B = (const char*)(Wt + (size_t)u.pn * 256 * DM); }
        else { const int ft = u.pm, ct = ft < 4 ? 8 + ft : ft < 8 ? 12 + ft : ft < 12 ? 24 + ft : 52 + ft;
            A = (const char*)(Wt + (size_t)ct * 256 * DM);
            const int sh = 2 * mode, b = u.pn >> 5, p = (u.pn & 31) * 256, res = p >> (13 - sh), w0 = p & ((SEQ >> sh) - 1);
            B = (const char*)(X + ((size_t)b * SEQ + ((size_t)w0 << sh) + res) * DM); }
    }
};
struct EpiInProj {
    static constexpr bool APERM = false, PERM = true, IDEMP = true;
    bf16* NAT; bf16* VT; bf16* DAK; bf16* DLK;
    __device__ __forceinline__ void operator()(const pg8::f32x4 (&acc)[2][2][4][2], const Unit& u, int wr, int wc, int fr, int fq) const {
        bf16* base; size_t rs_m, rs_ai, cs_bj; float sc = 1.f;
        const int b = u.kind == 0 ? (u.pm >> 5) : (u.pn >> 5), t0 = ((u.kind == 0 ? u.pm : u.pn) & 31) * 256;
        if (u.kind == 0) { const int ct = u.pn;
            sc = ct < 4 ? QS_DA : (ct == 12 || ct == 13) ? 0.125f : (ct >= 40 && ct < 52) ? QS_DL : 1.f;
            if (ct >= 4 && ct < 8) {
                base = DAK + ((size_t)(b * 8 + 2 * (ct - 4)) * SEQ + t0 + wr * 64 + fr) * 128 + wc * 32 + 8 * fq; rs_m = 16 * 128; rs_ai = 128 * 128; cs_bj = (size_t)SEQ * 128;
            } else if (ct >= 52 && ct < 64) {
                const int g = (ct - 52) >> 2, hq = (ct - 52) & 3, sh = 2 * g, R = 1 << sh;
                const int prow = (fr & (R - 1)) * (SEQ >> sh) + (t0 >> sh) + wr * (64 >> sh) + (fr >> sh);
                base = DLK + ((size_t)((g * 2 + b) * 8 + 2 * hq) * SEQ + prow) * 128 + wc * 32 + 8 * fq; rs_m = (size_t)(16 >> sh) * 128; rs_ai = (size_t)(128 >> sh) * 128; cs_bj = (size_t)SEQ * 128;
            } else { base = NAT + ((size_t)u.pm * 256 + wr * 64 + fr) * NIN + ct * 256 + wc * 32 + 8 * fq; rs_m = (size_t)16 * NIN; rs_ai = (size_t)128 * NIN; cs_bj = 128; }
        } else { const int ft = u.pm;
            if (ft < 4) {
                base = VT + (size_t)VT_DAV * M + ((size_t)((b * 8 + 2 * ft) * 128 + (t0 >> 6) + (wc >> 1)) * 128 + wr * 64 + fr) * 64 + (wc & 1) * 32 + 8 * fq;
                rs_m = 16 * 64; rs_ai = (size_t)128 * 128 * 64; cs_bj = (size_t)2 * 128 * 64;
            } else if (ft >= 12) {
                const int g = (ft - 12) >> 2, hq = (ft - 12) & 3;
                base = VT + (size_t)VT_DLV * M + ((size_t)(((g * 2 + b) * 8 + 2 * hq) * 256 + (t0 >> 5) + wc) * 128 + wr * 64 + fr) * 32 + 8 * fq;
                rs_m = 16 * 32; rs_ai = (size_t)256 * 128 * 32; cs_bj = (size_t)4 * 128 * 32;
            } else { base = VT + ((size_t)ft * 256 + wr * 64 + fr) * M + u.pn * 256 + wc * 32 + 8 * fq; rs_m = (size_t)16 * M; rs_ai = (size_t)128 * M; cs_bj = 128; }
        }
#pragma unroll
        for (int ai = 0; ai < 2; ++ai)
#pragma unroll
            for (int m = 0; m < 4; ++m) { bf16* rowp = base + ai * rs_ai + m * rs_m;
#pragma unroll
                for (int bj = 0; bj < 2; ++bj) { const pg8::f32x4 v0 = acc[ai][bj][m][0] * sc, v1 = acc[ai][bj][m][1] * sc;
                    pg8::u32x4 w; w.x = pg8::cvt_pk_bf16(v0[0], v0[1]); w.y = pg8::cvt_pk_bf16(v0[2], v0[3]); w.z = pg8::cvt_pk_bf16(v1[0], v1[1]); w.w = pg8::cvt_pk_bf16(v1[2], v1[3]);
                    *(pg8::u32x4*)(rowp + bj * cs_bj) = w; } }
    }
};
struct MergeSched {
    int G, c; const bf16* Y; const bf16* Wb;
    __device__ __forceinline__ bool next(int i, Unit& u) const {
        const int L = (i >> 2) * G + c; if (L >= 64 * 16) return false;
        int pm, pn; pg8::tile_map(L, 64, 16, pm, pn); u.pm = pm; u.pn = pn; u.kind = i & 3; return true;
    }
    __device__ __forceinline__ void ptrs(const Unit& u, const char*& A, const char*& B) const {
        A = (const char*)(Y + (size_t)u.kind * M * 1024 + (size_t)u.pm * 256 * 1024); B = (const char*)(Wb + (size_t)u.kind * DM * 1024 + (size_t)u.pn * 256 * 1024);
    }
};
struct EpiMerge {
    static constexpr bool APERM = false, PERM = true, IDEMP = false;
    const bf16* NAT; bf16* MRGB;
    __device__ __forceinline__ void operator()(const pg8::f32x4 (&acc)[2][2][4][2], const Unit& u, int wr, int wc, int fr, int fq) const {
        const int row0 = u.pm * 256 + wr * 64 + fr, col0 = u.pn * 256 + wc * 32 + 8 * fq, b = u.kind;
#pragma unroll
        for (int ai = 0; ai < 2; ++ai) {
            const bf16* gp = NAT + (size_t)(row0 + ai * 128) * NIN + C_GATE + b * DM + col0; bf16* bp = MRGB + (size_t)(row0 + ai * 128) * DM + col0;
            v4u G[4][2], O[4][2];
#pragma unroll
            for (int m = 0; m < 4; ++m)
#pragma unroll
                for (int bj = 0; bj < 2; ++bj) G[m][bj] = *(const v4u*)(gp + (size_t)m * 16 * NIN + bj * 128);
            if (b > 0) {
#pragma unroll
                for (int m = 0; m < 4; ++m)
#pragma unroll
                    for (int bj = 0; bj < 2; ++bj) O[m][bj] = *(const v4u*)(bp + (size_t)m * 16 * DM + bj * 128);
            } else {
#pragma unroll
                for (int m = 0; m < 4; ++m)
#pragma unroll
                    for (int bj = 0; bj < 2; ++bj) O[m][bj] = (v4u){0u, 0u, 0u, 0u};
            }
            __builtin_amdgcn_sched_barrier(0);
#pragma unroll
            for (int m = 0; m < 4; ++m)
#pragma unroll
                for (int bj = 0; bj < 2; ++bj) { const v4u g = G[m][bj], o = O[m][bj];
                    pg8::f32x4 v0 = acc[ai][bj][m][0], v1 = acc[ai][bj][m][1];
                    v0[0] = v0[0] * fsigmoid(bflo(g.x)) + bflo(o.x); v0[1] = v0[1] * fsigmoid(bfhi(g.x)) + bfhi(o.x); v0[2] = v0[2] * fsigmoid(bflo(g.y)) + bflo(o.y); v0[3] = v0[3] * fsigmoid(bfhi(g.y)) + bfhi(o.y);
                    v1[0] = v1[0] * fsigmoid(bflo(g.z)) + bflo(o.z); v1[1] = v1[1] * fsigmoid(bfhi(g.z)) + bfhi(o.z); v1[2] = v1[2] * fsigmoid(bflo(g.w)) + bflo(o.w); v1[3] = v1[3] * fsigmoid(bfhi(g.w)) + bfhi(o.w);
                    v4u w; w.x = pg8::cvt_pk_bf16(v0[0], v0[1]); w.y = pg8::cvt_pk_bf16(v0[2], v0[3]); w.z = pg8::cvt_pk_bf16(v1[0], v1[1]); w.w = pg8::cvt_pk_bf16(v1[2], v1[3]);
                    *(v4u*)(bp + (size_t)m * 16 * DM + bj * 128) = w; }
        }
    }
};
struct PlainSched {
    int G, c, nN, K; const bf16* A; const bf16* Bt;
    __device__ __forceinline__ bool next(int i, Unit& u) const {
        const int L = i * G + c; if (L >= 64 * nN) return false;
        int pm, pn; pg8::tile_map(L, 64, nN, pm, pn); u.pm = pm; u.pn = pn; u.kind = 0; return true;
    }
    __device__ __forceinline__ void ptrs(const Unit& u, const char*& Ap, const char*& Bp) const {
        Ap = (const char*)(A + (size_t)u.pm * 256 * K); Bp = (const char*)(Bt + (size_t)u.pn * 256 * K);
    }
};
struct EpiF32 {
    static constexpr bool APERM = false, PERM = false, IDEMP = true;
    float* C; int ldc;
    __device__ __forceinline__ void operator()(const pg8::f32x4 (&acc)[2][2][4][2], const Unit& u, int wr, int wc, int fr, int fq) const {
        const int row0 = u.pm * 256 + wr * 64 + fr, col0 = u.pn * 256 + wc * 32 + 4 * fq;
#pragma unroll
        for (int ai = 0; ai < 2; ++ai)
#pragma unroll
            for (int m = 0; m < 4; ++m) { float* rowp = C + (size_t)(row0 + ai * 128 + m * 16) * ldc + col0;
#pragma unroll
                for (int bj = 0; bj < 2; ++bj)
#pragma unroll
                    for (int n = 0; n < 2; ++n) *(pg8::f32x4*)(rowp + bj * 128 + n * 16) = acc[ai][bj][m][n]; }
    }
};
struct EpiBf16 {
    static constexpr bool APERM = false, PERM = true, IDEMP = true;
    bf16* O; int ldc;
    __device__ __forceinline__ void operator()(const pg8::f32x4 (&acc)[2][2][4][2], const Unit& u, int wr, int wc, int fr, int fq) const {
        const int row0 = u.pm * 256 + wr * 64 + fr, col0 = u.pn * 256 + wc * 32 + 8 * fq;
#pragma unroll
        for (int ai = 0; ai < 2; ++ai)
#pragma unroll
            for (int m = 0; m < 4; ++m) { bf16* rowp = O + (size_t)(row0 + ai * 128 + m * 16) * ldc + col0;
#pragma unroll
                for (int bj = 0; bj < 2; ++bj) { const pg8::f32x4 v0 = acc[ai][bj][m][0], v1 = acc[ai][bj][m][1];
                    pg8::u32x4 w; w.x = pg8::cvt_pk_bf16(v0[0], v0[1]); w.y = pg8::cvt_pk_bf16(v0[2], v0[3]); w.z = pg8::cvt_pk_bf16(v1[0], v1[1]); w.w = pg8::cvt_pk_bf16(v1[2], v1[3]);
                    *(pg8::u32x4*)(rowp + bj * 128) = w; } }
    }
};

__device__ __forceinline__ float gelu1(float v) {
    const float av = fabsf(v), t = __builtin_amdgcn_rcpf(av * 0.2316418882f + 1.0f);
    float q = t * 0.5307027145f + (-0.7265760135f); q = q * t + 0.7107068705f; q = q * t + (-0.142248368f); q = q * t + 0.127414796f; q = q * t;
    const float e = __builtin_amdgcn_exp2f((v * v) * (-0.72134752044f));
    const float mm = v * (q * e);
    return v < 0.f ? mm : v - mm;
}
__device__ __forceinline__ float dpp_shr1(float v) { return __int_as_float(__builtin_amdgcn_update_dpp(0, __float_as_int(v), 0x111, 0xf, 0xf, true)); }
struct EpiAct {
    static constexpr bool APERM = true, PERM = true, IDEMP = true;
    bf16* ACT; const float* cw; const float* cb; float* EA; float* EG; float* EL;
    __device__ __forceinline__ void operator()(const pg8::f32x4 (&acc)[2][2][4][2], const Unit& u, int wr, int wc, int fr, int fq) const {
        const int c0 = u.pn * 128 + wc * 32 + 8 * fq, seg = u.pm * 2 + wr;
        bf16* op = ACT + ((size_t)u.pm * 256 + 128 * wr + 8 * fr) * DFF + c0;
        pg8::f32x4 w0[2], w1[2], w2[2], bc[2], p2[2], p1[2];
#pragma unroll
        for (int n = 0; n < 2; ++n) { w0[n] = *(const GAS pg8::f32x4*)(cw + c0 + 4 * n); w1[n] = *(const GAS pg8::f32x4*)(cw + DFF + c0 + 4 * n); w2[n] = *(const GAS pg8::f32x4*)(cw + 2 * DFF + c0 + 4 * n); bc[n] = *(const GAS pg8::f32x4*)(cb + c0 + 4 * n);
#pragma unroll
            for (int e = 0; e < 4; ++e) { p2[n][e] = dpp_shr1(acc[1][0][2][n][e]); p1[n][e] = dpp_shr1(acc[1][0][3][n][e]); } }
#pragma unroll
        for (int j = 0; j < 8; ++j) {
            pg8::f32x4 o[2];
#pragma unroll
            for (int n = 0; n < 2; ++n) { const pg8::f32x4 a0 = acc[j >> 2][0][j & 3][n], gl = acc[j >> 2][1][j & 3][n];
                const pg8::f32x4 cv = bc[n] + w0[n] * p2[n] + w1[n] * p1[n] + w2[n] * a0;
#pragma unroll
                for (int e = 0; e < 4; ++e) o[n][e] = gelu1(cv[e]) * gl[e];
                p2[n] = p1[n]; p1[n] = a0;
                if (j < 2 && fr == 0) { *(pg8::f32x4*)(EA + (size_t)(seg * 2 + j) * DFF + c0 + 4 * n) = a0; *(pg8::f32x4*)(EG + (size_t)(seg * 2 + j) * DFF + c0 + 4 * n) = gl; }
                if (j >= 6 && fr == 15) *(pg8::f32x4*)(EL + (size_t)(seg * 2 + j - 6) * DFF + c0 + 4 * n) = a0; }
            pg8::u32x4 w; w.x = pg8::cvt_pk_bf16(o[0][0], o[0][1]); w.y = pg8::cvt_pk_bf16(o[0][2], o[0][3]); w.z = pg8::cvt_pk_bf16(o[1][0], o[1][1]); w.w = pg8::cvt_pk_bf16(o[1][2], o[1][3]);
            *(pg8::u32x4*)(op + (size_t)j * DFF) = w;
        }
    }
};

__device__ __forceinline__ int wq_pull(gu32* cnt, int lane) {
    unsigned v = 0; if (lane == 0) v = __hip_atomic_fetch_add(cnt, 1u, RLX_AGENT);
    return (int)__builtin_amdgcn_readfirstlane(v);
}

constexpr int OT_ROW = 272;
__device__ __forceinline__ void ot_put(LAS unsigned char* wl, int r, int hh, int d0, v2u w) { *(LAS v2u*)(wl + r * OT_ROW + (d0 + 4 * hh) * 2) = w; }
__device__ __forceinline__ void ot_emit(const LAS unsigned char* wl, bf16* yb  , int rstride  , int lane) {
#pragma unroll
    for (int k = 0; k < 8; ++k) { const int row = (lane >> 4) + 4 * k; const v4u v = *(const LAS v4u*)(wl + row * OT_ROW + (lane & 15) * 16);
        *(v4u*)(yb + (size_t)row * rstride * 1024 + (lane & 15) * 8) = v; }
}

__device__ __forceinline__ void diff_unit(const bf16* NAT, const bf16* VT, bf16* YA, const float* normg, float lam, float oscale, int b, int h, int qt, int lane) {
    const int r = lane & 31, hh = lane >> 5;
    const float slope2 = __builtin_amdgcn_exp2f(-(float)h - 0.25f) * LOG2E;
    const size_t tok0 = (size_t)b * SEQ;
    const int q = qt * 32 + r;
    const bf16* qp = NAT + (tok0 + q) * NIN + C_DAQ + h * 128 + 8 * hh;
    f32x16 O1[4], O2[4];
#pragma unroll
    for (int d = 0; d < 4; ++d) { O1[d] = zero16(); O2[d] = zero16(); }
    float m1 = -INFINITY, m2 = -INFINITY, l1 = 0.f, l2 = 0.f;
    for (int kt = qt; kt >= 0; --kt) {
        const int k0 = kt * 32;
        const bf16* kp = NAT + (tok0 + k0 + r) * NIN + C_DAK + h * 128 + 8 * hh;
        const bf16* vp = VT + (size_t)(VT_DAV + h * 128 + r) * M + tok0 + k0 + 4 * hh;
        const float base = slope2 * (float)(k0 + 4 * hh - q);
        const bool diag = (kt == qt);
        bf16x8 pf1[2], pf2[2];
        const bf16* qq = qp; asm volatile("" : "+v"(qq));
        {
            f32x16 s1 = zero16();
#pragma unroll
            for (int s = 0; s < 4; ++s) s1 = mfma32(ld8(kp + 16 * s), ld8(qq + 16 * s), s1);
            float mx = -INFINITY;
#pragma unroll
            for (int i = 0; i < 16; ++i) { float v = s1[i] + (base + slope2 * (float)ROWOFF(i)); if (diag && (k0 + 4 * hh + ROWOFF(i) > q)) v = -INFINITY; s1[i] = v; mx = fmaxf(mx, v); }
            mx = half_max(mx);
            const float mn = fmaxf(m1, mx), al = __builtin_amdgcn_exp2f(m1 - mn); m1 = mn;
            float ps = 0.f;
#pragma unroll
            for (int i = 0; i < 16; ++i) { const float p = __builtin_amdgcn_exp2f(s1[i] - mn); s1[i] = p; ps += p; }
            l1 = l1 * al + half_sum(ps);
            if (!__all(al == 1.f)) {
#pragma unroll
                for (int d = 0; d < 4; ++d) O1[d] *= al; }
            pf1[0] = pack8<0>(s1); pf1[1] = pack8<1>(s1);
        }
        {
            f32x16 s2 = zero16();
#pragma unroll
            for (int s = 0; s < 4; ++s) s2 = mfma32(ld8(kp + 64 + 16 * s), ld8(qq + 64 + 16 * s), s2);
            float mx = -INFINITY;
#pragma unroll
            for (int i = 0; i < 16; ++i) { float v = s2[i] + (base + slope2 * (float)ROWOFF(i)); if (diag && (k0 + 4 * hh + ROWOFF(i) > q)) v = -INFINITY; s2[i] = v; mx = fmaxf(mx, v); }
            mx = half_max(mx);
            const float mn = fmaxf(m2, mx), al = __builtin_amdgcn_exp2f(m2 - mn); m2 = mn;
            float ps = 0.f;
#pragma unroll
            for (int i = 0; i < 16; ++i) { const float p = __builtin_amdgcn_exp2f(s2[i] - mn); s2[i] = p; ps += p; }
            l2 = l2 * al + half_sum(ps);
            if (!__all(al == 1.f)) {
#pragma unroll
                for (int d = 0; d < 4; ++d) O2[d] *= al; }
            pf2[0] = pack8<0>(s2); pf2[1] = pack8<1>(s2);
        }
#pragma unroll
        for (int d = 0; d < 4; ++d)
#pragma unroll
            for (int s = 0; s < 2; ++s) { const bf16x8 vf = ld44(vp + (size_t)d * 32 * M + 16 * s); O1[d] = mfma32(vf, pf1[s], O1[d]); O2[d] = mfma32(vf, pf2[s], O2[d]); }
    }
    const float i1 = 1.f / l1, i2 = lam / l2;
    float ss = 0.f;
#pragma unroll
    for (int d = 0; d < 4; ++d)
#pragma unroll
        for (int i = 0; i < 16; ++i) { const float o = O1[d][i] * i1 - O2[d][i] * i2; O1[d][i] = o; ss += o * o; }
    ss = half_sum(ss);
    const float rs = __builtin_amdgcn_rsqf(ss * (1.f / 128.f) + EPS) * oscale;
    bf16* yp = YA + (tok0 + q) * 1024 + h * 128 + 4 * hh;
#pragma unroll
    for (int d = 0; d < 4; ++d)
#pragma unroll
        for (int g = 0; g < 4; ++g) { const int d0 = 32 * d + 8 * g; const f32x4 gv = *(const f32x4*)(normg + d0 + 4 * hh);
            v2u w; w.x = pg8::cvt_pk_bf16(O1[d][4 * g] * rs * gv.x, O1[d][4 * g + 1] * rs * gv.y); w.y = pg8::cvt_pk_bf16(O1[d][4 * g + 2] * rs * gv.z, O1[d][4 * g + 3] * rs * gv.w);
            *(v2u*)(yp + d0) = w; }
}

constexpr int DA_KROW = 272, DA_VROW = 136;
constexpr int DA_KBUF = 64 * DA_KROW, DA_VBUF = 128 * DA_VROW, DA_STAGE = DA_KBUF + DA_VBUF, DA_QOFF = 2 * DA_STAGE, DA_END = DA_QOFF + 256 * DA_KROW;
static_assert(DA_END <= LDSCTL_OFF, "diff-attention LDS map");
typedef LAS unsigned char* ldsp;
__device__ __forceinline__ bf16x8 lds8(const LAS unsigned char* p) { return *(const LAS bf16x8*)p; }
__device__ __forceinline__ bf16x8 lds44(const LAS unsigned char* p) { const bf16x4 a = *(const LAS bf16x4*)p, b = *(const LAS bf16x4*)(p + 16); return __builtin_shufflevector(a, b, 0, 1, 2, 3, 4, 5, 6, 7); }
__device__ __forceinline__ void da_softmax(f32x16& s, float slope2, float base, bool diag, int dq, float& m, float& l, f32x16 (&O)[4], bf16x8& p0, bf16x8& p1) {
    float mx = -INFINITY;
#pragma unroll
    for (int i = 0; i < 16; ++i) { float v = __builtin_fmaf(slope2, (float)ROWOFF(i), s[i]); if (diag && (ROWOFF(i) > dq)) v = -INFINITY; s[i] = v; mx = fmaxf(mx, v); }
    mx = half_max(mx + base);
    const float mn = fmaxf(m, mx), al = __builtin_amdgcn_exp2f(m - mn), sm = mn - base; m = mn;
    float ps = 0.f;
#pragma unroll
    for (int i = 0; i < 16; ++i) { const float p = __builtin_amdgcn_exp2f(s[i] - sm); s[i] = p; ps += p; }
    l = l * al + half_sum(ps);
    if (!__all(al == 1.f)) {
#pragma unroll
        for (int d = 0; d < 4; ++d) O[d] *= al; }
    p0 = pack8<0>(s); p1 = pack8<1>(s);
}
__device__ __forceinline__ void diff_block(LAS unsigned char* lds, volatile LAS unsigned* flags, const unsigned* nrm, const bf16* NAT, const bf16* DAK, const bf16* VT, bf16* YA, const float* normg, float lam, float oscale, int b, int h, int qb, int tid) {
    const int lane = tid & 63, w = __builtin_amdgcn_readfirstlane(tid >> 6), r = lane & 31, hh = lane >> 5;
    const float slope2 = __builtin_amdgcn_exp2f(-(float)h - 0.25f) * LOG2E;
    const float sub = sqrtf(fmaxf(__uint_as_float(nrm[4 * h + 0]) * __uint_as_float(nrm[4 * h + 2]), __uint_as_float(nrm[4 * h + 1]) * __uint_as_float(nrm[4 * h + 3]))) * 1.01f;
    const size_t tok0 = (size_t)b * SEQ;
    const int q0 = 256 * qb, q = q0 + 32 * w + r, qt_w = 8 * qb + w;
    const bf16* kg = DAK + (size_t)(b * 8 + h) * SEQ * 128 + 8 * tid;
    const bf16* vg = VT + (size_t)VT_DAV * M + (size_t)(b * 8 + h) * SEQ * 128 + 8 * tid;
    const int kw = (tid >> 4) * DA_KROW + (tid & 15) * 16, vw = DA_KBUF + (tid >> 3) * DA_VROW + (tid & 7) * 16;
    {
        const bf16* qg = NAT + (tok0 + q0 + (tid >> 4)) * NIN + C_DAQ + h * 128 + 8 * (tid & 15);
#pragma unroll
        for (int i = 0; i < 8; ++i) *(LAS v4u*)(lds + DA_QOFF + kw + i * 32 * DA_KROW) = *(const v4u*)(qg + (size_t)i * 32 * NIN);
    }
    int kt = 4 * qb + 3;
    v4u g0, g1, g2, g3;
#define DA_LOAD(KT) do { const size_t k0_ = (size_t)(KT) * 8192; g0 = *(const v4u*)(kg + k0_); g1 = *(const v4u*)(kg + k0_ + 4096); g2 = *(const v4u*)(vg + k0_); g3 = *(const v4u*)(vg + k0_ + 4096); } while (0)
#define DA_STORE(BUF) do { LAS unsigned char* s_ = lds + (BUF) * DA_STAGE; *(LAS v4u*)(s_ + kw) = g0; *(LAS v4u*)(s_ + kw + 32 * DA_KROW) = g1; \
        *(LAS v2u*)(s_ + vw) = (v2u){g2.x, g2.y}; *(LAS v2u*)(s_ + vw + 8) = (v2u){g2.z, g2.w}; *(LAS v2u*)(s_ + vw + 64 * DA_VROW) = (v2u){g3.x, g3.y}; *(LAS v2u*)(s_ + vw + 64 * DA_VROW + 8) = (v2u){g3.z, g3.w}; } while (0)
    DA_LOAD(kt); DA_STORE(0);
    __syncthreads();
    f32x16 O1[4], O2[4];
#pragma unroll
    for (int d = 0; d < 4; ++d) { O1[d] = zero16(); O2[d] = zero16(); }
    float m1 = -INFINITY, m2 = -INFINITY, l1 = 0.f, l2 = 0.f;
    const LAS unsigned char* qa = lds + DA_QOFF + (32 * w + r) * DA_KROW + 16 * hh;
    int cur = 0;
    for (; kt >= 0; --kt) {
        if (kt > 0) DA_LOAD(kt - 1);
        const LAS unsigned char* Kb = lds + cur * DA_STAGE; const LAS unsigned char* Vb = Kb + DA_KBUF;
#pragma unroll
        for (int sub = 1; sub >= 0; --sub) {
            const int st = 2 * kt + sub;
            if (st <= qt_w) {
                const bool diag = (st == qt_w);
                const float base = slope2 * (float)(32 * st + 4 * hh - q);
                const int dq = q - 32 * st - 4 * hh;
                const LAS unsigned char* ka = Kb + (32 * sub + r) * DA_KROW + 16 * hh;
                bf16x8 pf1[2], pf2[2];
                { f32x16 s1 = zero16();
#pragma unroll
                  for (int s = 0; s < 4; ++s) s1 = mfma32(lds8(ka + 32 * s), lds8(qa + 32 * s), s1);
                  da_softmax(s1, slope2, base, diag, dq, m1, l1, O1, pf1[0], pf1[1]); }
                { f32x16 s2 = zero16();
#pragma unroll
                  for (int s = 0; s < 4; ++s) s2 = mfma32(lds8(ka + 128 + 32 * s), lds8(qa + 128 + 32 * s), s2);
                  da_softmax(s2, slope2, base, diag, dq, m2, l2, O2, pf2[0], pf2[1]); }
                const LAS unsigned char* va = Vb + r * DA_VROW + (32 * sub + 4 * hh) * 2;
#pragma unroll
                for (int d = 0; d < 4; ++d)
#pragma unroll
                    for (int s = 0; s < 2; ++s) { const bf16x8 vf = lds44(va + d * 32 * DA_VROW + 32 * s); O1[d] = mfma32(vf, pf1[s], O1[d]); O2[d] = mfma32(vf, pf2[s], O2[d]); }
            }
        }
        const bool can = (sub - slope2 * (float)(q - 64 * kt + 1)) < fminf(m1, m2) - 32.f;
        const bool wcan = __all(can);
        if (lane == 0) flags[(kt & 1) * 8 + w] = wcan ? 1u : 0u;
        if (kt > 0) DA_STORE(cur ^ 1);
        __syncthreads();
        cur ^= 1;
        {   const LAS v4u* fp = (const LAS v4u*)(const_cast<LAS unsigned*>(flags) + (kt & 1) * 8); const v4u fa = fp[0], fb = fp[1];
            if ((fa.x & fa.y & fa.z & fa.w & fb.x & fb.y & fb.z & fb.w) != 0u) break; }
    }
#undef DA_LOAD
#undef DA_STORE
    const float i1 = 1.f / l1, i2 = lam / l2;
    float ss = 0.f;
#pragma unroll
    for (int d = 0; d < 4; ++d)
#pragma unroll
        for (int i = 0; i < 16; ++i) { const float o = O1[d][i] * i1 - O2[d][i] * i2; O1[d][i] = o; ss += o * o; }
    ss = half_sum(ss);
    const float rs = __builtin_amdgcn_rsqf(ss * (1.f / 128.f) + EPS) * oscale;
    LAS unsigned char* ot = lds + w * (32 * OT_ROW);
#pragma unroll
    for (int d = 0; d < 4; ++d)
#pragma unroll
        for (int g = 0; g < 4; ++g) { const int d0 = 32 * d + 8 * g; const f32x4 gv = *(const f32x4*)(normg + d0 + 4 * hh);
            v2u w2; w2.x = pg8::cvt_pk_bf16(O1[d][4 * g] * rs * gv.x, O1[d][4 * g + 1] * rs * gv.y); w2.y = pg8::cvt_pk_bf16(O1[d][4 * g + 2] * rs * gv.z, O1[d][4 * g + 3] * rs * gv.w);
            ot_put(ot, r, hh, d0, w2); }
    ot_emit(ot, YA + (tok0 + q0 + 32 * w) * 1024 + h * 128, 1, lane);
}

constexpr int DL_KROW = 272, DL_VROW = 72, DL_KBUF = 32 * DL_KROW, DL_WAVE = DL_KBUF + 128 * DL_VROW;
static_assert(8 * DL_WAVE <= LDSCTL_OFF, "dilated-attention LDS map");
template <int G_> __device__ __forceinline__ void dil_group(LAS unsigned char* wl, const bf16* NAT, const bf16* DLK, const bf16* VT, size_t tok0, int h, int rho, int ut, int lane, f32x16 (&O)[4], float& m, float& l) {
    constexpr int SH = G_ == 0 ? 0 : G_ == 1 ? 2 : 4, RATE = 1 << SH;
    const int r = lane & 31, hh = lane >> 5;
    const int tq = rho + 16 * (32 * ut + r);
    const int res = rho & (RATE - 1);
    const int wq = (tq - res) >> SH;
    const int wq0 = ((rho - res) >> SH) + (16 >> SH) * (32 * ut), wq31 = wq0 + (16 >> SH) * 31;
    const int kt_hi = wq31 >> 5; int kt_lo = (wq0 - 128) >> 5; kt_lo = kt_lo < 0 ? 0 : kt_lo;
    const float slope2 = __builtin_amdgcn_exp2f(-(float)(4 * h + 2 + G_) * 0.25f) * LOG2E * (float)RATE;
    const bf16* qp = NAT + (tok0 + tq) * NIN + C_DLQ + G_ * 1024 + h * 128 + 8 * hh;
    bf16x8 qf[8];
#pragma unroll
    for (int s = 0; s < 8; ++s) qf[s] = ld8(qp + 16 * s);
    const int bb = (int)(tok0 / SEQ);
    const bf16* kg = DLK + ((size_t)((G_ * 2 + bb) * 8 + h) * SEQ + (size_t)res * (SEQ >> SH)) * 128 + 8 * lane;
    const bf16* vg = VT + (size_t)VT_DLV * M + ((size_t)((G_ * 2 + bb) * 8 + h) * SEQ + (size_t)res * (SEQ >> SH)) * 128 + 8 * lane;
    LAS unsigned char* kw = wl + (lane >> 4) * DL_KROW + (lane & 15) * 16;
    LAS unsigned char* vw = wl + DL_KBUF + (lane >> 2) * DL_VROW + (lane & 3) * 16;
    v4u gk[8], gv[8];
#define DL_LOAD(KT) do { _Pragma("unroll") for (int i_ = 0; i_ < 8; ++i_) { gk[i_] = *(const v4u*)(kg + (size_t)(KT) * 4096 + 512 * i_); gv[i_] = *(const v4u*)(vg + (size_t)(KT) * 4096 + 512 * i_); } } while (0)
#define DL_STORE() do { _Pragma("unroll") for (int i_ = 0; i_ < 8; ++i_) { *(LAS v4u*)(kw + 4 * i_ * DL_KROW) = gk[i_]; \
        *(LAS v2u*)(vw + 16 * i_ * DL_VROW) = (v2u){gv[i_].x, gv[i_].y}; *(LAS v2u*)(vw + 16 * i_ * DL_VROW + 8) = (v2u){gv[i_].z, gv[i_].w}; } } while (0)
    DL_LOAD(kt_hi); DL_STORE();
    const LAS unsigned char* ka = wl + r * DL_KROW + 16 * hh;
    const LAS unsigned char* va = wl + DL_KBUF + r * DL_VROW + 8 * hh;
    for (int kt = kt_hi; kt >= kt_lo; --kt) {
        const int w0 = kt * 32;
        if (kt > kt_lo) DL_LOAD(kt - 1);
        f32x16 s = zero16();
#pragma unroll
        for (int ks = 0; ks < 8; ++ks) s = mfma32(lds8(ka + 32 * ks), qf[ks], s);
        float mx = -INFINITY;
        const int dq = wq - w0 - 4 * hh;
#pragma unroll
        for (int i = 0; i < 16; ++i) { const int d = dq - ROWOFF(i); const float v = (d >= 0 && d <= 128) ? s[i] - slope2 * (float)d : -INFINITY; s[i] = v; mx = fmaxf(mx, v); }
        mx = half_max(mx);
        const float mn = fmaxf(m, mx), mu = (mn == -INFINITY) ? 0.f : mn, al = __builtin_amdgcn_exp2f(m - mu); m = mn;
        float ps = 0.f;
#pragma unroll
        for (int i = 0; i < 16; ++i) { const float p = __builtin_amdgcn_exp2f(s[i] - mu); s[i] = p; ps += p; }
        l = l * al + half_sum(ps);
        if (!__all(al == 1.f)) {
#pragma unroll
            for (int d = 0; d < 4; ++d) O[d] *= al; }
        const bf16x8 pf0 = pack8<0>(s), pf1 = pack8<1>(s);
#pragma unroll
        for (int d = 0; d < 4; ++d) { O[d] = mfma32(lds44(va + d * 32 * DL_VROW), pf0, O[d]); O[d] = mfma32(lds44(va + d * 32 * DL_VROW + 32), pf1, O[d]); }
        if (kt > kt_lo) DL_STORE();
    }
#undef DL_LOAD
#undef DL_STORE
}
__device__ __forceinline__ void dil_unit(LAS unsigned char* wl, const bf16* NAT, const bf16* DLK, const bf16* VT, bf16* YD, int b, int h, int rho, int ut, int lane) {
    const int r = lane & 31, hh = lane >> 5;
    const size_t tok0 = (size_t)b * SEQ;
    f32x16 O[4];
#pragma unroll
    for (int d = 0; d < 4; ++d) O[d] = zero16();
    float m = -INFINITY, l = 0.f;
    dil_group<2>(wl, NAT, DLK, VT, tok0, h, rho, ut, lane, O, m, l);
    dil_group<1>(wl, NAT, DLK, VT, tok0, h, rho, ut, lane, O, m, l);
    dil_group<0>(wl, NAT, DLK, VT, tok0, h, rho, ut, lane, O, m, l);
    const float il = 1.f / l;
    const int tq = rho + 16 * (32 * ut + r);
    bf16* yp = YD + (tok0 + tq) * 1024 + h * 128 + 4 * hh;
#pragma unroll
    for (int d = 0; d < 4; ++d)
#pragma unroll
        for (int g = 0; g < 4; ++g) { v2u w; w.x = pg8::cvt_pk_bf16(O[d][4 * g] * il, O[d][4 * g + 1] * il); w.y = pg8::cvt_pk_bf16(O[d][4 * g + 2] * il, O[d][4 * g + 3] * il);
            *(v2u*)(yp + 32 * d + 8 * g) = w; }
}

__device__ __forceinline__ float ret_log2g(int h) { return __builtin_amdgcn_logf(1.f - __builtin_amdgcn_exp2f(-(float)(5 + h))); }
constexpr int RU_ROW = 132, RU_WAVE = 128 * RU_ROW;
__device__ __forceinline__ void retu_unit(LAS unsigned char* wl, const bf16* NAT, const bf16* VT, float* UR, int bh, int n, int lane) {
    const int r = lane & 31, hh = lane >> 5, b = bh >> 3, h = bh & 7;
    const size_t tokc = (size_t)b * SEQ + 128 * n;
    {   const bf16* kg = NAT + (tokc + (lane >> 3)) * NIN + C_RTK + h * 64 + 8 * (lane & 7);
        LAS unsigned* kw = (LAS unsigned*)(wl + (lane >> 3) * RU_ROW + (lane & 7) * 16);
#pragma unroll 1
        for (int i0 = 0; i0 < 16; i0 += 8) { v4u kv[8];
#pragma unroll
            for (int i = 0; i < 8; ++i) kv[i] = *(const v4u*)(kg + (size_t)8 * (i0 + i) * NIN);
#pragma unroll
            for (int i = 0; i < 8; ++i) { LAS unsigned* d = kw + 8 * (i0 + i) * (RU_ROW / 4); d[0] = kv[i].x; d[1] = kv[i].y; d[2] = kv[i].z; d[3] = kv[i].w; } } }
    bf16x8 kf[2][8];
    const float l2g = ret_log2g(h);
    float ge[8];
#pragma unroll
    for (int e = 0; e < 8; ++e) ge[e] = __builtin_amdgcn_exp2f(-(float)e * l2g);
#pragma unroll
    for (int s = 0; s < 8; ++s) { const float fs = __builtin_amdgcn_exp2f((float)(127 - 16 * s - 8 * hh) * l2g);
#pragma unroll
        for (int dt = 0; dt < 2; ++dt) { const LAS unsigned short* p = (const LAS unsigned short*)(wl + (16 * s + 8 * hh) * RU_ROW + (32 * dt + r) * 2);
            v4u w;
            w.x = pg8::cvt_pk_bf16(bf1(p[0 * (RU_ROW / 2)]) * (fs * ge[0]), bf1(p[1 * (RU_ROW / 2)]) * (fs * ge[1])); w.y = pg8::cvt_pk_bf16(bf1(p[2 * (RU_ROW / 2)]) * (fs * ge[2]), bf1(p[3 * (RU_ROW / 2)]) * (fs * ge[3]));
            w.z = pg8::cvt_pk_bf16(bf1(p[4 * (RU_ROW / 2)]) * (fs * ge[4]), bf1(p[5 * (RU_ROW / 2)]) * (fs * ge[5])); w.w = pg8::cvt_pk_bf16(bf1(p[6 * (RU_ROW / 2)]) * (fs * ge[6]), bf1(p[7 * (RU_ROW / 2)]) * (fs * ge[7]));
            kf[dt][s] = __builtin_bit_cast(bf16x8, w); __builtin_amdgcn_sched_barrier(0); } }
#pragma unroll 1
    for (int et = 0; et < 4; ++et) {
        const bf16* ap = VT + (size_t)(VT_RTV + h * 128 + 32 * et + r) * M + tokc + 8 * hh;
        f32x16 a0 = zero16(), a1 = zero16();
#pragma unroll
        for (int s = 0; s < 8; ++s) { const bf16x8 af = ld8(ap + 16 * s); a0 = mfma32(af, kf[0][s], a0); a1 = mfma32(af, kf[1][s], a1); }
        float* up = UR + ((size_t)(bh * 64 + n) * 128 + 32 * et + 4 * hh) * 64 + r;
#pragma unroll
        for (int i = 0; i < 16; ++i) { up[ROWOFF(i) * 64] = a0[i]; up[ROWOFF(i) * 64 + 32] = a1[i]; }
    }
}
__device__ __forceinline__ void ret_out_unit(LAS unsigned char* wl, const bf16* NAT, const bf16* VT, const bf16* SR, bf16* YR, int bh, int n, int it, int lane) {
    const int r = lane & 31, hh = lane >> 5, b = bh >> 3, h = bh & 7;
    const size_t tok0 = (size_t)b * SEQ + 128 * n;
    const int il = 32 * it + r;
    const float l2g = ret_log2g(h);
    const bf16* qp = NAT + (tok0 + il) * NIN + C_RTQ + h * 64 + 8 * hh;
    bf16x8 qf[4];
#pragma unroll
    for (int s = 0; s < 4; ++s) qf[s] = ld8(qp + 16 * s);
    f32x16 O[4];
    const bf16* sp = SR + ((size_t)(bh * 64 + n) * 128 + r) * 64 + 8 * hh;
    const float qd = __builtin_amdgcn_exp2f((float)(il + 1) * l2g);
#pragma unroll
    for (int e = 0; e < 4; ++e) { f32x16 a = zero16();
#pragma unroll
        for (int s = 0; s < 4; ++s) a = mfma32(ld8(sp + e * 32 * 64 + 16 * s), qf[s], a);
        O[e] = a * qd; }
    for (int jt = 0; jt <= it; ++jt) {
        const bf16* kp = NAT + (tok0 + 32 * jt + r) * NIN + C_RTK + h * 64 + 8 * hh;
        f32x16 s = zero16();
#pragma unroll
        for (int ks = 0; ks < 4; ++ks) s = mfma32(ld8(kp + 16 * ks), qf[ks], s);
        const int dq = il - 32 * jt - 4 * hh;
#pragma unroll
        for (int i = 0; i < 16; ++i) { const int d = dq - ROWOFF(i); s[i] = d >= 0 ? s[i] * __builtin_amdgcn_exp2f((float)d * l2g) : 0.f; }
        const bf16x8 pf0 = pack8<0>(s), pf1 = pack8<1>(s);
        const bf16* vp = VT + (size_t)(VT_RTV + h * 128 + r) * M + tok0 + 32 * jt + 4 * hh;
#pragma unroll
        for (int e = 0; e < 4; ++e) { O[e] = mfma32(ld44(vp + (size_t)e * 32 * M), pf0, O[e]); O[e] = mfma32(ld44(vp + (size_t)e * 32 * M + 16), pf1, O[e]); }
    }
    float sm = 0.f;
#pragma unroll
    for (int e = 0; e < 4; ++e)
#pragma unroll
        for (int i = 0; i < 16; ++i) sm += O[e][i];
    const float mean = half_sum(sm) * (1.f / 128.f);
    float sq = 0.f;
#pragma unroll
    for (int e = 0; e < 4; ++e)
#pragma unroll
        for (int i = 0; i < 16; ++i) { const float d = O[e][i] - mean; O[e][i] = d; sq += d * d; }
    const float rs = __builtin_amdgcn_rsqf(half_sum(sq) * (1.f / 128.f) + EPS);
    const bf16* gp = NAT + (tok0 + il) * NIN + C_RTG + h * 128 + 4 * hh;
#pragma unroll
    for (int e = 0; e < 4; ++e)
#pragma unroll
        for (int g = 0; g < 4; ++g) { const int d0 = 32 * e + 8 * g; const v2u gw = *(const v2u*)(gp + d0);
            const float g0 = bflo(gw.x), g1 = bfhi(gw.x), g2 = bflo(gw.y), g3 = bfhi(gw.y);
            v2u w; w.x = pg8::cvt_pk_bf16(O[e][4 * g] * rs * g0 * fsigmoid(g0), O[e][4 * g + 1] * rs * g1 * fsigmoid(g1));
            w.y = pg8::cvt_pk_bf16(O[e][4 * g + 2] * rs * g2 * fsigmoid(g2), O[e][4 * g + 3] * rs * g3 * fsigmoid(g3));
            ot_put(wl, r, hh, d0, w); }
    ot_emit(wl, YR + (tok0 + 32 * it) * 1024 + h * 128, 1, lane);
}

constexpr int HP_ROW = 136, HP_WAVE = 128 * HP_ROW;
static_assert(8 * HP_WAVE <= LDSCTL_OFF, "HGRN prep LDS map");
__device__ __forceinline__ float lb_of(const float* lbl, int layer, int c) {
    if (layer == 0) return 0.f;
    float mx = -INFINITY; for (int d = 0; d < DEPTH; ++d) mx = fmaxf(mx, lbl[d * 1024 + c]);
    float den = 0.f, num = 0.f;
    for (int d = 0; d < DEPTH; ++d) { const float e = __expf(lbl[d * 1024 + c] - mx); den += e; if (d >= 1 && d <= layer) num += e; }
    return num / den;
}
__device__ __forceinline__ void hgpu_unit(LAS unsigned char* wl, const bf16* NAT, const bf16* VT, const float* lbl, int layer, bf16* QT, bf16* KT, bf16* QC, float* DEC, float* UH, int bh, int n, int lane) {
    const int r = lane & 31, hh = lane >> 5, b = bh >> 3, h = bh & 7;
    const size_t t0 = (size_t)b * SEQ + 64 * n;
    const int c2 = h * 128 + 2 * lane;
    const float lb0 = lb_of(lbl, layer, c2), lb1 = lb_of(lbl, layer, c2 + 1), om0 = 1.f - lb0, om1 = 1.f - lb1;
    const unsigned* fp = (const unsigned*)(NAT + t0 * NIN + C_HGF + c2); const unsigned* qp = (const unsigned*)(NAT + t0 * NIN + C_HGQ + c2);
    float run0 = 0.f, run1 = 0.f, ref0 = 0.f, ref1 = 0.f;
#pragma unroll 1
    for (int jb = 0; jb < 4; ++jb) { unsigned fv[16];
#pragma unroll
        for (int k = 0; k < 16; ++k) fv[k] = fp[(size_t)(16 * jb + k) * (NIN / 2)];
#pragma unroll
        for (int k = 0; k < 16; ++k) { run0 += __logf(lb0 + om0 / (1.f + __expf(-bflo(fv[k])))); run1 += __logf(lb1 + om1 / (1.f + __expf(-bfhi(fv[k])))); }
        if (jb == 1) { ref0 = run0; ref1 = run1; } }
    const float bl0 = run0, bl1 = run1; run0 = 0.f; run1 = 0.f;
    unsigned* const QTu = (unsigned*)QT + (t0 * 1024 + c2) / 2; unsigned* const KTu = (unsigned*)KT + (t0 * 1024 + c2) / 2; unsigned* const QCu = (unsigned*)QC + (t0 * 1024 + c2) / 2;
    LAS unsigned char* kw = wl + (2 * lane) * HP_ROW;
#pragma unroll 1
    for (int jb = 0; jb < 4; ++jb) { unsigned fv[16], qv[16];
#pragma unroll
        for (int k = 0; k < 16; ++k) { fv[k] = fp[(size_t)(16 * jb + k) * (NIN / 2)]; qv[k] = qp[(size_t)(16 * jb + k) * (NIN / 2)]; }
        unsigned kp0 = 0u, kp1 = 0u;
#pragma unroll
        for (int k = 0; k < 16; ++k) { const int j = 16 * jb + k;
            const float lf0 = __logf(lb0 + om0 / (1.f + __expf(-bflo(fv[k])))), lf1 = __logf(lb1 + om1 / (1.f + __expf(-bfhi(fv[k]))));
            run0 += lf0; run1 += lf1;
            const float q0 = bflo(qv[k]), q1 = bfhi(qv[k]);
            const float qs0 = q0 / (1.f + __expf(-q0)), qs1 = q1 / (1.f + __expf(-q1)), kin0 = 1.f - __expf(lf0), kin1 = 1.f - __expf(lf1);
            QTu[(size_t)j * 512] = pk2(qs0 * __expf(run0 - ref0), qs1 * __expf(run1 - ref1));
            KTu[(size_t)j * 512] = pk2(kin0 * __expf(ref0 - run0), kin1 * __expf(ref1 - run1));
            QCu[(size_t)j * 512] = pk2(qs0 * __expf(run0), qs1 * __expf(run1));
            const unsigned k0b = f2bf(kin0 * __expf(bl0 - run0)), k1b = f2bf(kin1 * __expf(bl1 - run1));
            if (k & 1) { *(LAS unsigned*)(kw + 2 * (j - 1)) = kp0 | (k0b << 16); *(LAS unsigned*)(kw + HP_ROW + 2 * (j - 1)) = kp1 | (k1b << 16); } else { kp0 = k0b; kp1 = k1b; } } }
    { float2 dv; dv.x = __expf(bl0); dv.y = __expf(bl1); *(float2*)(DEC + (size_t)(b * 128 + n) * 1024 + c2) = dv; }
    const LAS unsigned char* kr = wl + r * HP_ROW + 16 * hh;
#pragma unroll 1
    for (int et = 0; et < 4; ++et) {
        const bf16* ap = VT + (size_t)(VT_HGI + h * 128 + 32 * et + r) * M + t0 + 8 * hh;
        bf16x8 af[4];
#pragma unroll
        for (int s2 = 0; s2 < 4; ++s2) af[s2] = ld8(ap + 16 * s2);
        float* up = UH + ((size_t)(bh * 128 + n) * 128 + 32 * et + 4 * hh) * 128 + r;
#pragma unroll
        for (int ct = 0; ct < 4; ++ct) { f32x16 a = zero16();
#pragma unroll
            for (int s2 = 0; s2 < 4; ++s2) { const LAS unsigned char* p = kr + ct * 32 * HP_ROW + 32 * s2;
                const bf16x4 lo = *(const LAS bf16x4*)p, hi = *(const LAS bf16x4*)(p + 8);
                a = mfma32(af[s2], __builtin_shufflevector(lo, hi, 0, 1, 2, 3, 4, 5, 6, 7), a); }
#pragma unroll
            for (int i = 0; i < 16; ++i) up[ROWOFF(i) * 128 + 32 * ct] = a[i]; }
    }
}
__device__ __forceinline__ void hg_out_unit(LAS unsigned char* wl, const bf16* NAT, const bf16* VT, const bf16* QT, const bf16* KT, const bf16* QC, const bf16* SH, const float* normg, bf16* YC, int bh, int n, int it, int lane) {
    const int r = lane & 31, hh = lane >> 5, b = bh >> 3, h = bh & 7;
    const size_t tok0 = (size_t)b * SEQ + 64 * n;
    const int il = 32 * it + r;
    f32x16 O[4];
#pragma unroll
    for (int e = 0; e < 4; ++e) O[e] = zero16();
    {
        const bf16* sp = SH + ((size_t)(bh * 128 + n) * 128 + r) * 128 + 8 * hh;
        const bf16* qc = QC + (tok0 + il) * 1024 + h * 128 + 8 * hh;
#pragma unroll
        for (int s = 0; s < 8; ++s) { const bf16x8 qf = ld8(qc + 16 * s);
#pragma unroll
            for (int e = 0; e < 4; ++e) O[e] = mfma32(ld8(sp + e * 32 * 128 + 16 * s), qf, O[e]); }
    }
    const bf16* qp = QT + (tok0 + il) * 1024 + h * 128 + 8 * hh;
    bf16x8 qf[8];
#pragma unroll
    for (int s = 0; s < 8; ++s) qf[s] = ld8(qp + 16 * s);
    for (int jt = 0; jt <= it; ++jt) {
        const bf16* kp = KT + (tok0 + 32 * jt + r) * 1024 + h * 128 + 8 * hh;
        f32x16 s = zero16();
#pragma unroll
        for (int ks = 0; ks < 8; ++ks) s = mfma32(ld8(kp + 16 * ks), qf[ks], s);
        const int dq = il - 32 * jt - 4 * hh;
#pragma unroll
        for (int i = 0; i < 16; ++i) s[i] = (dq - ROWOFF(i) >= 0) ? s[i] : 0.f;
        const bf16x8 pf0 = pack8<0>(s), pf1 = pack8<1>(s);
        const bf16* vp = VT + (size_t)(VT_HGI + h * 128 + r) * M + tok0 + 32 * jt + 4 * hh;
#pragma unroll
        for (int e = 0; e < 4; ++e) { O[e] = mfma32(ld44(vp + (size_t)e * 32 * M), pf0, O[e]); O[e] = mfma32(ld44(vp + (size_t)e * 32 * M + 16), pf1, O[e]); }
    }
    float sq = 0.f;
#pragma unroll
    for (int e = 0; e < 4; ++e)
#pragma unroll
        for (int i = 0; i < 16; ++i) sq += O[e][i] * O[e][i];
    const float rs = __builtin_amdgcn_rsqf(half_sum(sq) * (1.f / 128.f) + EPS);
    const bf16* gp = NAT + (tok0 + il) * NIN + C_HGG + h * 128 + 4 * hh;
#pragma unroll
    for (int e = 0; e < 4; ++e)
#pragma unroll
        for (int g = 0; g < 4; ++g) { const int d0 = 32 * e + 8 * g; const v2u gw = *(const v2u*)(gp + d0); const f32x4 ng = *(const f32x4*)(normg + d0 + 4 * hh);
            const float g0 = bflo(gw.x), g1 = bfhi(gw.x), g2 = bflo(gw.y), g3 = bfhi(gw.y);
            v2u w; w.x = pg8::cvt_pk_bf16(O[e][4 * g] * rs * ng.x * g0 * fsigmoid(g0), O[e][4 * g + 1] * rs * ng.y * g1 * fsigmoid(g1));
            w.y = pg8::cvt_pk_bf16(O[e][4 * g + 2] * rs * ng.z * g2 * fsigmoid(g2), O[e][4 * g + 3] * rs * ng.w * g3 * fsigmoid(g3));
            ot_put(wl, r, hh, d0, w); }
    ot_emit(wl, YC + (tok0 + 32 * it) * 1024 + h * 128, 1, lane);
}

__device__ __forceinline__ void ln_stage_gb(LAS unsigned char* lds, const float* g, const float* bb, int tid) {
    const GAS f32x4* gs = (const GAS f32x4*)g; const GAS f32x4* bs = (const GAS f32x4*)bb;
#pragma unroll
    for (int j = 0; j < 2; ++j) { ((LAS f32x4*)lds)[tid + 512 * j] = gs[tid + 512 * j]; ((LAS f32x4*)(lds + DM * 4))[tid + 512 * j] = bs[tid + 512 * j]; }
    __syncthreads();
}
__device__ __forceinline__ void unpack8(const v4u a, f32x4& lo, f32x4& hi) { lo = (f32x4){bflo(a.x), bfhi(a.x), bflo(a.y), bfhi(a.y)}; hi = (f32x4){bflo(a.z), bfhi(a.z), bflo(a.w), bfhi(a.w)}; }
template <bool HBF>
__device__ __forceinline__ void ln_row(const LAS unsigned char* lds, const void* hin, const bf16* add, float* of, bf16* ob, bf16* op4, bf16* op16, int lane) {
    const GAS v4u* ar = (const GAS v4u*)add + lane;
    f32x4 v[16]; float s = 0.f;
    if constexpr (HBF) { const GAS v4u* hr = (const GAS v4u*)hin + lane;
        v4u ha[8], aa[8];
#pragma unroll
        for (int j = 0; j < 8; ++j) { ha[j] = hr[64 * j]; aa[j] = ar[64 * j]; }
#pragma unroll
        for (int j = 0; j < 8; ++j) { f32x4 h0, h1, a0, a1; unpack8(ha[j], h0, h1); unpack8(aa[j], a0, a1); v[2 * j] = h0 * ALPHA + a0; v[2 * j + 1] = h1 * ALPHA + a1; }
    } else { const GAS f32x4* hr = (const GAS f32x4*)hin + 2 * lane;
        v4u aa[8];
#pragma unroll
        for (int j = 0; j < 8; ++j) { v[2 * j] = hr[128 * j]; v[2 * j + 1] = hr[128 * j + 1]; aa[j] = ar[64 * j]; }
#pragma unroll
        for (int j = 0; j < 8; ++j) { f32x4 a0, a1; unpack8(aa[j], a0, a1); v[2 * j] = v[2 * j] * ALPHA + a0; v[2 * j + 1] = v[2 * j + 1] * ALPHA + a1; }
    }
#pragma unroll
    for (int j = 0; j < 16; ++j) s += (v[j].x + v[j].y) + (v[j].z + v[j].w);
    const float mean = wave_sum(s) * (1.f / DM); float s2 = 0.f;
#pragma unroll
    for (int j = 0; j < 16; ++j) { v[j] = v[j] - mean; s2 += (v[j].x * v[j].x + v[j].y * v[j].y) + (v[j].z * v[j].z + v[j].w * v[j].w); }
    const float rstd = 1.f / sqrtf(wave_sum(s2) * (1.f / DM) + EPS);
    const LAS f32x4* gr = (const LAS f32x4*)lds + 2 * lane; const LAS f32x4* br = (const LAS f32x4*)(lds + DM * 4) + 2 * lane;
#pragma unroll
    for (int j = 0; j < 8; ++j) { const f32x4 o0 = v[2 * j] * rstd * gr[128 * j] + br[128 * j], o1 = v[2 * j + 1] * rstd * gr[128 * j + 1] + br[128 * j + 1];
        if (of) { ((GAS f32x4*)of + 2 * lane)[128 * j] = o0; ((GAS f32x4*)of + 2 * lane)[128 * j + 1] = o1; }
        v4u w; w.x = pk2(o0.x, o0.y); w.y = pk2(o0.z, o0.w); w.z = pk2(o1.x, o1.y); w.w = pk2(o1.z, o1.w);
        if (ob) ((GAS v4u*)ob + lane)[64 * j] = w;
        if (op4) { ((GAS v4u*)op4 + lane)[64 * j] = w; ((GAS v4u*)op16 + lane)[64 * j] = w; }
        if (j & 1) __builtin_amdgcn_sched_barrier(0); }
}

constexpr int WPRIV = 17920;
static_assert(WPRIV >= DL_WAVE && WPRIV >= HP_WAVE && WPRIV >= RU_WAVE && 8 * WPRIV <= LDSCTL_OFF, "wave-private LDS stride");
__global__ void __launch_bounds__(NWAVES * 64, 2) mk_fwd(Args args) {
    extern __shared__ __attribute__((aligned(16))) unsigned char lds[];
    Frame F;
    F.lds = (LAS unsigned char*)lds;
    volatile LAS unsigned* MISC = (volatile LAS unsigned*)(F.lds + MISC_OFF);
    F.tid = threadIdx.x; F.lane = F.tid & 63; F.wave = __builtin_amdgcn_readfirstlane(F.tid >> 6);
    F.G = gridDim.x; { const int bx = blockIdx.x; F.vcu = (F.G % 8 == 0) ? (bx % 8) * (F.G / 8) + bx / 8 : bx; }
    F.ws = args.ws; F.ctl = (gu32*)(args.ws + WS_CTL);
    unsigned char* ws = args.ws;
    for (int u = F.tid; u < (LDS_BYTES - LDSCTL_OFF) / 4; u += NWAVES * 64) ((LAS unsigned*)(F.lds + LDSCTL_OFF))[u] = 0u;
    __syncthreads();
#if MK_PER_PHASE
    XcdBarrier bar; bar.bar = nullptr; bar.x = 0; bar.st = nullptr;
#define GRID_BAR() do { } while (0)
#else
    XcdBarrier bar = xcd_barrier_post((unsigned*)(F.ctl + CW_BAR), MISC + 8);
#define GRID_BAR() do { xcd_barrier(bar); if (DUP_BAR) xcd_barrier(bar); } while (0)
#endif
    const int lo = args.ph_lo, hi = args.ph_hi;
#define IN(k) (lo <= (k) && (k) < hi)
#define SEAM(k) do { if (IN(k) && IN((k) + 1)) GRID_BAR(); } while (0)
    const int NGW = F.G * NWAVES;
#define PHASE_IDS() int tid = threadIdx.x; asm volatile("" : "+v"(tid)); const int lane = tid & 63; const int gw = F.vcu * NWAVES + __builtin_amdgcn_readfirstlane(tid >> 6); (void)lane; (void)gw

#define AB   ((bf16*)(ws + WS_AB))
#define XP4  ((bf16*)(ws + WS_XP4))
#define XP16 ((bf16*)(ws + WS_XP16))
#define NAT  ((bf16*)(ws + WS_NAT))
#define VT   ((bf16*)(ws + WS_VT))
#define HQT  ((bf16*)(ws + WS_HQT))
#define HKT  ((bf16*)(ws + WS_HKT))
#define HQC  ((bf16*)(ws + WS_HQC))
#define HKH  ((bf16*)(ws + WS_HKH))
#define DEC  ((float*)(ws + WS_DEC))
#define UR   ((float*)(ws + WS_UR))
#define UH   ((float*)(ws + WS_UH))
#define SR   ((bf16*)(ws + WS_SR))
#define SH   ((bf16*)(ws + WS_SH))
#define YB   ((bf16*)(ws + WS_Y))
#define MRG  ((bf16*)(ws + WS_MRG))
#define MRGB ((bf16*)(ws + WS_MRGB))
#define H1   ((float*)(ws + WS_H1))
#define H2   ((float*)(ws + WS_H2))
#define EDG  ((float*)(ws + WS_UUP))
#define ACT  ((bf16*)(ws + WS_ACT))

    if (PHEN(0) && IN(0)) { for (int rep = 0; rep < NREP(0); ++rep) { p0_prologue(F); if (rep + 1 < NREP(0)) GRID_BAR(); } }
    SEAM(0);

    for (int l = 0; l < DEPTH; ++l) {
        const int pb = 1 + 12 * l;


        if (PHEN(1) && IN(pb + 0)) for (int rep = 0; rep < NREP(1); ++rep) { PHASE_IDS(); if (rep) GRID_BAR();
            EpiInProj E{NAT, VT, (bf16*)(ws + WS_DAK), (bf16*)(ws + WS_DLK)};
            { InProjSched<0> S{F.G, (int)blockIdx.x, AB, (const bf16*)(ws + WS_WIN + l * WIN_L)}; pg8::gemm_phase<EpiInProj, InProjSched<0>, true, true, 1>(F.lds, DM, S, E, tid); }
            { InProjSched<1> S{F.G, (int)blockIdx.x, AB, (const bf16*)(ws + WS_WIN + l * WIN_L)}; pg8::gemm_phase<EpiInProj, InProjSched<1>, true, true, 4>(F.lds, DM, S, E, tid); }
            { InProjSched<2> S{F.G, (int)blockIdx.x, AB, (const bf16*)(ws + WS_WIN + l * WIN_L)}; pg8::gemm_phase<EpiInProj, InProjSched<2>, true, true, 16>(F.lds, DM, S, E, tid); }
        }
        SEAM(pb + 0);

        if (PHEN(2) && IN(pb + 1)) for (int rep = 0; rep < NREP(2); ++rep) { PHASE_IDS(); if (rep) GRID_BAR();
            for (int it = gw; it < 16 * 128; it += NGW) hgpu_unit(F.lds + (tid >> 6) * WPRIV, NAT, VT, INP(4), l, HQT, HKT, HQC, DEC, UH, it >> 7, it & 127, lane);
            for (int it = gw; it < 16 * 64; it += NGW) retu_unit(F.lds + (tid >> 6) * WPRIV, NAT, VT, UR, it >> 6, it & 63, lane);
            {
                float mq = 0.f, mk = 0.f;
                for (int m0 = gw; m0 < M; m0 += 4 * NGW) {
                    v4u a0[4], a1[4], b0[4], b1[4];
#pragma unroll
                    for (int i = 0; i < 4; ++i) { const int m = (m0 + i * NGW) < M ? m0 + i * NGW : m0;
                        const bf16* qr = NAT + (size_t)m * NIN + C_DAQ + 16 * lane;
                        const bf16* kr = (const bf16*)(ws + WS_DAK) + ((size_t)((m / SEQ) * 8 + (lane >> 3)) * SEQ + (m % SEQ)) * 128 + 16 * (lane & 7);
                        a0[i] = *(const v4u*)qr; a1[i] = *(const v4u*)(qr + 8); b0[i] = *(const v4u*)kr; b1[i] = *(const v4u*)(kr + 8); }
#pragma unroll
                    for (int i = 0; i < 4; ++i) { float sq = 0.f, sk = 0.f;
#pragma unroll
                        for (int e = 0; e < 4; ++e) { sq += bflo(a0[i][e]) * bflo(a0[i][e]) + bfhi(a0[i][e]) * bfhi(a0[i][e]) + bflo(a1[i][e]) * bflo(a1[i][e]) + bfhi(a1[i][e]) * bfhi(a1[i][e]);
                                                      sk += bflo(b0[i][e]) * bflo(b0[i][e]) + bfhi(b0[i][e]) * bfhi(b0[i][e]) + bflo(b1[i][e]) * bflo(b1[i][e]) + bfhi(b1[i][e]) * bfhi(b1[i][e]); }
                        sq += __shfl_xor(sq, 1); sq += __shfl_xor(sq, 2); sk += __shfl_xor(sk, 1); sk += __shfl_xor(sk, 2);
                        mq = fmaxf(mq, sq); mk = fmaxf(mk, sk); }
                }
                if ((lane & 3) == 0) { gu32* nb = F.ctl + CW_NRM + 64 * l + (lane >> 3) * 4 + ((lane >> 2) & 1);
                    __hip_atomic_fetch_max(nb, __float_as_uint(mq), RLX_AGENT); __hip_atomic_fetch_max(nb + 2, __float_as_uint(mk), RLX_AGENT); }
            }
        }
        SEAM(pb + 1);

        if ((PHEN(3) || PHEN(4)) && IN(pb + 2)) for (int rep = 0; rep < NREP(3); ++rep) { PHASE_IDS(); if (rep) GRID_BAR();
            for (int e = F.vcu * 512 + tid; e < 16 * 8192; e += F.G * 512) {
                const int bh = e >> 13, h = bh & 7; const float cd = __builtin_amdgcn_exp2f(128.f * ret_log2g(h));
                const float* up = UR + (size_t)bh * 64 * 8192 + (e & 8191); bf16* sp = SR + (size_t)bh * 64 * 8192 + (e & 8191);
                float s = 0.f;
                for (int n0 = 0; n0 < 64; n0 += 32) { float uv[32];
#pragma unroll
                    for (int k = 0; k < 32; ++k) uv[k] = up[(size_t)(n0 + k) * 8192];
#pragma unroll
                    for (int k = 0; k < 32; ++k) { sp[(size_t)(n0 + k) * 8192] = (bf16)f2bf(s); s = cd * s + uv[k]; } }
            }
            {
                const int stride = F.G * 512;
                for (int e = F.vcu * 512 + tid; e < 16 * 16384; e += 2 * stride) {
                    const bool two = (e + stride) < 16 * 16384; const int e1 = two ? e + stride : e;
                    const int bh0 = e >> 14, bh1 = e1 >> 14;
                    const float* up0 = UH + (size_t)bh0 * 128 * 16384 + (e & 16383); bf16* sp0 = SH + (size_t)bh0 * 128 * 16384 + (e & 16383);
                    const float* up1 = UH + (size_t)bh1 * 128 * 16384 + (e1 & 16383); bf16* sp1 = SH + (size_t)bh1 * 128 * 16384 + (e1 & 16383);
                    const float* dp0 = DEC + (size_t)(bh0 >> 3) * 128 * 1024 + (bh0 & 7) * 128 + (e & 127);
                    const float* dp1 = DEC + (size_t)(bh1 >> 3) * 128 * 1024 + (bh1 & 7) * 128 + (e1 & 127);
                    float s0 = 0.f, s1 = 0.f;
                    for (int n0 = 0; n0 < 128; n0 += 32) { float u0[32], d0[32], u1[32], d1[32];
#pragma unroll
                        for (int k = 0; k < 32; ++k) { u0[k] = up0[(size_t)(n0 + k) * 16384]; d0[k] = dp0[(size_t)(n0 + k) * 1024]; u1[k] = up1[(size_t)(n0 + k) * 16384]; d1[k] = dp1[(size_t)(n0 + k) * 1024]; }
#pragma unroll
                        for (int k = 0; k < 32; ++k) { sp0[(size_t)(n0 + k) * 16384] = (bf16)f2bf(s0); s0 = d0[k] * s0 + u0[k];
                            if (two) sp1[(size_t)(n0 + k) * 16384] = (bf16)f2bf(s1); s1 = d1[k] * s1 + u1[k]; } }
                }
            }
        }
        SEAM(pb + 2); if (IN(pb + 2) && !IN(pb + 3) && IN(pb + 4)) GRID_BAR();

        if (PHEN(5) && IN(pb + 4)) for (int rep = 0; rep < NREP(5); ++rep) { PHASE_IDS(); if (rep) GRID_BAR();
            gu32* wq = F.ctl + CW_WQ + 64 * 4 * (l + 2 * rep);
            {
                const float* lv = INP(2) + l * 256;
                const float p01 = wave_sum(lv[lane] * lv[64 + lane]), p23 = wave_sum(lv[128 + lane] * lv[192 + lane]);
                const float lam_init = 0.8f - 0.6f * __expf(-0.3f * (float)l);
                const float lam = __expf(p01) - __expf(p23) + lam_init;
                const float* ng = INP(3) + l * 128;
                volatile LAS unsigned* wqw = (volatile LAS unsigned*)(F.lds + MISC_OFF);
                for (int rp = 0; rp < NMIX(0); ++rp)
                for (;;) {
                    if (tid == 0) wqw[0] = __hip_atomic_fetch_add(wq + 2048 * rp, 1u, RLX_AGENT);
                    __syncthreads();
                    const int it = (int)wqw[0];
                    if (it >= 16 * 32) break;
                    diff_block(F.lds, (volatile LAS unsigned*)(F.lds + MISC_OFF + 64), (const unsigned*)(F.ctl + CW_NRM + 64 * l), NAT, (const bf16*)(ws + WS_DAK), VT, YB, ng, lam, 1.f - lam_init, (it & 15) >> 3, it & 7, 31 - (it >> 4), tid);
                }
            }
            __syncthreads();
            for (int rp = 0; rp < NMIX(1); ++rp)
            for (;;) { const int it = wq_pull(wq + 64 + 2048 * rp, lane); if (it >= 16 * 256) break;
                dil_unit(F.lds + (tid >> 6) * WPRIV, NAT, (const bf16*)(ws + WS_DLK), VT, YB + (size_t)3 * M * 1024, it >> 11, (it >> 8) & 7, (it >> 4) & 15, it & 15, lane); }
            for (int rp = 0; rp < NMIX(2); ++rp)
            for (;;) { const int it = wq_pull(wq + 128 + 2048 * rp, lane); if (it >= 16 * 64 * 4) break;
                ret_out_unit(F.lds + (tid >> 6) * WPRIV, NAT, VT, SR, YB + (size_t)1 * M * 1024, it >> 8, (it >> 2) & 63, it & 3, lane); }
            {   const float* ng = INP(5) + l * 128;
                for (int rp = 0; rp < NMIX(3); ++rp)
                for (;;) { const int it = wq_pull(wq + 192 + 2048 * rp, lane); if (it >= 16 * 128 * 2) break;
                    hg_out_unit(F.lds + (tid >> 6) * WPRIV, NAT, VT, HQT, HKT, HQC, SH, ng, YB + (size_t)2 * M * 1024, it >> 8, (it >> 1) & 127, it & 1, lane); } }
        }
        SEAM(pb + 4);

        if (PHEN(6) && IN(pb + 5)) for (int rep = 0; rep < NREP(6); ++rep) { PHASE_IDS(); if (rep) GRID_BAR();
            MergeSched S{F.G, (int)blockIdx.x, YB, (const bf16*)(ws + WS_WBR + l * WBR_L)};
            EpiMerge E{NAT, MRGB};
            pg8::gemm_phase<EpiMerge, MergeSched, true, true>(F.lds, 1024, S, E, tid);
        }
        SEAM(pb + 5);

        if (PHEN(7) && IN(pb + 6)) for (int rep = 0; rep < NREP(7); ++rep) { PHASE_IDS(); if (rep) GRID_BAR();
            PlainSched S{F.G, (int)blockIdx.x, 16, DM, MRGB, (const bf16*)(ws + WS_WO + l * WO_L)};
            EpiBf16 E{MRG, DM};
            pg8::gemm_phase<EpiBf16, PlainSched, true, true>(F.lds, DM, S, E, tid);
        }
        SEAM(pb + 6);

        if (PHEN(8) && IN(pb + 7)) for (int rep = 0; rep < NREP(8); ++rep) { PHASE_IDS(); if (rep) GRID_BAR();
            const float* g = INP(8) + l * DM; const float* bb = INP(9) + l * DM;
            ln_stage_gb(F.lds, g, bb, tid);
            if (l == 0) { const float* hin = INP(0);
                for (int m = gw; m < M; m += NGW) ln_row<false>(F.lds, hin + (size_t)m * DM, MRG + (size_t)m * DM, nullptr, AB + (size_t)m * DM, nullptr, nullptr, lane);
            } else {
                for (int m = gw; m < M; m += NGW) ln_row<true>(F.lds, AB + (size_t)m * DM, MRG + (size_t)m * DM, nullptr, AB + (size_t)m * DM, nullptr, nullptr, lane); }
        }
        SEAM(pb + 7);

        if (PHEN(9) && IN(pb + 8)) for (int rep = 0; rep < NREP(9); ++rep) { PHASE_IDS(); if (rep) GRID_BAR();
            PlainSched S{F.G, (int)blockIdx.x, NUP / 256, DM, AB, (const bf16*)(ws + WS_WUP + l * WUP_L)};
            EpiAct E{ACT, INP(11) + (size_t)l * 3 * DFF, INP(12) + (size_t)l * DFF, EDG, EDG + (size_t)256 * DFF, EDG + (size_t)512 * DFF};
            pg8::gemm_phase<EpiAct, PlainSched, true, true>(F.lds, DM, S, E, tid);
        }
        SEAM(pb + 8);

        if (PHEN(10) && IN(pb + 9)) for (int rep = 0; rep < NREP(10); ++rep) { PHASE_IDS(); if (rep) GRID_BAR();
            const float* cw = INP(11) + (size_t)l * 3 * DFF; const float* cb = INP(12) + (size_t)l * DFF;
            const float* EA = EDG; const float* EG = EDG + (size_t)256 * DFF; const float* EL = EDG + (size_t)512 * DFF;
            constexpr int NC4 = DFF / 4;
            for (int it = F.vcu * 512 + tid; it < 128 * NC4; it += F.G * 512) {
                const int seg = it / NC4, c = 4 * (it % NC4); const bool first = (seg % (SEQ / 128)) == 0;
                const f32x4 z = (f32x4){0.f, 0.f, 0.f, 0.f};
                const f32x4 am2 = first ? z : *(const f32x4*)(EL + (size_t)(seg * 2 - 2) * DFF + c), am1 = first ? z : *(const f32x4*)(EL + (size_t)(seg * 2 - 1) * DFF + c);
                const f32x4 a0 = *(const f32x4*)(EA + (size_t)(seg * 2) * DFF + c), a1 = *(const f32x4*)(EA + (size_t)(seg * 2 + 1) * DFF + c);
                const f32x4 g0 = *(const f32x4*)(EG + (size_t)(seg * 2) * DFF + c), g1 = *(const f32x4*)(EG + (size_t)(seg * 2 + 1) * DFF + c);
                const f32x4 w0 = *(const f32x4*)(cw + c), w1 = *(const f32x4*)(cw + DFF + c), w2 = *(const f32x4*)(cw + 2 * DFF + c), bc = *(const f32x4*)(cb + c);
                const f32x4 c0v = bc + w0 * am2 + w1 * am1 + w2 * a0, c1v = bc + w0 * am1 + w1 * a0 + w2 * a1;
                v2u o0, o1;
                o0.x = pk2(gelu1(c0v.x) * g0.x, gelu1(c0v.y) * g0.y); o0.y = pk2(gelu1(c0v.z) * g0.z, gelu1(c0v.w) * g0.w);
                o1.x = pk2(gelu1(c1v.x) * g1.x, gelu1(c1v.y) * g1.y); o1.y = pk2(gelu1(c1v.z) * g1.z, gelu1(c1v.w) * g1.w);
                *(v2u*)(ACT + (size_t)(seg * 128) * DFF + c) = o0; *(v2u*)(ACT + (size_t)(seg * 128 + 1) * DFF + c) = o1;
            }
        }
        SEAM(pb + 9);

        if (PHEN(11) && IN(pb + 10)) for (int rep = 0; rep < NREP(11); ++rep) { PHASE_IDS(); if (rep) GRID_BAR();
            PlainSched S{F.G, (int)blockIdx.x, 16, DFF, ACT, (const bf16*)(ws + WS_WDN + l * WDN_L)};
            EpiBf16 E{MRG, DM};
            pg8::gemm_phase<EpiBf16, PlainSched, true, true>(F.lds, DFF, S, E, tid);
        }
        SEAM(pb + 10);

        if (PHEN(12) && IN(pb + 11)) for (int rep = 0; rep < NREP(12); ++rep) { PHASE_IDS(); if (rep) GRID_BAR();
            const float* g = INP(14) + l * DM; const float* bb = INP(15) + l * DM;
            const bool lastl = (l == DEPTH - 1); float* hout = (float*)INP(16);
            ln_stage_gb(F.lds, g, bb, tid);
            for (int m = gw; m < M; m += NGW)
                ln_row<true>(F.lds, AB + (size_t)m * DM, MRG + (size_t)m * DM, lastl ? hout + (size_t)m * DM : nullptr, lastl ? nullptr : AB + (size_t)m * DM, nullptr, nullptr, lane);
        }
        if (l + 1 < DEPTH) SEAM(pb + 11);
    }
#undef IN
#undef SEAM
}

constexpr int N_PHASES = 1 + 12 * DEPTH;
extern "C" void kernel_launch(void* const* d_in, const int* in_sizes, int n_in, void* d_out, int out_size, void* d_ws, size_t ws_size, hipStream_t stream) {
    static int grid = 0;
    if (grid == 0) {
        if (n_in != 16 || in_sizes[0] != M * DM || out_size != M * DM || ws_size < WS_END) { fprintf(stderr, "kernel_launch: unexpected shapes / workspace (n_in %d, ws %zu < %zu)\n", n_in, ws_size, (size_t)WS_END); grid = -1; return; }
        int dev = 0, cus = 0, per_cu = 0;
        if (hipGetDevice(&dev) != hipSuccess || hipDeviceGetAttribute(&cus, hipDeviceAttributeMultiprocessorCount, dev) != hipSuccess) { grid = -1; return; }
        if (hipFuncSetAttribute((const void*)mk_fwd, hipFuncAttributeMaxDynamicSharedMemorySize, LDS_BYTES) != hipSuccess) { fprintf(stderr, "kernel_launch: hipFuncSetAttribute failed\n"); grid = -1; return; }
        if (hipOccupancyMaxActiveBlocksPerMultiprocessor(&per_cu, (const void*)mk_fwd, NWAVES * 64, LDS_BYTES) != hipSuccess || per_cu < 1)
            fprintf(stderr, "kernel_launch: note: occupancy query reports %d workgroups per CU\n", per_cu);
        (void)hipGetLastError();
        grid = cus;
    }
    if (grid < 0) return;
    if (hipMemsetAsync((char*)d_ws + WS_CTL, 0, CTL_ZERO_BYTES, stream) != hipSuccess) { fprintf(stderr, "kernel_launch: memset failed\n"); return; }
    Args a{};
    for (int i = 0; i < 16; ++i) a.in[i] = (const float*)d_in[i];
    a.out = (float*)d_out; a.ws = (unsigned char*)d_ws;
#if MK_PER_PHASE
    for (int p = 0; p < N_PHASES; ++p) { a.ph_lo = p; a.ph_hi = p + 1; hipLaunchKernelGGL(mk_fwd, dim3(grid), dim3(NWAVES * 64), LDS_BYTES, stream, a); }
#else
    a.ph_lo = 0; a.ph_hi = N_PHASES;
    hipLaunchKernelGGL(mk_fwd, dim3(grid), dim3(NWAVES * 64), LDS_BYTES, stream, a);
#endif
    const hipError_t le = hipPeekAtLastError();
    if (le != hipSuccess) fprintf(stderr, "kernel_launch: launch failed: %s\n", hipGetErrorName(le));
}
```

```cpp
#include <hip/hip_runtime.h>
#include <cstdio>
#include <cstdint>

#ifndef MK_PER_PHASE
#define MK_PER_PHASE 0
#endif
#ifndef PH_MASK
#define PH_MASK 0x1fff
#endif
#define PHEN(k) (((PH_MASK) >> (k)) & 1)
#ifndef REP_MASK
#define REP_MASK 0
#endif
#define NREP(k) ((((REP_MASK) >> (k)) & 1) ? 2 : 1)
#ifndef MIX_REP
#define MIX_REP 0
#endif
#define NMIX(k) ((((MIX_REP) >> (k)) & 1) ? 2 : 1)
#ifndef DUP_BAR
#define DUP_BAR 0
#endif
#ifndef DUP_EPI
#define DUP_EPI 0
#endif

namespace pg8 {
#define PG8_LAS __attribute__((address_space(3)))
typedef unsigned short bf16_t;
typedef short bf16x8 __attribute__((ext_vector_type(8)));
typedef float f32x4 __attribute__((ext_vector_type(4)));
typedef unsigned u32x4 __attribute__((ext_vector_type(4)));
typedef unsigned u32x2 __attribute__((ext_vector_type(2)));
typedef float f32x2 __attribute__((ext_vector_type(2)));
constexpr int BM = 256, BK = 64, HALF = 128, HTB = HALF * BK * 2, STAGE_BYTES = 8 * HTB, NXCD = 8, WGM = 4;

__host__ __device__ __forceinline__ int lds_byte(int r, int c) { const int st = (r >> 4) * 2 + (c >> 5), rr = r & 15, cc = c & 31, ob = rr * 64 + cc * 2; return st * 1024 + (ob ^ (((ob >> 9) & 1) << 5)); }
__host__ __device__ __forceinline__ void stage_rc(int b, int& R, int& C) { const int st = b / 1024, sb = b % 1024, swz = sb ^ (((sb >> 9) & 1) << 5); R = (st >> 1) * 16 + swz / 64; C = (st & 1) * 32 + (swz % 64) / 2; }
__host__ __device__ __forceinline__ int perm32(int rho) { const int n = rho >> 4, i = rho & 15; return 8 * (i >> 2) + 4 * n + (i & 3); }

struct Unit { int pm, pn, kind; };

__device__ __forceinline__ void tile_map(int wgid, int nM, int nN, int& pm, int& pn) {
    const int nwg = nM * nN;
    { const int q = nwg / NXCD, r = nwg % NXCD, xcd = wgid % NXCD, off = wgid / NXCD; wgid = (xcd < r ? xcd * (q + 1) : r * (q + 1) + (xcd - r) * q) + off; }
    const int nig = WGM * nN, gid = wgid / nig, fm = gid * WGM, gsz = (nM - fm) < WGM ? (nM - fm) : WGM;
    pm = fm + ((wgid % nig) % gsz); pn = (wgid % nig) / gsz;
}

__device__ __forceinline__ unsigned cvt_pk_bf16(float lo, float hi) { unsigned r; asm volatile("v_cvt_pk_bf16_f32 %0, %1, %2" : "=v"(r) : "v"(lo), "v"(hi)); return r; }

template <class Epi, class Sched, bool ALIGN_EPI, bool SP2, int BSTRIDE = 1>
__device__ __forceinline__ void gemm_phase(PG8_LAS unsigned char* lds, const int K, const Sched& S, const Epi& E, const int tid) {
    constexpr int bstride = BSTRIDE;
    const int wid = __builtin_amdgcn_readfirstlane(tid >> 6), lane = tid & 63, wr = wid >> 2, wc = wid & 3, fr = lane & 15, fq = lane >> 4;
    const int nt = K / BK;
    unsigned voffA[2], voffB[2];
#pragma unroll
    for (int i = 0; i < 2; ++i) { int R, C; stage_rc(tid * 16 + i * 8192, R, C); const int Rb = Epi::PERM ? ((R & ~31) + perm32(R & 31)) : R;
        const int Ra = Epi::APERM ? (128 * (R >> 6) + 8 * (R & 15) + ((R >> 4) & 3)) : R;
        voffA[i] = (unsigned)(Ra * K + C) * 2u; voffB[i] = (unsigned)(Rb * bstride * K + C) * 2u; }
    const size_t kstep = (size_t)(BK * 2);
    const size_t hstepB = (size_t)HALF * K * 2 * bstride, hstepA = Epi::APERM ? (size_t)4 * K * 2 : (size_t)HALF * K * 2;
    const unsigned ldsw = (unsigned)wid * 1024u;
    const int aoff = lds_byte(wr * 64 + fr, fq * 8), boff = lds_byte(wc * 32 + fr, fq * 8);
#define PG8_SA(b, h) (((b) * 2 + (h)) * HTB)
#define PG8_SB(b, h) ((4 + (b) * 2 + (h)) * HTB)
#define PG8_STAGE(bufoff, gbase, voff) do { _Pragma("unroll") for (int _i = 0; _i < 2; ++_i) \
        __builtin_amdgcn_global_load_lds((const unsigned*)((const char*)(gbase) + (voff)[_i]), (PG8_LAS unsigned*)(lds + (bufoff) + ldsw + _i * 8192), 16, 0, 0); } while (0)
#define PG8_LDA(dst, b, h) do { _Pragma("unroll") for (int m = 0; m < 4; ++m) _Pragma("unroll") for (int k = 0; k < 2; ++k) dst[m][k] = *(const PG8_LAS bf16x8*)(lds + PG8_SA(b, h) + aoff + m * 2048 + k * 1024); } while (0)
#define PG8_LDB(dst, b, h) do { _Pragma("unroll") for (int n = 0; n < 2; ++n) _Pragma("unroll") for (int k = 0; k < 2; ++k) dst[n][k] = *(const PG8_LAS bf16x8*)(lds + PG8_SB(b, h) + boff + n * 2048 + k * 1024); } while (0)
#define PG8_MMA(ai, bj, At, Bt) do { __builtin_amdgcn_s_setprio(1); _Pragma("unroll") for (int m = 0; m < 4; ++m) _Pragma("unroll") for (int n = 0; n < 2; ++n) _Pragma("unroll") for (int k = 0; k < 2; ++k) \
        acc[ai][bj][m][n] = __builtin_amdgcn_mfma_f32_16x16x32_bf16(Bt[n][k], At[m][k], acc[ai][bj][m][n], 0, 0, 0); __builtin_amdgcn_s_setprio(0); } while (0)
#define PG8_WAIT_V(n) asm volatile("s_waitcnt vmcnt(" #n ")" ::: "memory")
#define PG8_WAIT_L(n) asm volatile("s_waitcnt lgkmcnt(" #n ")" ::: "memory")
#define PG8_BAR __builtin_amdgcn_s_barrier()
#define PG8_SCHED __builtin_amdgcn_sched_barrier(0)
    Unit cur, nxt; int ui = 0;
    if (!S.next(0, cur)) return;
    f32x4 acc[2][2][4][2];
#pragma unroll
    for (int a = 0; a < 2; ++a)
#pragma unroll
        for (int b = 0; b < 2; ++b)
#pragma unroll
            for (int m = 0; m < 4; ++m)
#pragma unroll
                for (int n = 0; n < 2; ++n) acc[a][b][m][n] = (f32x4){0.f, 0.f, 0.f, 0.f};
    bf16x8 At[4][2], B0[2][2], B1[2][2];
    const char* cA; const char* cB; S.ptrs(cur, cA, cB);
    if constexpr (SP2) {
        PG8_STAGE(PG8_SB(0, 0), cB, voffB); PG8_STAGE(PG8_SB(0, 1), cB + hstepB, voffB); PG8_STAGE(PG8_SA(0, 0), cA, voffA); PG8_STAGE(PG8_SA(0, 1), cA + hstepA, voffA);
        if (wr == 1) PG8_BAR;
        PG8_WAIT_V(2); PG8_BAR;
        PG8_STAGE(PG8_SB(1, 0), cB + kstep, voffB); PG8_STAGE(PG8_SA(1, 0), cA + kstep, voffA); PG8_STAGE(PG8_SB(1, 1), cB + hstepB + kstep, voffB);
        PG8_WAIT_V(6); PG8_BAR;
    } else {
        PG8_STAGE(PG8_SB(0, 0), cB, voffB); PG8_STAGE(PG8_SA(0, 0), cA, voffA); PG8_STAGE(PG8_SB(0, 1), cB + hstepB, voffB); PG8_STAGE(PG8_SA(0, 1), cA + hstepA, voffA);
        if (wr == 1) PG8_BAR;
        PG8_WAIT_V(4); PG8_BAR;
        PG8_STAGE(PG8_SB(1, 0), cB + kstep, voffB); PG8_STAGE(PG8_SA(1, 0), cA + kstep, voffA); PG8_STAGE(PG8_SB(1, 1), cB + hstepB + kstep, voffB);
        PG8_WAIT_V(6); PG8_BAR;
    }
    for (;;) {
        const bool has_next = S.next(ui + 1, nxt);
        const char* nA = cA; const char* nB = cB; if (has_next) S.ptrs(nxt, nA, nB);
        for (int t = 0; t < nt; t += 2) {
            const bool last = (t == nt - 2);
            const char* a1 = cA + (size_t)(t + 1) * kstep;
            const char* a2 = last ? nA : cA + (size_t)(t + 2) * kstep; const char* b2 = last ? nB : cB + (size_t)(t + 2) * kstep;
            const char* a3 = a2 + kstep; const char* b3 = b2 + kstep;
            if constexpr (SP2) {
            PG8_LDB(B0, 0, 0); PG8_LDB(B1, 0, 1); PG8_SCHED; PG8_LDA(At, 0, 0); PG8_STAGE(PG8_SA(1, 1), a1 + hstepA, voffA);
            PG8_WAIT_V(8); PG8_WAIT_L(0); PG8_BAR; PG8_MMA(0, 0, At, B0); PG8_MMA(0, 1, At, B1); PG8_BAR; PG8_SCHED;
            PG8_LDA(At, 0, 1); PG8_STAGE(PG8_SB(0, 0), b2, voffB); PG8_STAGE(PG8_SB(0, 1), b2 + hstepB, voffB); PG8_STAGE(PG8_SA(0, 0), a2, voffA);
            PG8_WAIT_V(8); PG8_WAIT_L(0); PG8_BAR; PG8_MMA(1, 0, At, B0); PG8_MMA(1, 1, At, B1); PG8_BAR; PG8_SCHED;
            PG8_LDB(B0, 1, 0); PG8_LDB(B1, 1, 1); PG8_SCHED; PG8_LDA(At, 1, 0); PG8_STAGE(PG8_SA(0, 1), a2 + hstepA, voffA);
            PG8_WAIT_V(8); PG8_WAIT_L(0); PG8_BAR; PG8_MMA(0, 0, At, B0); PG8_MMA(0, 1, At, B1); PG8_BAR; PG8_SCHED;
            PG8_LDA(At, 1, 1); PG8_STAGE(PG8_SB(1, 0), b3, voffB); PG8_STAGE(PG8_SB(1, 1), b3 + hstepB, voffB); PG8_STAGE(PG8_SA(1, 0), a3, voffA);
            PG8_WAIT_V(8); PG8_WAIT_L(0); PG8_BAR; PG8_MMA(1, 0, At, B0); PG8_MMA(1, 1, At, B1); PG8_BAR; PG8_SCHED;
            } else {
            PG8_LDB(B0, 0, 0); PG8_SCHED; PG8_LDA(At, 0, 0); PG8_STAGE(PG8_SA(1, 1), a1 + hstepA, voffA);
            PG8_WAIT_L(8); PG8_BAR; PG8_WAIT_L(0); PG8_MMA(0, 0, At, B0); PG8_BAR; PG8_SCHED;
            PG8_LDB(B1, 0, 1); PG8_STAGE(PG8_SB(0, 0), b2, voffB);
            PG8_BAR; PG8_WAIT_L(0); PG8_MMA(0, 1, At, B1); PG8_BAR;
            PG8_LDA(At, 0, 1); PG8_STAGE(PG8_SA(0, 0), a2, voffA);
            PG8_BAR; PG8_WAIT_L(0); PG8_MMA(1, 0, At, B0); PG8_BAR; PG8_SCHED;
            PG8_STAGE(PG8_SB(0, 1), b2 + hstepB, voffB);
            PG8_WAIT_V(6); PG8_BAR; PG8_MMA(1, 1, At, B1); PG8_BAR;
            PG8_LDB(B0, 1, 0); PG8_SCHED; PG8_LDA(At, 1, 0); PG8_STAGE(PG8_SA(0, 1), a2 + hstepA, voffA);
            PG8_WAIT_L(8); PG8_BAR; PG8_WAIT_L(0); PG8_MMA(0, 0, At, B0); PG8_BAR; PG8_SCHED;
            PG8_LDB(B1, 1, 1); PG8_STAGE(PG8_SB(1, 0), b3, voffB);
            PG8_BAR; PG8_WAIT_L(0); PG8_MMA(0, 1, At, B1); PG8_BAR;
            PG8_LDA(At, 1, 1); PG8_STAGE(PG8_SA(1, 0), a3, voffA);
            PG8_BAR; PG8_WAIT_L(0); PG8_MMA(1, 0, At, B0); PG8_BAR; PG8_SCHED;
            PG8_STAGE(PG8_SB(1, 1), b3 + hstepB, voffB);
            PG8_WAIT_V(6); PG8_BAR; PG8_MMA(1, 1, At, B1); PG8_BAR;
            }
        }
        if constexpr (ALIGN_EPI) { if (wr == 0) PG8_BAR; }
        {
            int t2 = threadIdx.x; asm volatile("" : "+v"(t2)); const int l2 = t2 & 63;
            E(acc, cur, wr, wc, l2 & 15, l2 >> 4);
            if constexpr (DUP_EPI && Epi::IDEMP) E(acc, cur, wr, wc, l2 & 15, l2 >> 4);
        }
        if (!has_next) break;
#pragma unroll
        for (int a = 0; a < 2; ++a)
#pragma unroll
            for (int b = 0; b < 2; ++b)
#pragma unroll
                for (int m = 0; m < 4; ++m)
#pragma unroll
                    for (int n = 0; n < 2; ++n) acc[a][b][m][n] = (f32x4){0.f, 0.f, 0.f, 0.f};
        cur = nxt; cA = nA; cB = nB; ++ui;
        if constexpr (ALIGN_EPI) { if (wr == 1) PG8_BAR; }
    }
    PG8_WAIT_V(0);
    if constexpr (!ALIGN_EPI) { if (wr == 0) PG8_BAR; }
    PG8_BAR;
#undef PG8_SA
#undef PG8_SB
#undef PG8_STAGE
#undef PG8_LDA
#undef PG8_LDB
#undef PG8_MMA
#undef PG8_WAIT_V
#undef PG8_WAIT_L
#undef PG8_BAR
#undef PG8_SCHED
}
}

constexpr int NWAVES = 8;
constexpr int BATCH = 2, SEQ = 8192, DM = 4096, M = BATCH * SEQ, NIN = 35840, DFF = 11008, NUP = 2 * DFF, DEPTH = 2;
constexpr float EPS = 1e-5f, LOG2E = 1.4426950408889634f;
constexpr float ALPHA = 1.4142135623730951f;
constexpr int C_DAQ = 0, C_DAK = 1024, C_DAV = 2048, C_RTQ = 3072, C_RTK = 3584, C_RTV = 4096, C_RTG = 5120, C_HGQ = 6144, C_HGF = 7168, C_HGI = 8192, C_HGG = 9216,
              C_DLQ = 10240, C_DLK = 13312, C_DLV = 16384, C_GATE = 19456;
constexpr int VT_DAV = 0, VT_RTV = 1024, VT_HGI = 2048, VT_DLV = 3072, VT_ROWS = 6144;
constexpr int NAT_TILES = 116, SWP_TILES = 16;
constexpr float QS_DA = 0.125f * LOG2E;
constexpr float QS_DL = 0.08838834764831845f * LOG2E;

constexpr size_t MiB = 1u << 20;
constexpr size_t WS_CTL = 0, CTL_ZERO_BYTES = 1 * MiB;
constexpr size_t WS_WIN = 16 * MiB, WIN_L = (size_t)NIN * DM * 2;
constexpr size_t WS_WBR = 576 * MiB, WBR_L = (size_t)4 * DM * 1024 * 2;
constexpr size_t WS_WO = 640 * MiB, WO_L = (size_t)DM * DM * 2;
constexpr size_t WS_WUP = 704 * MiB, WUP_L = (size_t)NUP * DM * 2;
constexpr size_t WS_WDN = 1048 * MiB, WDN_L = (size_t)DM * DFF * 2;
constexpr size_t WS_AB = 1220 * MiB, WS_XP4 = 1348 * MiB, WS_XP16 = 1476 * MiB;
constexpr size_t WS_NAT = 1604 * MiB;
constexpr size_t WS_UUP = WS_NAT, WS_ACT = WS_NAT + 688 * MiB;
constexpr size_t WS_VT = 2724 * MiB;
constexpr size_t WS_HQT = 2932 * MiB, WS_HKT = 2964 * MiB, WS_HQC = 2996 * MiB, WS_HKH = 3028 * MiB, WS_DEC = 3060 * MiB;
constexpr size_t WS_UR = 3062 * MiB, WS_UH = 3094 * MiB, WS_SR = 3222 * MiB, WS_SH = 3238 * MiB;
constexpr size_t WS_Y = 3302 * MiB;
constexpr size_t WS_MRG = 3430 * MiB, WS_MRGB = 3686 * MiB, WS_H1 = 3814 * MiB, WS_H2 = 4070 * MiB, WS_DAK = 4326 * MiB, WS_DLK = 4358 * MiB, WS_END = 4454 * MiB;
static_assert(WS_WIN + 2 * WIN_L <= WS_WBR && WS_WUP + 2 * WUP_L <= WS_WDN && WS_WDN + 2 * WDN_L <= WS_AB, "ws map");
static_assert(WS_NAT + (size_t)M * NIN * 2 <= WS_VT && WS_ACT + (size_t)M * DFF * 2 <= WS_VT && WS_UUP + (size_t)M * NUP * 2 <= WS_ACT, "ws map");
static_assert(WS_VT + (size_t)VT_ROWS * M * 2 <= WS_HQT, "ws map");
static_assert(WS_XP16 - WS_XP4 == WS_XP4 - WS_AB, "the permuted activation copies are equally spaced");
constexpr int CW_TMO = 0, CW_CODE = 1, CW_BAR = 4096, CW_WQ = 16384, CW_NRM = 20480;

constexpr int LDS_BYTES = 147456, LDSCTL_OFF = LDS_BYTES - 512, MISC_OFF = LDSCTL_OFF + 320;

#define GAS __attribute__((address_space(1)))
#define LAS __attribute__((address_space(3)))
typedef unsigned short bf16;
typedef unsigned v4u __attribute__((ext_vector_type(4)));
typedef unsigned v2u __attribute__((ext_vector_type(2)));
typedef float f32x4 __attribute__((ext_vector_type(4)));
typedef float f32x16 __attribute__((ext_vector_type(16)));
typedef short bf16x8 __attribute__((ext_vector_type(8)));
typedef short bf16x4 __attribute__((ext_vector_type(4)));
typedef GAS unsigned gu32;
#define RLX_AGENT __ATOMIC_RELAXED, __HIP_MEMORY_SCOPE_AGENT
#define LDS_WAIT() asm volatile("s_waitcnt lgkmcnt(0)" ::: "memory")
#define VM_WAIT() asm volatile("s_waitcnt vmcnt(0)" ::: "memory")
__device__ __forceinline__ unsigned f2bf(float f) { unsigned u = __builtin_bit_cast(unsigned, f); return (u + 0x7fffu + ((u >> 16) & 1u)) >> 16; }
__device__ __forceinline__ unsigned pk2(float lo, float hi) { return f2bf(lo) | (f2bf(hi) << 16); }
__device__ __forceinline__ float bflo(unsigned u) { return __uint_as_float(u << 16); }
__device__ __forceinline__ float bfhi(unsigned u) { return __uint_as_float(u & 0xffff0000u); }
__device__ __forceinline__ float bf1(bf16 b) { return __uint_as_float((unsigned)b << 16); }
__device__ __forceinline__ float fsigmoid(float x) { return __builtin_amdgcn_rcpf(1.f + __builtin_amdgcn_exp2f(-x * LOG2E)); }

#define XB_TMO      128
#define XB_XCNT(j)  (256  + 64 * (j))
#define XB_XSUB(j)  (1280 + 64 * (j))
#define XB_XGEN(j)  (2304 + 64 * (j))
#define XB_TOP      3328
#define XB_TOPGEN   3392
#define XCD_BAR_WORDS 3456
#define XB_SPIN_CAP (1u << 18)
__device__ __forceinline__ unsigned xb_ld(unsigned* p)              { return __hip_atomic_load(p, __ATOMIC_RELAXED, __HIP_MEMORY_SCOPE_AGENT); }
__device__ __forceinline__ unsigned xb_add(unsigned* p, unsigned v) { return __hip_atomic_fetch_add(p, v, __ATOMIC_RELAXED, __HIP_MEMORY_SCOPE_AGENT); }
__device__ __forceinline__ unsigned xb_xcc_id() { return (unsigned)__builtin_amdgcn_s_getreg((3 << 11) | 20) & 0xFu; }
#define XB_SPIN(cond, bar) do { unsigned _sp = 0; while (cond) { __builtin_amdgcn_s_sleep(1); \
    if ((++_sp & 255u) == 0u) { if (xb_ld(&(bar)[XB_TMO])) break; if (_sp > XB_SPIN_CAP) { atomicAdd(&(bar)[XB_TMO], 1u); break; } } } } while (0)
struct XcdBarrier { unsigned* bar; unsigned x; volatile LAS unsigned* st; };
__device__ __forceinline__ XcdBarrier xcd_barrier_post(unsigned* bar, volatile LAS unsigned* st) {
    XcdBarrier b; b.bar = bar; b.x = xb_xcc_id(); b.st = st;
    if (threadIdx.x == 0) (void)xb_add(&bar[XB_XCNT(b.x)], 1u);
    return b;
}
__device__ __forceinline__ void xcd_barrier_complete(unsigned* bar, unsigned x, unsigned& nloc, unsigned& nx) {
    const unsigned G = gridDim.x * gridDim.y * gridDim.z;
    unsigned sum, cnt, mine, sp = 0u;
    for (;;) {
        sum = 0u; cnt = 0u; mine = 0u;
#pragma unroll
        for (unsigned j = 0; j < 16; ++j) { const unsigned c = xb_ld(&bar[XB_XCNT(j)]); sum += c; cnt += (c > 0u) ? 1u : 0u; mine = (j == x) ? c : mine; }
        if (sum == G) break;
        __builtin_amdgcn_s_sleep(1);
        if ((++sp & 255u) == 0u) { if (xb_ld(&bar[XB_TMO])) break; if (sp > XB_SPIN_CAP) { atomicAdd(&bar[XB_TMO], 1u); break; } }
    }
    nloc = mine > 0u ? mine : 1u; nx = cnt > 0u ? cnt : 1u;
}
__device__ __forceinline__ void xcd_barrier(const XcdBarrier& b) {
    asm volatile("s_waitcnt vmcnt(0)" ::: "memory");
    __syncthreads();
    if (threadIdx.x == 0) {
        unsigned* bar = b.bar;
        __builtin_amdgcn_s_waitcnt(0);
        unsigned nloc = b.st[0], nx = b.st[1];
        if (nloc == 0u) { xcd_barrier_complete(bar, b.x, nloc, nx); b.st[0] = nloc; b.st[1] = nx; }
        const unsigned old = xb_add(&bar[XB_XSUB(b.x)], 1u);
        const unsigned gen = old / nloc;
        if (old + 1u == (gen + 1u) * nloc) {
            __builtin_amdgcn_fence(__ATOMIC_RELEASE, "agent");
            asm volatile("s_waitcnt vmcnt(0)" ::: "memory");
            const unsigned og = xb_add(&bar[XB_TOP], 1u);
            const unsigned tg = og / nx;
            if (og + 1u == (tg + 1u) * nx) xb_add(&bar[XB_TOPGEN], 1u);
            else XB_SPIN(xb_ld(&bar[XB_TOPGEN]) == tg, bar);
            __builtin_amdgcn_fence(__ATOMIC_ACQUIRE, "agent");
            xb_add(&bar[XB_XGEN(b.x)], 1u);
            asm volatile("s_waitcnt vmcnt(0)" ::: "memory");
        } else {
            XB_SPIN(xb_ld(&bar[XB_XGEN(b.x)]) == gen, bar);
            __builtin_amdgcn_fence(__ATOMIC_ACQUIRE, "agent");
            asm volatile("s_waitcnt vmcnt(0)" ::: "memory");
        }
    }
    __syncthreads();
}

struct Frame {
    LAS unsigned char* lds;
    gu32* ctl;
    unsigned char* ws;
    int tid, lane, wave, vcu, G;
};

__device__ __forceinline__ float wave_sum(float v) {
#pragma unroll
    for (int o = 1; o < 64; o <<= 1) v += __shfl_xor(v, o);
    return v;
}
__device__ __forceinline__ float half_sum(float v) { const auto rr = __builtin_amdgcn_permlane32_swap(__float_as_uint(v), __float_as_uint(v), false, false); return __uint_as_float(rr[0]) + __uint_as_float(rr[1]); }
__device__ __forceinline__ float half_max(float v) { const auto rr = __builtin_amdgcn_permlane32_swap(__float_as_uint(v), __float_as_uint(v), false, false); return fmaxf(__uint_as_float(rr[0]), __uint_as_float(rr[1])); }

__device__ __forceinline__ f32x16 mfma32(bf16x8 a, bf16x8 b, f32x16 c) { return __builtin_amdgcn_mfma_f32_32x32x16_bf16(a, b, c, 0, 0, 0); }
__device__ __forceinline__ bf16x8 ld8(const bf16* p) { return *(const bf16x8*)p; }
__device__ __forceinline__ bf16x8 ld44(const bf16* p) { const bf16x4 a = *(const bf16x4*)p, b = *(const bf16x4*)(p + 8); return __builtin_shufflevector(a, b, 0, 1, 2, 3, 4, 5, 6, 7); }
template <int S> __device__ __forceinline__ bf16x8 pack8(const f32x16& p) {
    v4u w; w.x = pg8::cvt_pk_bf16(p[8 * S + 0], p[8 * S + 1]); w.y = pg8::cvt_pk_bf16(p[8 * S + 2], p[8 * S + 3]); w.z = pg8::cvt_pk_bf16(p[8 * S + 4], p[8 * S + 5]); w.w = pg8::cvt_pk_bf16(p[8 * S + 6], p[8 * S + 7]);
    return __builtin_bit_cast(bf16x8, w);
}
__device__ __forceinline__ f32x16 zero16() { f32x16 z; _Pragma("unroll") for (int i = 0; i < 16; ++i) z[i] = 0.f; return z; }
#define ROWOFF(i) (((i) & 3) + 8 * ((i) >> 2))

template <bool UPIL = false>
__device__ __forceinline__ void p0_transpose_item(const float* W, int K, int N, bf16* WT, LAS float* scr, int item, int lane) {
    const int nblk = N / 32, kb = item / nblk, nb = item % nblk, k0 = 64 * kb, n0 = 32 * nb;
    const int cu = n0 < DFF ? n0 : n0 - DFF, d0 = UPIL ? (256 * (cu >> 7) + (n0 < DFF ? 0 : 128) + (cu & 127)) : n0;
    const int lr = lane >> 3, lc = 4 * (lane & 7);
    const GAS f32x4* src = (const GAS f32x4*)(W + (size_t)(k0 + lr) * N + n0 + lc);
    f32x4 v[8];
#pragma unroll
    for (int j = 0; j < 8; ++j) v[j] = src[(size_t)j * 2 * N];
#pragma unroll
    for (int j = 0; j < 8; ++j) { LAS float* d = scr + (8 * j + lr) * 33 + lc; d[0] = v[j].x; d[1] = v[j].y; d[2] = v[j].z; d[3] = v[j].w; }
    LDS_WAIT(); asm volatile("" ::: "memory");
    const int c = lane & 7;
#pragma unroll
    for (int j = 0; j < 4; ++j) { const int n = (lane >> 3) + 8 * j; const LAS float* s = scr + (8 * c) * 33 + n;
        v4u o; o.x = pk2(s[0 * 33], s[1 * 33]); o.y = pk2(s[2 * 33], s[3 * 33]); o.z = pk2(s[4 * 33], s[5 * 33]); o.w = pk2(s[6 * 33], s[7 * 33]);
        *(GAS v4u*)(WT + (size_t)(d0 + n) * K + k0 + 8 * c) = o; }
    LDS_WAIT(); asm volatile("" ::: "memory");
}
__device__ __forceinline__ int perm_row(int m, int sh) { const int b = m / SEQ, t = m % SEQ; return b * SEQ + (t & ((1 << sh) - 1)) * (SEQ >> sh) + (t >> sh); }

struct Args { const float* in[16]; float* out; unsigned char* ws; int ph_lo, ph_hi; };
template <int K_> __device__ __forceinline__ const float* karg() {
    const float* p; asm volatile("s_load_dwordx2 %0, %1, %2\n\ts_waitcnt lgkmcnt(0)" : "=s"(p) : "s"(__builtin_amdgcn_kernarg_segment_ptr()), "i"(K_ * 8) : "memory"); return p; }
#define INP(k) (karg<(k)>())

__device__ __forceinline__ void p0_prologue(Frame& F) {
    LAS float* scr = (LAS float*)(F.lds + F.wave * 16384);
    const int gw = F.vcu * NWAVES + F.wave, NGW = F.G * NWAVES;
    constexpr int I_IN = (DM / 64) * (NIN / 32), I_BR = (1024 / 64) * (DM / 32), I_O = (DM / 64) * (DM / 32), I_UP = (DM / 64) * (NUP / 32), I_DN = (DFF / 64) * (DM / 32);
    constexpr int I_L = I_IN + 4 * I_BR + I_O + I_UP + I_DN;
    for (int it = gw; it < DEPTH * I_L; it += NGW) {
        const int l = it / I_L; int r = it % I_L;
        if (r < I_IN) { p0_transpose_item(INP(1) + (size_t)l * DM * NIN, DM, NIN, (bf16*)(F.ws + WS_WIN + l * WIN_L), scr, r, F.lane); continue; } r -= I_IN;
        if (r < 4 * I_BR) { const int b = r / I_BR; p0_transpose_item(INP(6) + ((size_t)l * 4 + b) * 1024 * DM, 1024, DM, (bf16*)(F.ws + WS_WBR + l * WBR_L) + (size_t)b * DM * 1024, scr, r % I_BR, F.lane); continue; } r -= 4 * I_BR;
        if (r < I_O) { p0_transpose_item(INP(7) + (size_t)l * DM * DM, DM, DM, (bf16*)(F.ws + WS_WO + l * WO_L), scr, r, F.lane); continue; } r -= I_O;
        if (r < I_UP) { p0_transpose_item<true>(INP(10) + (size_t)l * DM * NUP, DM, NUP, (bf16*)(F.ws + WS_WUP + l * WUP_L), scr, r, F.lane); continue; } r -= I_UP;
        p0_transpose_item(INP(13) + (size_t)l * DFF * DM, DFF, DM, (bf16*)(F.ws + WS_WDN + l * WDN_L), scr, r, F.lane);
    }
    const float* x = INP(0);
    for (int m = gw; m < M; m += NGW) {
        const GAS f32x4* xr = (const GAS f32x4*)(x + (size_t)m * DM) + F.lane;
        GAS v2u* o0 = (GAS v2u*)((bf16*)(F.ws + WS_AB) + (size_t)m * DM) + F.lane;
#pragma unroll 4
        for (int j = 0; j < 16; ++j) { const f32x4 v = xr[64 * j]; v2u w; w.x = pk2(v.x, v.y); w.y = pk2(v.z, v.w); o0[64 * j] = w; }
    }
}

using pg8::Unit;
template <int mode> struct InProjSched {
    int G, c; const bf16* X; const bf16* Wt;
    __device__ __forceinline__ bool next(int i, Unit& u) const {
        const int L = i * G + c;
        if constexpr (mode == 0) {
            if (L < 64 * NAT_TILES) {
                int pm, pn; pg8::tile_map(L, 64, NAT_TILES, pm, pn);
                u.pm = pm; u.pn = pn < 8 ? pn : pn < 12 ? pn + 4 : pn < 24 ? pn + 8 : pn < 52 ? pn + 12 : pn + 24; u.kind = 0; return true;
            }
            const int L2 = L - 64 * NAT_TILES;
            if (L2 >= SWP_TILES * 64) return false;
            int ft, tt; pg8::tile_map(L2, SWP_TILES, 64, ft, tt);
            u.pm = ft; u.pn = tt; u.kind = 1; return true;
        } else {
            if (L >= 4 * 64) return false;
            int ft, tt; pg8::tile_map(L, 4, 64, ft, tt);
            u.pm = 12 + 4 * mode + ft; u.pn = tt; u.kind = 1; return true;
        }
    }
    __device__ __forceinline__ void ptrs(const Unit& u, const char*& A, const char*& B) const {
        if (u.kind == 0) { A = (const char*)(X + (size_t)u.pm * 256 * DM); B = (const char*)(Wt + (size_t)u.pn * 256 * DM); }
        else { const int ft = u.pm, ct = ft < 4 ? 8 + ft : ft < 8 ? 12 + ft : ft < 12 ? 24 + ft : 52 + ft;
            A = (const char*)(Wt + (size_t)ct * 256 * DM);
            const int sh = 2 * mode, b = u.pn >> 5, p = (u.pn & 31) * 256, res = p >> (13 - sh), w0 = p & ((SEQ >> sh) - 1);
            B = (const char*)(X + ((size_t)b * SEQ + ((size_t)w0 << sh) + res) * DM); }
    }
};
struct EpiInProj {
    static constexpr bool APERM = false, PERM = true, IDEMP = true;
    bf16* NAT; bf16* VT; bf16* DAK; bf16* DLK;
    __device__ __forceinline__ void operator()(const pg8::f32x4 (&acc)[2][2][4][2], const Unit& u, int wr, int wc, int fr, int fq) const {
        bf16* base; size_t rs_m, rs_ai, cs_bj; float sc = 1.f;
        const int b = u.kind == 0 ? (u.pm >> 5) : (u.pn >> 5), t0 = ((u.kind == 0 ? u.pm : u.pn) & 31) * 256;
        if (u.kind == 0) { const int ct = u.pn;
            sc = ct < 4 ? QS_DA : (ct == 12 || ct == 13) ? 0.125f : (ct >= 40 && ct < 52) ? QS_DL : 1.f;
            if (ct >= 4 && ct < 8) {
                base = DAK + ((size_t)(b * 8 + 2 * (ct - 4)) * SEQ + t0 + wr * 64 + fr) * 128 + wc * 32 + 8 * fq; rs_m = 16 * 128; rs_ai = 128 * 128; cs_bj = (size_t)SEQ * 128;
            } else if (ct >= 52 && ct < 64) {
                const int g = (ct - 52) >> 2, hq = (ct - 52) & 3, sh = 2 * g, R = 1 << sh;
                const int prow = (fr & (R - 1)) * (SEQ >> sh) + (t0 >> sh) + wr * (64 >> sh) + (fr >> sh);
                base = DLK + ((size_t)((g * 2 + b) * 8 + 2 * hq) * SEQ + prow) * 128 + wc * 32 + 8 * fq; rs_m = (size_t)(16 >> sh) * 128; rs_ai = (size_t)(128 >> sh) * 128; cs_bj = (size_t)SEQ * 128;
            } else { base = NAT + ((size_t)u.pm * 256 + wr * 64 + fr) * NIN + ct * 256 + wc * 32 + 8 * fq; rs_m = (size_t)16 * NIN; rs_ai = (size_t)128 * NIN; cs_bj = 128; }
        } else { const int ft = u.pm;
            if (ft < 4) {
                base = VT + (size_t)VT_DAV * M + ((size_t)((b * 8 + 2 * ft) * 128 + (t0 >> 6) + (wc >> 1)) * 128 + wr * 64 + fr) * 64 + (wc & 1) * 32 + 8 * fq;
                rs_m = 16 * 64; rs_ai = (size_t)128 * 128 * 64; cs_bj = (size_t)2 * 128 * 64;
            } else if (ft >= 12) {
                const int g = (ft - 12) >> 2, hq = (ft - 12) & 3;
                base = VT + (size_t)VT_DLV * M + ((size_t)(((g * 2 + b) * 8 + 2 * hq) * 256 + (t0 >> 5) + wc) * 128 + wr * 64 + fr) * 32 + 8 * fq;
                rs_m = 16 * 32; rs_ai = (size_t)256 * 128 * 32; cs_bj = (size_t)4 * 128 * 32;
            } else { base = VT + ((size_t)ft * 256 + wr * 64 + fr) * M + u.pn * 256 + wc * 32 + 8 * fq; rs_m = (size_t)16 * M; rs_ai = (size_t)128 * M; cs_bj = 128; }
        }
#pragma unroll
        for (int ai = 0; ai < 2; ++ai)
#pragma unroll
            for (int m = 0; m < 4; ++m) { bf16* rowp = base + ai * rs_ai + m * rs_m;
#pragma unroll
                for (int bj = 0; bj < 2; ++bj) { const pg8::f32x4 v0 = acc[ai][bj][m][0] * sc, v1 = acc[ai][bj][m][1] * sc;
                    pg8::u32x4 w; w.x = pg8::cvt_pk_bf16(v0[0], v0[1]); w.y = pg8::cvt_pk_bf16(v0[2], v0[3]); w.z = pg8::cvt_pk_bf16(v1[0], v1[1]); w.w = pg8::cvt_pk_bf16(v1[2], v1[3]);
                    *(pg8::u32x4*)(rowp + bj * cs_bj) = w; } }
    }
};
struct MergeSched {
    int G, c; const bf16* Y; const bf16* Wb;
    __device__ __forceinline__ bool next(int i, Unit& u) const {
        const int L = (i >> 2) * G + c; if (L >= 64 * 16) return false;
        int pm, pn; pg8::tile_map(L, 64, 16, pm, pn); u.pm = pm; u.pn = pn; u.kind = i & 3; return true;
    }
    __device__ __forceinline__ void ptrs(const Unit& u, const char*& A, const char*& B) const {
        A = (const char*)(Y + (size_t)u.kind * M * 1024 + (size_t)u.pm * 256 * 1024); B = (const char*)(Wb + (size_t)u.kind * DM * 1024 + (size_t)u.pn * 256 * 1024);
    }
};
struct EpiMerge {
    static constexpr bool APERM = false, PERM = true, IDEMP = false;
    const bf16* NAT; bf16* MRGB;
    __device__ __forceinline__ void operator()(const pg8::f32x4 (&acc)[2][2][4][2], const Unit& u, int wr, int wc, int fr, int fq) const {
        const int row0 = u.pm * 256 + wr * 64 + fr, col0 = u.pn * 256 + wc * 32 + 8 * fq, b = u.kind;
#pragma unroll
        for (int ai = 0; ai < 2; ++ai) {
            const bf16* gp = NAT + (size_t)(row0 + ai * 128) * NIN + C_GATE + b * DM + col0; bf16* bp = MRGB + (size_t)(row0 + ai * 128) * DM + col0;
            v4u G[4][2], O[4][2];
#pragma unroll
            for (int m = 0; m < 4; ++m)
#pragma unroll
                for (int bj = 0; bj < 2; ++bj) G[m][bj] = *(const v4u*)(gp + (size_t)m * 16 * NIN + bj * 128);
            if (b > 0) {
#pragma unroll
                for (int m = 0; m < 4; ++m)
#pragma unroll
                    for (int bj = 0; bj < 2; ++bj) O[m][bj] = *(const v4u*)(bp + (size_t)m * 16 * DM + bj * 128);
            } else {
#pragma unroll
                for (int m = 0; m < 4; ++m)
#pragma unroll
                    for (int bj = 0; bj < 2; ++bj) O[m][bj] = (v4u){0u, 0u, 0u, 0u};
            }
            __builtin_amdgcn_sched_barrier(0);
#pragma unroll
            for (int m = 0; m < 4; ++m)
#pragma unroll
                for (int bj = 0; bj < 2; ++bj) { const v4u g = G[m][bj], o = O[m][bj];
                    pg8::f32x4 v0 = acc[ai][bj][m][0], v1 = acc[ai][bj][m][1];
                    v0[0] = v0[0] * fsigmoid(bflo(g.x)) + bflo(o.x); v0[1] = v0[1] * fsigmoid(bfhi(g.x)) + bfhi(o.x); v0[2] = v0[2] * fsigmoid(bflo(g.y)) + bflo(o.y); v0[3] = v0[3] * fsigmoid(bfhi(g.y)) + bfhi(o.y);
                    v1[0] = v1[0] * fsigmoid(bflo(g.z)) + bflo(o.z); v1[1] = v1[1] * fsigmoid(bfhi(g.z)) + bfhi(o.z); v1[2] = v1[2] * fsigmoid(bflo(g.w)) + bflo(o.w); v1[3] = v1[3] * fsigmoid(bfhi(g.w)) + bfhi(o.w);
                    v4u w; w.x = pg8::cvt_pk_bf16(v0[0], v0[1]); w.y = pg8::cvt_pk_bf16(v0[2], v0[3]); w.z = pg8::cvt_pk_bf16(v1[0], v1[1]); w.w = pg8::cvt_pk_bf16(v1[2], v1[3]);
                    *(v4u*)(bp + (size_t)m * 16 * DM + bj * 128) = w; }
        }
    }
};
struct PlainSched {
    int G, c, nN, K; const bf16* A; const bf16* Bt;
    __device__ __forceinline__ bool next(int i, Unit& u) const {
        const int L = i * G + c; if (L >= 64 * nN) return false;
        int pm, pn; pg8::tile_map(L, 64, nN, pm, pn); u.pm = pm; u.pn = pn; u.kind = 0; return true;
    }
    __device__ __forceinline__ void ptrs(const Unit& u, const char*& Ap, const char*& Bp) const {
        Ap = (const char*)(A + (size_t)u.pm * 256 * K); Bp = (const char*)(Bt + (size_t)u.pn * 256 * K);
    }
};
struct EpiF32 {
    static constexpr bool APERM = false, PERM = false, IDEMP = true;
    float* C; int ldc;
    __device__ __forceinline__ void operator()(const pg8::f32x4 (&acc)[2][2][4][2], const Unit& u, int wr, int wc, int fr, int fq) const {
        const int row0 = u.pm * 256 + wr * 64 + fr, col0 = u.pn * 256 + wc * 32 + 4 * fq;
#pragma unroll
        for (int ai = 0; ai < 2; ++ai)
#pragma unroll
            for (int m = 0; m < 4; ++m) { float* rowp = C + (size_t)(row0 + ai * 128 + m * 16) * ldc + col0;
#pragma unroll
                for (int bj = 0; bj < 2; ++bj)
#pragma unroll
                    for (int n = 0; n < 2; ++n) *(pg8::f32x4*)(rowp + bj * 128 + n * 16) = acc[ai][bj][m][n]; }
    }
};
struct EpiBf16 {
    static constexpr bool APERM = false, PERM = true, IDEMP = true;
    bf16* O; int ldc;
    __device__ __forceinline__ void operator()(const pg8::f32x4 (&acc)[2][2][4][2], const Unit& u, int wr, int wc, int fr, int fq) const {
        const int row0 = u.pm * 256 + wr * 64 + fr, col0 = u.pn * 256 + wc * 32 + 8 * fq;
#pragma unroll
        for (int ai = 0; ai < 2; ++ai)
#pragma unroll
            for (int m = 0; m < 4; ++m) { bf16* rowp = O + (size_t)(row0 + ai * 128 + m * 16) * ldc + col0;
#pragma unroll
                for (int bj = 0; bj < 2; ++bj) { const pg8::f32x4 v0 = acc[ai][bj][m][0], v1 = acc[ai][bj][m][1];
                    pg8::u32x4 w; w.x = pg8::cvt_pk_bf16(v0[0], v0[1]); w.y = pg8::cvt_pk_bf16(v0[2], v0[3]); w.z = pg8::cvt_pk_bf16(v1[0], v1[1]); w.w = pg8::cvt_pk_bf16(v1[2], v1[3]);
                    *(pg8::u32x4*)(rowp + bj * 128) = w; } }
    }
};

__device__ __forceinline__ float gelu1(float v) {
    const float av = fabsf(v), t = __builtin_amdgcn_rcpf(av * 0.2316418882f + 1.0f);
    float q = t * 0.5307027145f + (-0.7265760135f); q = q * t + 0.7107068705f; q = q * t + (-0.142248368f); q = q * t + 0.127414796f; q = q * t;
    const float e = __builtin_amdgcn_exp2f((v * v) * (-0.72134752044f));
    const float mm = v * (q * e);
    return v < 0.f ? mm : v - mm;
}
__device__ __forceinline__ float dpp_shr1(float v) { return __int_as_float(__builtin_amdgcn_update_dpp(0, __float_as_int(v), 0x111, 0xf, 0xf, true)); }
struct EpiAct {
    static constexpr bool APERM = true, PERM = true, IDEMP = true;
    bf16* ACT; const float* cw; const float* cb; float* EA; float* EG; float* EL;
    __device__ __forceinline__ void operator()(const pg8::f32x4 (&acc)[2][2][4][2], const Unit& u, int wr, int wc, int fr, int fq) const {
        const int c0 = u.pn * 128 + wc * 32 + 8 * fq, seg = u.pm * 2 + wr;
        bf16* op = ACT + ((size_t)u.pm * 256 + 128 * wr + 8 * fr) * DFF + c0;
        pg8::f32x4 w0[2], w1[2], w2[2], bc[2], p2[2], p1[2];
#pragma unroll
        for (int n = 0; n < 2; ++n) { w0[n] = *(const GAS pg8::f32x4*)(cw + c0 + 4 * n); w1[n] = *(const GAS pg8::f32x4*)(cw + DFF + c0 + 4 * n); w2[n] = *(const GAS pg8::f32x4*)(cw + 2 * DFF + c0 + 4 * n); bc[n] = *(const GAS pg8::f32x4*)(cb + c0 + 4 * n);
#pragma unroll
            for (int e = 0; e < 4; ++e) { p2[n][e] = dpp_shr1(acc[1][0][2][n][e]); p1[n][e] = dpp_shr1(acc[1][0][3][n][e]); } }
#pragma unroll
        for (int j = 0; j < 8; ++j) {
            pg8::f32x4 o[2];
#pragma unroll
            for (int n = 0; n < 2; ++n) { const pg8::f32x4 a0 = acc[j >> 2][0][j & 3][n], gl = acc[j >> 2][1][j & 3][n];
                const pg8::f32x4 cv = bc[n] + w0[n] * p2[n] + w1[n] * p1[n] + w2[n] * a0;
#pragma unroll
                for (int e = 0; e < 4; ++e) o[n][e] = gelu1(cv[e]) * gl[e];
                p2[n] = p1[n]; p1[n] = a0;
                if (j < 2 && fr == 0) { *(pg8::f32x4*)(EA + (size_t)(seg * 2 + j) * DFF + c0 + 4 * n) = a0; *(pg8::f32x4*)(EG + (size_t)(seg * 2 + j) * DFF + c0 + 4 * n) = gl; }
                if (j >= 6 && fr == 15) *(pg8::f32x4*)(EL + (size_t)(seg * 2 + j - 6) * DFF + c0 + 4 * n) = a0; }
            pg8::u32x4 w; w.x = pg8::cvt_pk_bf16(o[0][0], o[0][1]); w.y = pg8::cvt_pk_bf16(o[0][2], o[0][3]); w.z = pg8::cvt_pk_bf16(o[1][0], o[1][1]); w.w = pg8::cvt_pk_bf16(o[1][2], o[1][3]);
            *(pg8::u32x4*)(op + (size_t)j * DFF) = w;
        }
    }
};

__device__ __forceinline__ int wq_pull(gu32* cnt, int lane) {
    unsigned v = 0; if (lane == 0) v = __hip_atomic_fetch_add(cnt, 1u, RLX_AGENT);
    return (int)__builtin_amdgcn_readfirstlane(v);
}

constexpr int OT_ROW = 272;
__device__ __forceinline__ void ot_put(LAS unsigned char* wl, int r, int hh, int d0, v2u w) { *(LAS v2u*)(wl + r * OT_ROW + (d0 + 4 * hh) * 2) = w; }
__device__ __forceinline__ void ot_emit(const LAS unsigned char* wl, bf16* yb  , int rstride  , int lane) {
#pragma unroll
    for (int k = 0; k < 8; ++k) { const int row = (lane >> 4) + 4 * k; const v4u v = *(const LAS v4u*)(wl + row * OT_ROW + (lane & 15) * 16);
        *(v4u*)(yb + (size_t)row * rstride * 1024 + (lane & 15) * 8) = v; }
}

__device__ __forceinline__ void diff_unit(const bf16* NAT, const bf16* VT, bf16* YA, const float* normg, float lam, float oscale, int b, int h, int qt, int lane) {
    const int r = lane & 31, hh = lane >> 5;
    const float slope2 = __builtin_amdgcn_exp2f(-(float)h - 0.25f) * LOG2E;
    const size_t tok0 = (size_t)b * SEQ;
    const int q = qt * 32 + r;
    const bf16* qp = NAT + (tok0 + q) * NIN + C_DAQ + h * 128 + 8 * hh;
    f32x16 O1[4], O2[4];
#pragma unroll
    for (int d = 0; d < 4; ++d) { O1[d] = zero16(); O2[d] = zero16(); }
    float m1 = -INFINITY, m2 = -INFINITY, l1 = 0.f, l2 = 0.f;
    for (int kt = qt; kt >= 0; --kt) {
        const int k0 = kt * 32;
        const bf16* kp = NAT + (tok0 + k0 + r) * NIN + C_DAK + h * 128 + 8 * hh;
        const bf16* vp = VT + (size_t)(VT_DAV + h * 128 + r) * M + tok0 + k0 + 4 * hh;
        const float base = slope2 * (float)(k0 + 4 * hh - q);
        const bool diag = (kt == qt);
        bf16x8 pf1[2], pf2[2];
        const bf16* qq = qp; asm volatile("" : "+v"(qq));
        {
            f32x16 s1 = zero16();
#pragma unroll
            for (int s = 0; s < 4; ++s) s1 = mfma32(ld8(kp + 16 * s), ld8(qq + 16 * s), s1);
            float mx = -INFINITY;
#pragma unroll
            for (int i = 0; i < 16; ++i) { float v = s1[i] + (base + slope2 * (float)ROWOFF(i)); if (diag && (k0 + 4 * hh + ROWOFF(i) > q)) v = -INFINITY; s1[i] = v; mx = fmaxf(mx, v); }
            mx = half_max(mx);
            const float mn = fmaxf(m1, mx), al = __builtin_amdgcn_exp2f(m1 - mn); m1 = mn;
            float ps = 0.f;
#pragma unroll
            for (int i = 0; i < 16; ++i) { const float p = __builtin_amdgcn_exp2f(s1[i] - mn); s1[i] = p; ps += p; }
            l1 = l1 * al + half_sum(ps);
            if (!__all(al == 1.f)) {
#pragma unroll
                for (int d = 0; d < 4; ++d) O1[d] *= al; }
            pf1[0] = pack8<0>(s1); pf1[1] = pack8<1>(s1);
        }
        {
            f32x16 s2 = zero16();
#pragma unroll
            for (int s = 0; s < 4; ++s) s2 = mfma32(ld8(kp + 64 + 16 * s), ld8(qq + 64 + 16 * s), s2);
            float mx = -INFINITY;
#pragma unroll
            for (int i = 0; i < 16; ++i) { float v = s2[i] + (base + slope2 * (float)ROWOFF(i)); if (diag && (k0 + 4 * hh + ROWOFF(i) > q)) v = -INFINITY; s2[i] = v; mx = fmaxf(mx, v); }
            mx = half_max(mx);
            const float mn = fmaxf(m2, mx), al = __builtin_amdgcn_exp2f(m2 - mn); m2 = mn;
            float ps = 0.f;
#pragma unroll
            for (int i = 0; i < 16; ++i) { const float p = __builtin_amdgcn_exp2f(s2[i] - mn); s2[i] = p; ps += p; }
            l2 = l2 * al + half_sum(ps);
            if (!__all(al == 1.f)) {
#pragma unroll
                for (int d = 0; d < 4; ++d) O2[d] *= al; }
            pf2[0] = pack8<0>(s2); pf2[1] = pack8<1>(s2);
        }
#pragma unroll
        for (int d = 0; d < 4; ++d)
#pragma unroll
            for (int s = 0; s < 2; ++s) { const bf16x8 vf = ld44(vp + (size_t)d * 32 * M + 16 * s); O1[d] = mfma32(vf, pf1[s], O1[d]); O2[d] = mfma32(vf, pf2[s], O2[d]); }
    }
    const float i1 = 1.f / l1, i2 = lam / l2;
    float ss = 0.f;
#pragma unroll
    for (int d = 0; d < 4; ++d)
#pragma unroll
        for (int i = 0; i < 16; ++i) { const float o = O1[d][i] * i1 - O2[d][i] * i2; O1[d][i] = o; ss += o * o; }
    ss = half_sum(ss);
    const float rs = __builtin_amdgcn_rsqf(ss * (1.f / 128.f) + EPS) * oscale;
    bf16* yp = YA + (tok0 + q) * 1024 + h * 128 + 4 * hh;
#pragma unroll
    for (int d = 0; d < 4; ++d)
#pragma unroll
        for (int g = 0; g < 4; ++g) { const int d0 = 32 * d + 8 * g; const f32x4 gv = *(const f32x4*)(normg + d0 + 4 * hh);
            v2u w; w.x = pg8::cvt_pk_bf16(O1[d][4 * g] * rs * gv.x, O1[d][4 * g + 1] * rs * gv.y); w.y = pg8::cvt_pk_bf16(O1[d][4 * g + 2] * rs * gv.z, O1[d][4 * g + 3] * rs * gv.w);
            *(v2u*)(yp + d0) = w; }
}

constexpr int DA_KROW = 272, DA_VROW = 136;
constexpr int DA_KBUF = 64 * DA_KROW, DA_VBUF = 128 * DA_VROW, DA_STAGE = DA_KBUF + DA_VBUF, DA_QOFF = 2 * DA_STAGE, DA_END = DA_QOFF + 256 * DA_KROW;
static_assert(DA_END <= LDSCTL_OFF, "diff-attention LDS map");
typedef LAS unsigned char* ldsp;
__device__ __forceinline__ bf16x8 lds8(const LAS unsigned char* p) { return *(const LAS bf16x8*)p; }
__device__ __forceinline__ bf16x8 lds44(const LAS unsigned char* p) { const bf16x4 a = *(const LAS bf16x4*)p, b = *(const LAS bf16x4*)(p + 16); return __builtin_shufflevector(a, b, 0, 1, 2, 3, 4, 5, 6, 7); }
__device__ __forceinline__ void da_softmax(f32x16& s, float slope2, float base, bool diag, int dq, float& m, float& l, f32x16 (&O)[4], bf16x8& p0, bf16x8& p1) {
    float mx = -INFINITY;
#pragma unroll
    for (int i = 0; i < 16; ++i) { float v = __builtin_fmaf(slope2, (float)ROWOFF(i), s[i]); if (diag && (ROWOFF(i) > dq)) v = -INFINITY; s[i] = v; mx = fmaxf(mx, v); }
    mx = half_max(mx + base);
    const float mn = fmaxf(m, mx), al = __builtin_amdgcn_exp2f(m - mn), sm = mn - base; m = mn;
    float ps = 0.f;
#pragma unroll
    for (int i = 0; i < 16; ++i) { const float p = __builtin_amdgcn_exp2f(s[i] - sm); s[i] = p; ps += p; }
    l = l * al + half_sum(ps);
    if (!__all(al == 1.f)) {
#pragma unroll
        for (int d = 0; d < 4; ++d) O[d] *= al; }
    p0 = pack8<0>(s); p1 = pack8<1>(s);
}
__device__ __forceinline__ void diff_block(LAS unsigned char* lds, volatile LAS unsigned* flags, const unsigned* nrm, const bf16* NAT, const bf16* DAK, const bf16* VT, bf16* YA, const float* normg, float lam, float oscale, int b, int h, int qb, int tid) {
    const int lane = tid & 63, w = __builtin_amdgcn_readfirstlane(tid >> 6), r = lane & 31, hh = lane >> 5;
    const float slope2 = __builtin_amdgcn_exp2f(-(float)h - 0.25f) * LOG2E;
    const float sub = sqrtf(fmaxf(__uint_as_float(nrm[4 * h + 0]) * __uint_as_float(nrm[4 * h + 2]), __uint_as_float(nrm[4 * h + 1]) * __uint_as_float(nrm[4 * h + 3]))) * 1.01f;
    const size_t tok0 = (size_t)b * SEQ;
    const int q0 = 256 * qb, q = q0 + 32 * w + r, qt_w = 8 * qb + w;
    const bf16* kg = DAK + (size_t)(b * 8 + h) * SEQ * 128 + 8 * tid;
    const bf16* vg = VT + (size_t)VT_DAV * M + (size_t)(b * 8 + h) * SEQ * 128 + 8 * tid;
    const int kw = (tid >> 4) * DA_KROW + (tid & 15) * 16, vw = DA_KBUF + (tid >> 3) * DA_VROW + (tid & 7) * 16;
    {
        const bf16* qg = NAT + (tok0 + q0 + (tid >> 4)) * NIN + C_DAQ + h * 128 + 8 * (tid & 15);
#pragma unroll
        for (int i = 0; i < 8; ++i) *(LAS v4u*)(lds + DA_QOFF + kw + i * 32 * DA_KROW) = *(const v4u*)(qg + (size_t)i * 32 * NIN);
    }
    int kt = 4 * qb + 3;
    v4u g0, g1, g2, g3;
#define DA_LOAD(KT) do { const size_t k0_ = (size_t)(KT) * 8192; g0 = *(const v4u*)(kg + k0_); g1 = *(const v4u*)(kg + k0_ + 4096); g2 = *(const v4u*)(vg + k0_); g3 = *(const v4u*)(vg + k0_ + 4096); } while (0)
#define DA_STORE(BUF) do { LAS unsigned char* s_ = lds + (BUF) * DA_STAGE; *(LAS v4u*)(s_ + kw) = g0; *(LAS v4u*)(s_ + kw + 32 * DA_KROW) = g1; \
        *(LAS v2u*)(s_ + vw) = (v2u){g2.x, g2.y}; *(LAS v2u*)(s_ + vw + 8) = (v2u){g2.z, g2.w}; *(LAS v2u*)(s_ + vw + 64 * DA_VROW) = (v2u){g3.x, g3.y}; *(LAS v2u*)(s_ + vw + 64 * DA_VROW + 8) = (v2u){g3.z, g3.w}; } while (0)
    DA_LOAD(kt); DA_STORE(0);
    __syncthreads();
    f32x16 O1[4], O2[4];
#pragma unroll
    for (int d = 0; d < 4; ++d) { O1[d] = zero16(); O2[d] = zero16(); }
    float m1 = -INFINITY, m2 = -INFINITY, l1 = 0.f, l2 = 0.f;
    const LAS unsigned char* qa = lds + DA_QOFF + (32 * w + r) * DA_KROW + 16 * hh;
    int cur = 0;
    for (; kt >= 0; --kt) {
        if (kt > 0) DA_LOAD(kt - 1);
        const LAS unsigned char* Kb = lds + cur * DA_STAGE; const LAS unsigned char* Vb = Kb + DA_KBUF;
#pragma unroll
        for (int sub = 1; sub >= 0; --sub) {
            const int st = 2 * kt + sub;
            if (st <= qt_w) {
                const bool diag = (st == qt_w);
                const float base = slope2 * (float)(32 * st + 4 * hh - q);
                const int dq = q - 32 * st - 4 * hh;
                const LAS unsigned char* ka = Kb + (32 * sub + r) * DA_KROW + 16 * hh;
                bf16x8 pf1[2], pf2[2];
                { f32x16 s1 = zero16();
#pragma unroll
                  for (int s = 0; s < 4; ++s) s1 = mfma32(lds8(ka + 32 * s), lds8(qa + 32 * s), s1);
                  da_softmax(s1, slope2, base, diag, dq, m1, l1, O1, pf1[0], pf1[1]); }
                { f32x16 s2 = zero16();
#pragma unroll
                  for (int s = 0; s < 4; ++s) s2 = mfma32(lds8(ka + 128 + 32 * s), lds8(qa + 128 + 32 * s), s2);
                  da_softmax(s2, slope2, base, diag, dq, m2, l2, O2, pf2[0], pf2[1]); }
                const LAS unsigned char* va = Vb + r * DA_VROW + (32 * sub + 4 * hh) * 2;
#pragma unroll
                for (int d = 0; d < 4; ++d)
#pragma unroll
                    for (int s = 0; s < 2; ++s) { const bf16x8 vf = lds44(va + d * 32 * DA_VROW + 32 * s); O1[d] = mfma32(vf, pf1[s], O1[d]); O2[d] = mfma32(vf, pf2[s], O2[d]); }
            }
        }
        const bool can = (sub - slope2 * (float)(q - 64 * kt + 1)) < fminf(m1, m2) - 32.f;
        const bool wcan = __all(can);
        if (lane == 0) flags[(kt & 1) * 8 + w] = wcan ? 1u : 0u;
        if (kt > 0) DA_STORE(cur ^ 1);
        __syncthreads();
        cur ^= 1;
        {   const LAS v4u* fp = (const LAS v4u*)(const_cast<LAS unsigned*>(flags) + (kt & 1) * 8); const v4u fa = fp[0], fb = fp[1];
            if ((fa.x & fa.y & fa.z & fa.w & fb.x & fb.y & fb.z & fb.w) != 0u) break; }
    }
#undef DA_LOAD
#undef DA_STORE
    const float i1 = 1.f / l1, i2 = lam / l2;
    float ss = 0.f;
#pragma unroll
    for (int d = 0; d < 4; ++d)
#pragma unroll
        for (int i = 0; i < 16; ++i) { const float o = O1[d][i] * i1 - O2[d][i] * i2; O1[d][i] = o; ss += o * o; }
    ss = half_sum(ss);
    const float rs = __builtin_amdgcn_rsqf(ss * (1.f / 128.f) + EPS) * oscale;
    LAS unsigned char* ot = lds + w * (32 * OT_ROW);
#pragma unroll
    for (int d = 0; d < 4; ++d)
#pragma unroll
        for (int g = 0; g < 4; ++g) { const int d0 = 32 * d + 8 * g; const f32x4 gv = *(const f32x4*)(normg + d0 + 4 * hh);
            v2u w2; w2.x = pg8::cvt_pk_bf16(O1[d][4 * g] * rs * gv.x, O1[d][4 * g + 1] * rs * gv.y); w2.y = pg8::cvt_pk_bf16(O1[d][4 * g + 2] * rs * gv.z, O1[d][4 * g + 3] * rs * gv.w);
            ot_put(ot, r, hh, d0, w2); }
    ot_emit(ot, YA + (tok0 + q0 + 32 * w) * 1024 + h * 128, 1, lane);
}

constexpr int DL_KROW = 272, DL_VROW = 72, DL_KBUF = 32 * DL_KROW, DL_WAVE = DL_KBUF + 128 * DL_VROW;
static_assert(8 * DL_WAVE <= LDSCTL_OFF, "dilated-attention LDS map");
template <int G_> __device__ __forceinline__ void dil_group(LAS unsigned char* wl, const bf16* NAT, const bf16* DLK, const bf16* VT, size_t tok0, int h, int rho, int ut, int lane, f32x16 (&O)[4], float& m, float& l) {
    constexpr int SH = G_ == 0 ? 0 : G_ == 1 ? 2 : 4, RATE = 1 << SH;
    const int r = lane & 31, hh = lane >> 5;
    const int tq = rho + 16 * (32 * ut + r);
    const int res = rho & (RATE - 1);
    const int wq = (tq - res) >> SH;
    const int wq0 = ((rho - res) >> SH) + (16 >> SH) * (32 * ut), wq31 = wq0 + (16 >> SH) * 31;
    const int kt_hi = wq31 >> 5; int kt_lo = (wq0 - 128) >> 5; kt_lo = kt_lo < 0 ? 0 : kt_lo;
    const float slope2 = __builtin_amdgcn_exp2f(-(float)(4 * h + 2 + G_) * 0.25f) * LOG2E * (float)RATE;
    const bf16* qp = NAT + (tok0 + tq) * NIN + C_DLQ + G_ * 1024 + h * 128 + 8 * hh;
    bf16x8 qf[8];
#pragma unroll
    for (int s = 0; s < 8; ++s) qf[s] = ld8(qp + 16 * s);
    const int bb = (int)(tok0 / SEQ);
    const bf16* kg = DLK + ((size_t)((G_ * 2 + bb) * 8 + h) * SEQ + (size_t)res * (SEQ >> SH)) * 128 + 8 * lane;
    const bf16* vg = VT + (size_t)VT_DLV * M + ((size_t)((G_ * 2 + bb) * 8 + h) * SEQ + (size_t)res * (SEQ >> SH)) * 128 + 8 * lane;
    LAS unsigned char* kw = wl + (lane >> 4) * DL_KROW + (lane & 15) * 16;
    LAS unsigned char* vw = wl + DL_KBUF + (lane >> 2) * DL_VROW + (lane & 3) * 16;
    v4u gk[8], gv[8];
#define DL_LOAD(KT) do { _Pragma("unroll") for (int i_ = 0; i_ < 8; ++i_) { gk[i_] = *(const v4u*)(kg + (size_t)(KT) * 4096 + 512 * i_); gv[i_] = *(const v4u*)(vg + (size_t)(KT) * 4096 + 512 * i_); } } while (0)
#define DL_STORE() do { _Pragma("unroll") for (int i_ = 0; i_ < 8; ++i_) { *(LAS v4u*)(kw + 4 * i_ * DL_KROW) = gk[i_]; \
        *(LAS v2u*)(vw + 16 * i_ * DL_VROW) = (v2u){gv[i_].x, gv[i_].y}; *(LAS v2u*)(vw + 16 * i_ * DL_VROW + 8) = (v2u){gv[i_].z, gv[i_].w}; } } while (0)
    DL_LOAD(kt_hi); DL_STORE();
    const LAS unsigned char* ka = wl + r * DL_KROW + 16 * hh;
    const LAS unsigned char* va = wl + DL_KBUF + r * DL_VROW + 8 * hh;
    for (int kt = kt_hi; kt >= kt_lo; --kt) {
        const int w0 = kt * 32;
        if (kt > kt_lo) DL_LOAD(kt - 1);
        f32x16 s = zero16();
#pragma unroll
        for (int ks = 0; ks < 8; ++ks) s = mfma32(lds8(ka + 32 * ks), qf[ks], s);
        float mx = -INFINITY;
        const int dq = wq - w0 - 4 * hh;
#pragma unroll
        for (int i = 0; i < 16; ++i) { const int d = dq - ROWOFF(i); const float v = (d >= 0 && d <= 128) ? s[i] - slope2 * (float)d : -INFINITY; s[i] = v; mx = fmaxf(mx, v); }
        mx = half_max(mx);
        const float mn = fmaxf(m, mx), mu = (mn == -INFINITY) ? 0.f : mn, al = __builtin_amdgcn_exp2f(m - mu); m = mn;
        float ps = 0.f;
#pragma unroll
        for (int i = 0; i < 16; ++i) { const float p = __builtin_amdgcn_exp2f(s[i] - mu); s[i] = p; ps += p; }
        l = l * al + half_sum(ps);
        if (!__all(al == 1.f)) {
#pragma unroll
            for (int d = 0; d < 4; ++d) O[d] *= al; }
        const bf16x8 pf0 = pack8<0>(s), pf1 = pack8<1>(s);
#pragma unroll
        for (int d = 0; d < 4; ++d) { O[d] = mfma32(lds44(va + d * 32 * DL_VROW), pf0, O[d]); O[d] = mfma32(lds44(va + d * 32 * DL_VROW + 32), pf1, O[d]); }
        if (kt > kt_lo) DL_STORE();
    }
#undef DL_LOAD
#undef DL_STORE
}
__device__ __forceinline__ void dil_unit(LAS unsigned char* wl, const bf16* NAT, const bf16* DLK, const bf16* VT, bf16* YD, int b, int h, int rho, int ut, int lane) {
    const int r = lane & 31, hh = lane >> 5;
    const size_t tok0 = (size_t)b * SEQ;
    f32x16 O[4];
#pragma unroll
    for (int d = 0; d < 4; ++d) O[d] = zero16();
    float m = -INFINITY, l = 0.f;
    dil_group<2>(wl, NAT, DLK, VT, tok0, h, rho, ut, lane, O, m, l);
    dil_group<1>(wl, NAT, DLK, VT, tok0, h, rho, ut, lane, O, m, l);
    dil_group<0>(wl, NAT, DLK, VT, tok0, h, rho, ut, lane, O, m, l);
    const float il = 1.f / l;
    const int tq = rho + 16 * (32 * ut + r);
    bf16* yp = YD + (tok0 + tq) * 1024 + h * 128 + 4 * hh;
#pragma unroll
    for (int d = 0; d < 4; ++d)
#pragma unroll
        for (int g = 0; g < 4; ++g) { v2u w; w.x = pg8::cvt_pk_bf16(O[d][4 * g] * il, O[d][4 * g + 1] * il); w.y = pg8::cvt_pk_bf16(O[d][4 * g + 2] * il, O[d][4 * g + 3] * il);
            *(v2u*)(yp + 32 * d + 8 * g) = w; }
}

__device__ __forceinline__ float ret_log2g(int h) { return __builtin_amdgcn_logf(1.f - __builtin_amdgcn_exp2f(-(float)(5 + h))); }
constexpr int RU_ROW = 132, RU_WAVE = 128 * RU_ROW;
__device__ __forceinline__ void retu_unit(LAS unsigned char* wl, const bf16* NAT, const bf16* VT, float* UR, int bh, int n, int lane) {
    const int r = lane & 31, hh = lane >> 5, b = bh >> 3, h = bh & 7;
    const size_t tokc = (size_t)b * SEQ + 128 * n;
    {   const bf16* kg = NAT + (tokc + (lane >> 3)) * NIN + C_RTK + h * 64 + 8 * (lane & 7);
        LAS unsigned* kw = (LAS unsigned*)(wl + (lane >> 3) * RU_ROW + (lane & 7) * 16);
#pragma unroll 1
        for (int i0 = 0; i0 < 16; i0 += 8) { v4u kv[8];
#pragma unroll
            for (int i = 0; i < 8; ++i) kv[i] = *(const v4u*)(kg + (size_t)8 * (i0 + i) * NIN);
#pragma unroll
            for (int i = 0; i < 8; ++i) { LAS unsigned* d = kw + 8 * (i0 + i) * (RU_ROW / 4); d[0] = kv[i].x; d[1] = kv[i].y; d[2] = kv[i].z; d[3] = kv[i].w; } } }
    bf16x8 kf[2][8];
    const float l2g = ret_log2g(h);
    float ge[8];
#pragma unroll
    for (int e = 0; e < 8; ++e) ge[e] = __builtin_amdgcn_exp2f(-(float)e * l2g);
#pragma unroll
    for (int s = 0; s < 8; ++s) { const float fs = __builtin_amdgcn_exp2f((float)(127 - 16 * s - 8 * hh) * l2g);
#pragma unroll
        for (int dt = 0; dt < 2; ++dt) { const LAS unsigned short* p = (const LAS unsigned short*)(wl + (16 * s + 8 * hh) * RU_ROW + (32 * dt + r) * 2);
            v4u w;
            w.x = pg8::cvt_pk_bf16(bf1(p[0 * (RU_ROW / 2)]) * (fs * ge[0]), bf1(p[1 * (RU_ROW / 2)]) * (fs * ge[1])); w.y = pg8::cvt_pk_bf16(bf1(p[2 * (RU_ROW / 2)]) * (fs * ge[2]), bf1(p[3 * (RU_ROW / 2)]) * (fs * ge[3]));
            w.z = pg8::cvt_pk_bf16(bf1(p[4 * (RU_ROW / 2)]) * (fs * ge[4]), bf1(p[5 * (RU_ROW / 2)]) * (fs * ge[5])); w.w = pg8::cvt_pk_bf16(bf1(p[6 * (RU_ROW / 2)]) * (fs * ge[6]), bf1(p[7 * (RU_ROW / 2)]) * (fs * ge[7]));
            kf[dt][s] = __builtin_bit_cast(bf16x8, w); __builtin_amdgcn_sched_barrier(0); } }
#pragma unroll 1
    for (int et = 0; et < 4; ++et) {
        const bf16* ap = VT + (size_t)(VT_RTV + h * 128 + 32 * et + r) * M + tokc + 8 * hh;
        f32x16 a0 = zero16(), a1 = zero16();
#pragma unroll
        for (int s = 0; s < 8; ++s) { const bf16x8 af = ld8(ap + 16 * s); a0 = mfma32(af, kf[0][s], a0); a1 = mfma32(af, kf[1][s], a1); }
        float* up = UR + ((size_t)(bh * 64 + n) * 128 + 32 * et + 4 * hh) * 64 + r;
#pragma unroll
        for (int i = 0; i < 16; ++i) { up[ROWOFF(i) * 64] = a0[i]; up[ROWOFF(i) * 64 + 32] = a1[i]; }
    }
}
__device__ __forceinline__ void ret_out_unit(LAS unsigned char* wl, const bf16* NAT, const bf16* VT, const bf16* SR, bf16* YR, int bh, int n, int it, int lane) {
    const int r = lane & 31, hh = lane >> 5, b = bh >> 3, h = bh & 7;
    const size_t tok0 = (size_t)b * SEQ + 128 * n;
    const int il = 32 * it + r;
    const float l2g = ret_log2g(h);
    const bf16* qp = NAT + (tok0 + il) * NIN + C_RTQ + h * 64 + 8 * hh;
    bf16x8 qf[4];
#pragma unroll
    for (int s = 0; s < 4; ++s) qf[s] = ld8(qp + 16 * s);
    f32x16 O[4];
    const bf16* sp = SR + ((size_t)(bh * 64 + n) * 128 + r) * 64 + 8 * hh;
    const float qd = __builtin_amdgcn_exp2f((float)(il + 1) * l2g);
#pragma unroll
    for (int e = 0; e < 4; ++e) { f32x16 a = zero16();
#pragma unroll
        for (int s = 0; s < 4; ++s) a = mfma32(ld8(sp + e * 32 * 64 + 16 * s), qf[s], a);
        O[e] = a * qd; }
    for (int jt = 0; jt <= it; ++jt) {
        const bf16* kp = NAT + (tok0 + 32 * jt + r) * NIN + C_RTK + h * 64 + 8 * hh;
        f32x16 s = zero16();
#pragma unroll
        for (int ks = 0; ks < 4; ++ks) s = mfma32(ld8(kp + 16 * ks), qf[ks], s);
        const int dq = il - 32 * jt - 4 * hh;
#pragma unroll
        for (int i = 0; i < 16; ++i) { const int d = dq - ROWOFF(i); s[i] = d >= 0 ? s[i] * __builtin_amdgcn_exp2f((float)d * l2g) : 0.f; }
        const bf16x8 pf0 = pack8<0>(s), pf1 = pack8<1>(s);
        const bf16* vp = VT + (size_t)(VT_RTV + h * 128 + r) * M + tok0 + 32 * jt + 4 * hh;
#pragma unroll
        for (int e = 0; e < 4; ++e) { O[e] = mfma32(ld44(vp + (size_t)e * 32 * M), pf0, O[e]); O[e] = mfma32(ld44(vp + (size_t)e * 32 * M + 16), pf1, O[e]); }
    }
    float sm = 0.f;
#pragma unroll
    for (int e = 0; e < 4; ++e)
#pragma unroll
        for (int i = 0; i < 16; ++i) sm += O[e][i];
    const float mean = half_sum(sm) * (1.f / 128.f);
    float sq = 0.f;
#pragma unroll
    for (int e = 0; e < 4; ++e)
#pragma unroll
        for (int i = 0; i < 16; ++i) { const float d = O[e][i] - mean; O[e][i] = d; sq += d * d; }
    const float rs = __builtin_amdgcn_rsqf(half_sum(sq) * (1.f / 128.f) + EPS);
    const bf16* gp = NAT + (tok0 + il) * NIN + C_RTG + h * 128 + 4 * hh;
#pragma unroll
    for (int e = 0; e < 4; ++e)
#pragma unroll
        for (int g = 0; g < 4; ++g) { const int d0 = 32 * e + 8 * g; const v2u gw = *(const v2u*)(gp + d0);
            const float g0 = bflo(gw.x), g1 = bfhi(gw.x), g2 = bflo(gw.y), g3 = bfhi(gw.y);
            v2u w; w.x = pg8::cvt_pk_bf16(O[e][4 * g] * rs * g0 * fsigmoid(g0), O[e][4 * g + 1] * rs * g1 * fsigmoid(g1));
            w.y = pg8::cvt_pk_bf16(O[e][4 * g + 2] * rs * g2 * fsigmoid(g2), O[e][4 * g + 3] * rs * g3 * fsigmoid(g3));
            ot_put(wl, r, hh, d0, w); }
    ot_emit(wl, YR + (tok0 + 32 * it) * 1024 + h * 128, 1, lane);
}

constexpr int HP_ROW = 136, HP_WAVE = 128 * HP_ROW;
static_assert(8 * HP_WAVE <= LDSCTL_OFF, "HGRN prep LDS map");
__device__ __forceinline__ float lb_of(const float* lbl, int layer, int c) {
    if (layer == 0) return 0.f;
    float mx = -INFINITY; for (int d = 0; d < DEPTH; ++d) mx = fmaxf(mx, lbl[d * 1024 + c]);
    float den = 0.f, num = 0.f;
    for (int d = 0; d < DEPTH; ++d) { const float e = __expf(lbl[d * 1024 + c] - mx); den += e; if (d >= 1 && d <= layer) num += e; }
    return num / den;
}
__device__ __forceinline__ void hgpu_unit(LAS unsigned char* wl, const bf16* NAT, const bf16* VT, const float* lbl, int layer, bf16* QT, bf16* KT, bf16* QC, float* DEC, float* UH, int bh, int n, int lane) {
    const int r = lane & 31, hh = lane >> 5, b = bh >> 3, h = bh & 7;
    const size_t t0 = (size_t)b * SEQ + 64 * n;
    const int c2 = h * 128 + 2 * lane;
    const float lb0 = lb_of(lbl, layer, c2), lb1 = lb_of(lbl, layer, c2 + 1), om0 = 1.f - lb0, om1 = 1.f - lb1;
    const unsigned* fp = (const unsigned*)(NAT + t0 * NIN + C_HGF + c2); const unsigned* qp = (const unsigned*)(NAT + t0 * NIN + C_HGQ + c2);
    float run0 = 0.f, run1 = 0.f, ref0 = 0.f, ref1 = 0.f;
#pragma unroll 1
    for (int jb = 0; jb < 4; ++jb) { unsigned fv[16];
#pragma unroll
        for (int k = 0; k < 16; ++k) fv[k] = fp[(size_t)(16 * jb + k) * (NIN / 2)];
#pragma unroll
        for (int k = 0; k < 16; ++k) { run0 += __logf(lb0 + om0 / (1.f + __expf(-bflo(fv[k])))); run1 += __logf(lb1 + om1 / (1.f + __expf(-bfhi(fv[k])))); }
        if (jb == 1) { ref0 = run0; ref1 = run1; } }
    const float bl0 = run0, bl1 = run1; run0 = 0.f; run1 = 0.f;
    unsigned* const QTu = (unsigned*)QT + (t0 * 1024 + c2) / 2; unsigned* const KTu = (unsigned*)KT + (t0 * 1024 + c2) / 2; unsigned* const QCu = (unsigned*)QC + (t0 * 1024 + c2) / 2;
    LAS unsigned char* kw = wl + (2 * lane) * HP_ROW;
#pragma unroll 1
    for (int jb = 0; jb < 4; ++jb) { unsigned fv[16], qv[16];
#pragma unroll
        for (int k = 0; k < 16; ++k) { fv[k] = fp[(size_t)(16 * jb + k) * (NIN / 2)]; qv[k] = qp[(size_t)(16 * jb + k) * (NIN / 2)]; }
        unsigned kp0 = 0u, kp1 = 0u;
#pragma unroll
        for (int k = 0; k < 16; ++k) { const int j = 16 * jb + k;
            const float lf0 = __logf(lb0 + om0 / (1.f + __expf(-bflo(fv[k])))), lf1 = __logf(lb1 + om1 / (1.f + __expf(-bfhi(fv[k]))));
            run0 += lf0; run1 += lf1;
            const float q0 = bflo(qv[k]), q1 = bfhi(qv[k]);
            const float qs0 = q0 / (1.f + __expf(-q0)), qs1 = q1 / (1.f + __expf(-q1)), kin0 = 1.f - __expf(lf0), kin1 = 1.f - __expf(lf1);
            QTu[(size_t)j * 512] = pk2(qs0 * __expf(run0 - ref0), qs1 * __expf(run1 - ref1));
            KTu[(size_t)j * 512] = pk2(kin0 * __expf(ref0 - run0), kin1 * __expf(ref1 - run1));
            QCu[(size_t)j * 512] = pk2(qs0 * __expf(run0), qs1 * __expf(run1));
            const unsigned k0b = f2bf(kin0 * __expf(bl0 - run0)), k1b = f2bf(kin1 * __expf(bl1 - run1));
            if (k & 1) { *(LAS unsigned*)(kw + 2 * (j - 1)) = kp0 | (k0b << 16); *(LAS unsigned*)(kw + HP_ROW + 2 * (j - 1)) = kp1 | (k1b << 16); } else { kp0 = k0b; kp1 = k1b; } } }
    { float2 dv; dv.x = __expf(bl0); dv.y = __expf(bl1); *(float2*)(DEC + (size_t)(b * 128 + n) * 1024 + c2) = dv; }
    const LAS unsigned char* kr = wl + r * HP_ROW + 16 * hh;
#pragma unroll 1
    for (int et = 0; et < 4; ++et) {
        const bf16* ap = VT + (size_t)(VT_HGI + h * 128 + 32 * et + r) * M + t0 + 8 * hh;
        bf16x8 af[4];
#pragma unroll
        for (int s2 = 0; s2 < 4; ++s2) af[s2] = ld8(ap + 16 * s2);
        float* up = UH + ((size_t)(bh * 128 + n) * 128 + 32 * et + 4 * hh) * 128 + r;
#pragma unroll
        for (int ct = 0; ct < 4; ++ct) { f32x16 a = zero16();
#pragma unroll
            for (int s2 = 0; s2 < 4; ++s2) { const LAS unsigned char* p = kr + ct * 32 * HP_ROW + 32 * s2;
                const bf16x4 lo = *(const LAS bf16x4*)p, hi = *(const LAS bf16x4*)(p + 8);
                a = mfma32(af[s2], __builtin_shufflevector(lo, hi, 0, 1, 2, 3, 4, 5, 6, 7), a); }
#pragma unroll
            for (int i = 0; i < 16; ++i) up[ROWOFF(i) * 128 + 32 * ct] = a[i]; }
    }
}
__device__ __forceinline__ void hg_out_unit(LAS unsigned char* wl, const bf16* NAT, const bf16* VT, const bf16* QT, const bf16* KT, const bf16* QC, const bf16* SH, const float* normg, bf16* YC, int bh, int n, int it, int lane) {
    const int r = lane & 31, hh = lane >> 5, b = bh >> 3, h = bh & 7;
    const size_t tok0 = (size_t)b * SEQ + 64 * n;
    const int il = 32 * it + r;
    f32x16 O[4];
#pragma unroll
    for (int e = 0; e < 4; ++e) O[e] = zero16();
    {
        const bf16* sp = SH + ((size_t)(bh * 128 + n) * 128 + r) * 128 + 8 * hh;
        const bf16* qc = QC + (tok0 + il) * 1024 + h * 128 + 8 * hh;
#pragma unroll
        for (int s = 0; s < 8; ++s) { const bf16x8 qf = ld8(qc + 16 * s);
#pragma unroll
            for (int e = 0; e < 4; ++e) O[e] = mfma32(ld8(sp + e * 32 * 128 + 16 * s), qf, O[e]); }
    }
    const bf16* qp = QT + (tok0 + il) * 1024 + h * 128 + 8 * hh;
    bf16x8 qf[8];
#pragma unroll
    for (int s = 0; s < 8; ++s) qf[s] = ld8(qp + 16 * s);
    for (int jt = 0; jt <= it; ++jt) {
        const bf16* kp = KT + (tok0 + 32 * jt + r) * 1024 + h * 128 + 8 * hh;
        f32x16 s = zero16();
#pragma unroll
        for (int ks = 0; ks < 8; ++ks) s = mfma32(ld8(kp + 16 * ks), qf[ks], s);
        const int dq = il - 32 * jt - 4 * hh;
#pragma unroll
        for (int i = 0; i < 16; ++i) s[i] = (dq - ROWOFF(i) >= 0) ? s[i] : 0.f;
        const bf16x8 pf0 = pack8<0>(s), pf1 = pack8<1>(s);
        const bf16* vp = VT + (size_t)(VT_HGI + h * 128 + r) * M + tok0 + 32 * jt + 4 * hh;
#pragma unroll
        for (int e = 0; e < 4; ++e) { O[e] = mfma32(ld44(vp + (size_t)e * 32 * M), pf0, O[e]); O[e] = mfma32(ld44(vp + (size_t)e * 32 * M + 16), pf1, O[e]); }
    }
    float sq = 0.f;
#pragma unroll
    for (int e = 0; e < 4; ++e)
#pragma unroll
        for (int i = 0; i < 16; ++i) sq += O[e][i] * O[e][i];
    const float rs = __builtin_amdgcn_rsqf(half_sum(sq) * (1.f / 128.f) + EPS);
    const bf16* gp = NAT + (tok0 + il) * NIN + C_HGG + h * 128 + 4 * hh;
#pragma unroll
    for (int e = 0; e < 4; ++e)
#pragma unroll
        for (int g = 0; g < 4; ++g) { const int d0 = 32 * e + 8 * g; const v2u gw = *(const v2u*)(gp + d0); const f32x4 ng = *(const f32x4*)(normg + d0 + 4 * hh);
            const float g0 = bflo(gw.x), g1 = bfhi(gw.x), g2 = bflo(gw.y), g3 = bfhi(gw.y);
            v2u w; w.x = pg8::cvt_pk_bf16(O[e][4 * g] * rs * ng.x * g0 * fsigmoid(g0), O[e][4 * g + 1] * rs * ng.y * g1 * fsigmoid(g1));
            w.y = pg8::cvt_pk_bf16(O[e][4 * g + 2] * rs * ng.z * g2 * fsigmoid(g2), O[e][4 * g + 3] * rs * ng.w * g3 * fsigmoid(g3));
            ot_put(wl, r, hh, d0, w); }
    ot_emit(wl, YC + (tok0 + 32 * it) * 1024 + h * 128, 1, lane);
}

__device__ __forceinline__ void ln_stage_gb(LAS unsigned char* lds, const float* g, const float* bb, int tid) {
    const GAS f32x4* gs = (const GAS f32x4*)g; const GAS f32x4* bs = (const GAS f32x4*)bb;
#pragma unroll
    for (int j = 0; j < 2; ++j) { ((LAS f32x4*)lds)[tid + 512 * j] = gs[tid + 512 * j]; ((LAS f32x4*)(lds + DM * 4))[tid + 512 * j] = bs[tid + 512 * j]; }
    __syncthreads();
}
__device__ __forceinline__ void unpack8(const v4u a, f32x4& lo, f32x4& hi) { lo = (f32x4){bflo(a.x), bfhi(a.x), bflo(a.y), bfhi(a.y)}; hi = (f32x4){bflo(a.z), bfhi(a.z), bflo(a.w), bfhi(a.w)}; }
template <bool HBF>
__device__ __forceinline__ void ln_row(const LAS unsigned char* lds, const void* hin, const bf16* add, float* of, bf16* ob, bf16* op4, bf16* op16, int lane) {
    const GAS v4u* ar = (const GAS v4u*)add + lane;
    f32x4 v[16]; float s = 0.f;
    if constexpr (HBF) { const GAS v4u* hr = (const GAS v4u*)hin + lane;
        v4u ha[8], aa[8];
#pragma unroll
        for (int j = 0; j < 8; ++j) { ha[j] = hr[64 * j]; aa[j] = ar[64 * j]; }
#pragma unroll
        for (int j = 0; j < 8; ++j) { f32x4 h0, h1, a0, a1; unpack8(ha[j], h0, h1); unpack8(aa[j], a0, a1); v[2 * j] = h0 * ALPHA + a0; v[2 * j + 1] = h1 * ALPHA + a1; }
    } else { const GAS f32x4* hr = (const GAS f32x4*)hin + 2 * lane;
        v4u aa[8];
#pragma unroll
        for (int j = 0; j < 8; ++j) { v[2 * j] = hr[128 * j]; v[2 * j + 1] = hr[128 * j + 1]; aa[j] = ar[64 * j]; }
#pragma unroll
        for (int j = 0; j < 8; ++j) { f32x4 a0, a1; unpack8(aa[j], a0, a1); v[2 * j] = v[2 * j] * ALPHA + a0; v[2 * j + 1] = v[2 * j + 1] * ALPHA + a1; }
    }
#pragma unroll
    for (int j = 0; j < 16; ++j) s += (v[j].x + v[j].y) + (v[j].z + v[j].w);
    const float mean = wave_sum(s) * (1.f / DM); float s2 = 0.f;
#pragma unroll
    for (int j = 0; j < 16; ++j) { v[j] = v[j] - mean; s2 += (v[j].x * v[j].x + v[j].y * v[j].y) + (v[j].z * v[j].z + v[j].w * v[j].w); }
    const float rstd = 1.f / sqrtf(wave_sum(s2) * (1.f / DM) + EPS);
    const LAS f32x4* gr = (const LAS f32x4*)lds + 2 * lane; const LAS f32x4* br = (const LAS f32x4*)(lds + DM * 4) + 2 * lane;
#pragma unroll
    for (int j = 0; j < 8; ++j) { const f32x4 o0 = v[2 * j] * rstd * gr[128 * j] + br[128 * j], o1 = v[2 * j + 1] * rstd * gr[128 * j + 1] + br[128 * j + 1];
        if (of) { ((GAS f32x4*)of + 2 * lane)[128 * j] = o0; ((GAS f32x4*)of + 2 * lane)[128 * j + 1] = o1; }
        v4u w; w.x = pk2(o0.x, o0.y); w.y = pk2(o0.z, o0.w); w.z = pk2(o1.x, o1.y); w.w = pk2(o1.z, o1.w);
        if (ob) ((GAS v4u*)ob + lane)[64 * j] = w;
        if (op4) { ((GAS v4u*)op4 + lane)[64 * j] = w; ((GAS v4u*)op16 + lane)[64 * j] = w; }
        if (j & 1) __builtin_amdgcn_sched_barrier(0); }
}

constexpr int WPRIV = 17920;
static_assert(WPRIV >= DL_WAVE && WPRIV >= HP_WAVE && WPRIV >= RU_WAVE && 8 * WPRIV <= LDSCTL_OFF, "wave-private LDS stride");
__global__ void __launch_bounds__(NWAVES * 64, 2) mk_fwd(Args args) {
    extern __shared__ __attribute__((aligned(16))) unsigned char lds[];
    Frame F;
    F.lds = (LAS unsigned char*)lds;
    volatile LAS unsigned* MISC = (volatile LAS unsigned*)(F.lds + MISC_OFF);
    F.tid = threadIdx.x; F.lane = F.tid & 63; F.wave = __builtin_amdgcn_readfirstlane(F.tid >> 6);
    F.G = gridDim.x; { const int bx = blockIdx.x; F.vcu = (F.G % 8 == 0) ? (bx % 8) * (F.G / 8) + bx / 8 : bx; }
    F.ws = args.ws; F.ctl = (gu32*)(args.ws + WS_CTL);
    unsigned char* ws = args.ws;
    for (int u = F.tid; u < (LDS_BYTES - LDSCTL_OFF) / 4; u += NWAVES * 64) ((LAS unsigned*)(F.lds + LDSCTL_OFF))[u] = 0u;
    __syncthreads();
#if MK_PER_PHASE
    XcdBarrier bar; bar.bar = nullptr; bar.x = 0; bar.st = nullptr;
#define GRID_BAR() do { } while (0)
#else
    XcdBarrier bar = xcd_barrier_post((unsigned*)(F.ctl + CW_BAR), MISC + 8);
#define GRID_BAR() do { xcd_barrier(bar); if (DUP_BAR) xcd_barrier(bar); } while (0)
#endif
    const int lo = args.ph_lo, hi = args.ph_hi;
#define IN(k) (lo <= (k) && (k) < hi)
#define SEAM(k) do { if (IN(k) && IN((k) + 1)) GRID_BAR(); } while (0)
    const int NGW = F.G * NWAVES;
#define PHASE_IDS() int tid = threadIdx.x; asm volatile("" : "+v"(tid)); const int lane = tid & 63; const int gw = F.vcu * NWAVES + __builtin_amdgcn_readfirstlane(tid >> 6); (void)lane; (void)gw

#define AB   ((bf16*)(ws + WS_AB))
#define XP4  ((bf16*)(ws + WS_XP4))
#define XP16 ((bf16*)(ws + WS_XP16))
#define NAT  ((bf16*)(ws + WS_NAT))
#define VT   ((bf16*)(ws + WS_VT))
#define HQT  ((bf16*)(ws + WS_HQT))
#define HKT  ((bf16*)(ws + WS_HKT))
#define HQC  ((bf16*)(ws + WS_HQC))
#define HKH  ((bf16*)(ws + WS_HKH))
#define DEC  ((float*)(ws + WS_DEC))
#define UR   ((float*)(ws + WS_UR))
#define UH   ((float*)(ws + WS_UH))
#define SR   ((bf16*)(ws + WS_SR))
#define SH   ((bf16*)(ws + WS_SH))
#define YB   ((bf16*)(ws + WS_Y))
#define MRG  ((bf16*)(ws + WS_MRG))
#define MRGB ((bf16*)(ws + WS_MRGB))
#define H1   ((float*)(ws + WS_H1))
#define H2   ((float*)(ws + WS_H2))
#define EDG  ((float*)(ws + WS_UUP))
#define ACT  ((bf16*)(ws + WS_ACT))

    if (PHEN(0) && IN(0)) { for (int rep = 0; rep < NREP(0); ++rep) { p0_prologue(F); if (rep + 1 < NREP(0)) GRID_BAR(); } }
    SEAM(0);

    for (int l = 0; l < DEPTH; ++l) {
        const int pb = 1 + 12 * l;


        if (PHEN(1) && IN(pb + 0)) for (int rep = 0; rep < NREP(1); ++rep) { PHASE_IDS(); if (rep) GRID_BAR();
            EpiInProj E{NAT, VT, (bf16*)(ws + WS_DAK), (bf16*)(ws + WS_DLK)};
            { InProjSched<0> S{F.G, (int)blockIdx.x, AB, (const bf16*)(ws + WS_WIN + l * WIN_L)}; pg8::gemm_phase<EpiInProj, InProjSched<0>, true, true, 1>(F.lds, DM, S, E, tid); }
            { InProjSched<1> S{F.G, (int)blockIdx.x, AB, (const bf16*)(ws + WS_WIN + l * WIN_L)}; pg8::gemm_phase<EpiInProj, InProjSched<1>, true, true, 4>(F.lds, DM, S, E, tid); }
            { InProjSched<2> S{F.G, (int)blockIdx.x, AB, (const bf16*)(ws + WS_WIN + l * WIN_L)}; pg8::gemm_phase<EpiInProj, InProjSched<2>, true, true, 16>(F.lds, DM, S, E, tid); }
        }
        SEAM(pb + 0);

        if (PHEN(2) && IN(pb + 1)) for (int rep = 0; rep < NREP(2); ++rep) { PHASE_IDS(); if (rep) GRID_BAR();
            for (int it = gw; it < 16 * 128; it += NGW) hgpu_unit(F.lds + (tid >> 6) * WPRIV, NAT, VT, INP(4), l, HQT, HKT, HQC, DEC, UH, it >> 7, it & 127, lane);
            if ((gw & 7) < 4)
                for (int it = (gw >> 3) * 4 + (gw & 7); it < 16 * 64; it += (NGW >> 1)) retu_unit(F.lds + (tid >> 6) * WPRIV, NAT, VT, UR, it >> 6, it & 63, lane);
            {
                float mq = 0.f, mk = 0.f;
                for (int m0 = gw; m0 < M; m0 += 4 * NGW) {
                    v4u a0[4], a1[4], b0[4], b1[4];
#pragma unroll
                    for (int i = 0; i < 4; ++i) { const int m = (m0 + i * NGW) < M ? m0 + i * NGW : m0;
                        const bf16* qr = NAT + (size_t)m * NIN + C_DAQ + 16 * lane;
                        const bf16* kr = (const bf16*)(ws + WS_DAK) + ((size_t)((m / SEQ) * 8 + (lane >> 3)) * SEQ + (m % SEQ)) * 128 + 16 * (lane & 7);
                        a0[i] = *(const v4u*)qr; a1[i] = *(const v4u*)(qr + 8); b0[i] = *(const v4u*)kr; b1[i] = *(const v4u*)(kr + 8); }
#pragma unroll
                    for (int i = 0; i < 4; ++i) { float sq = 0.f, sk = 0.f;
#pragma unroll
                        for (int e = 0; e < 4; ++e) { sq += bflo(a0[i][e]) * bflo(a0[i][e]) + bfhi(a0[i][e]) * bfhi(a0[i][e]) + bflo(a1[i][e]) * bflo(a1[i][e]) + bfhi(a1[i][e]) * bfhi(a1[i][e]);
                                                      sk += bflo(b0[i][e]) * bflo(b0[i][e]) + bfhi(b0[i][e]) * bfhi(b0[i][e]) + bflo(b1[i][e]) * bflo(b1[i][e]) + bfhi(b1[i][e]) * bfhi(b1[i][e]); }
                        sq += __shfl_xor(sq, 1); sq += __shfl_xor(sq, 2); sk += __shfl_xor(sk, 1); sk += __shfl_xor(sk, 2);
                        mq = fmaxf(mq, sq); mk = fmaxf(mk, sk); }
                }
                if ((lane & 3) == 0) { gu32* nb = F.ctl + CW_NRM + 64 * l + (lane >> 3) * 4 + ((lane >> 2) & 1);
                    __hip_atomic_fetch_max(nb, __float_as_uint(mq), RLX_AGENT); __hip_atomic_fetch_max(nb + 2, __float_as_uint(mk), RLX_AGENT); }
            }
        }
        SEAM(pb + 1);

        if ((PHEN(3) || PHEN(4)) && IN(pb + 2)) for (int rep = 0; rep < NREP(3); ++rep) { PHASE_IDS(); if (rep) GRID_BAR();
            for (int e = F.vcu * 512 + tid; e < 16 * 8192; e += F.G * 512) {
                const int bh = e >> 13, h = bh & 7; const float cd = __builtin_amdgcn_exp2f(128.f * ret_log2g(h));
                const float* up = UR + (size_t)bh * 64 * 8192 + (e & 8191); bf16* sp = SR + (size_t)bh * 64 * 8192 + (e & 8191);
                float s = 0.f;
                for (int n0 = 0; n0 < 64; n0 += 32) { float uv[32];
#pragma unroll
                    for (int k = 0; k < 32; ++k) uv[k] = up[(size_t)(n0 + k) * 8192];
#pragma unroll
                    for (int k = 0; k < 32; ++k) { sp[(size_t)(n0 + k) * 8192] = (bf16)f2bf(s); s = cd * s + uv[k]; } }
            }
            {
                const int stride = F.G * 512;
                for (int e = F.vcu * 512 + tid; e < 16 * 16384; e += 2 * stride) {
                    const bool two = (e + stride) < 16 * 16384; const int e1 = two ? e + stride : e;
                    const int bh0 = e >> 14, bh1 = e1 >> 14;
                    const float* up0 = UH + (size_t)bh0 * 128 * 16384 + (e & 16383); bf16* sp0 = SH + (size_t)bh0 * 128 * 16384 + (e & 16383);
                    const float* up1 = UH + (size_t)bh1 * 128 * 16384 + (e1 & 16383); bf16* sp1 = SH + (size_t)bh1 * 128 * 16384 + (e1 & 16383);
                    const float* dp0 = DEC + (size_t)(bh0 >> 3) * 128 * 1024 + (bh0 & 7) * 128 + (e & 127);
                    const float* dp1 = DEC + (size_t)(bh1 >> 3) * 128 * 1024 + (bh1 & 7) * 128 + (e1 & 127);
                    float s0 = 0.f, s1 = 0.f;
                    for (int n0 = 0; n0 < 128; n0 += 32) { float u0[32], d0[32], u1[32], d1[32];
#pragma unroll
                        for (int k = 0; k < 32; ++k) { u0[k] = up0[(size_t)(n0 + k) * 16384]; d0[k] = dp0[(size_t)(n0 + k) * 1024]; u1[k] = up1[(size_t)(n0 + k) * 16384]; d1[k] = dp1[(size_t)(n0 + k) * 1024]; }
#pragma unroll
                        for (int k = 0; k < 32; ++k) { sp0[(size_t)(n0 + k) * 16384] = (bf16)f2bf(s0); s0 = d0[k] * s0 + u0[k];
                            if (two) sp1[(size_t)(n0 + k) * 16384] = (bf16)f2bf(s1); s1 = d1[k] * s1 + u1[k]; } }
                }
            }
        }
        SEAM(pb + 2); if (IN(pb + 2) && !IN(pb + 3) && IN(pb + 4)) GRID_BAR();

        if (PHEN(5) && IN(pb + 4)) for (int rep = 0; rep < NREP(5); ++rep) { PHASE_IDS(); if (rep) GRID_BAR();
            gu32* wq = F.ctl + CW_WQ + 64 * 4 * (l + 2 * rep);
            {
                const float* lv = INP(2) + l * 256;
                const float p01 = wave_sum(lv[lane] * lv[64 + lane]), p23 = wave_sum(lv[128 + lane] * lv[192 + lane]);
                const float lam_init = 0.8f - 0.6f * __expf(-0.3f * (float)l);
                const float lam = __expf(p01) - __expf(p23) + lam_init;
                const float* ng = INP(3) + l * 128;
                volatile LAS unsigned* wqw = (volatile LAS unsigned*)(F.lds + MISC_OFF);
                for (int rp = 0; rp < NMIX(0); ++rp)
                for (;;) {
                    if (tid == 0) wqw[0] = __hip_atomic_fetch_add(wq + 2048 * rp, 1u, RLX_AGENT);
                    __syncthreads();
                    const int it = (int)wqw[0];
                    if (it >= 16 * 32) break;
                    diff_block(F.lds, (volatile LAS unsigned*)(F.lds + MISC_OFF + 64), (const unsigned*)(F.ctl + CW_NRM + 64 * l), NAT, (const bf16*)(ws + WS_DAK), VT, YB, ng, lam, 1.f - lam_init, (it & 15) >> 3, it & 7, 31 - (it >> 4), tid);
                }
            }
            __syncthreads();
            for (int rp = 0; rp < NMIX(1); ++rp)
            for (;;) { const int it = wq_pull(wq + 64 + 2048 * rp, lane); if (it >= 16 * 256) break;
                dil_unit(F.lds + (tid >> 6) * WPRIV, NAT, (const bf16*)(ws + WS_DLK), VT, YB + (size_t)3 * M * 1024, it >> 11, (it >> 8) & 7, (it >> 4) & 15, it & 15, lane); }
            for (int rp = 0; rp < NMIX(2); ++rp)
            for (;;) { const int it = wq_pull(wq + 128 + 2048 * rp, lane); if (it >= 16 * 64 * 4) break;
                ret_out_unit(F.lds + (tid >> 6) * WPRIV, NAT, VT, SR, YB + (size_t)1 * M * 1024, it >> 8, (it >> 2) & 63, it & 3, lane); }
            {   const float* ng = INP(5) + l * 128;
                for (int rp = 0; rp < NMIX(3); ++rp)
                for (;;) { const int it = wq_pull(wq + 192 + 2048 * rp, lane); if (it >= 16 * 128 * 2) break;
                    hg_out_unit(F.lds + (tid >> 6) * WPRIV, NAT, VT, HQT, HKT, HQC, SH, ng, YB + (size_t)2 * M * 1024, it >> 8, (it >> 1) & 127, it & 1, lane); } }
        }
        SEAM(pb + 4);

        if (PHEN(6) && IN(pb + 5)) for (int rep = 0; rep < NREP(6); ++rep) { PHASE_IDS(); if (rep) GRID_BAR();
            MergeSched S{F.G, (int)blockIdx.x, YB, (const bf16*)(ws + WS_WBR + l * WBR_L)};
            EpiMerge E{NAT, MRGB};
            pg8::gemm_phase<EpiMerge, MergeSched, true, true>(F.lds, 1024, S, E, tid);
        }
        SEAM(pb + 5);

        if (PHEN(7) && IN(pb + 6)) for (int rep = 0; rep < NREP(7); ++rep) { PHASE_IDS(); if (rep) GRID_BAR();
            PlainSched S{F.G, (int)blockIdx.x, 16, DM, MRGB, (const bf16*)(ws + WS_WO + l * WO_L)};
            EpiBf16 E{MRG, DM};
            pg8::gemm_phase<EpiBf16, PlainSched, true, true>(F.lds, DM, S, E, tid);
        }
        SEAM(pb + 6);

        if (PHEN(8) && IN(pb + 7)) for (int rep = 0; rep < NREP(8); ++rep) { PHASE_IDS(); if (rep) GRID_BAR();
            const float* g = INP(8) + l * DM; const float* bb = INP(9) + l * DM;
            ln_stage_gb(F.lds, g, bb, tid);
            if (l == 0) { const float* hin = INP(0);
                for (int m = gw; m < M; m += NGW) ln_row<false>(F.lds, hin + (size_t)m * DM, MRG + (size_t)m * DM, nullptr, AB + (size_t)m * DM, nullptr, nullptr, lane);
            } else {
                for (int m = gw; m < M; m += NGW) ln_row<true>(F.lds, AB + (size_t)m * DM, MRG + (size_t)m * DM, nullptr, AB + (size_t)m * DM, nullptr, nullptr, lane); }
        }
        SEAM(pb + 7);

        if (PHEN(9) && IN(pb + 8)) for (int rep = 0; rep < NREP(9); ++rep) { PHASE_IDS(); if (rep) GRID_BAR();
            PlainSched S{F.G, (int)blockIdx.x, NUP / 256, DM, AB, (const bf16*)(ws + WS_WUP + l * WUP_L)};
            EpiAct E{ACT, INP(11) + (size_t)l * 3 * DFF, INP(12) + (size_t)l * DFF, EDG, EDG + (size_t)256 * DFF, EDG + (size_t)512 * DFF};
            pg8::gemm_phase<EpiAct, PlainSched, true, true>(F.lds, DM, S, E, tid);
        }
        SEAM(pb + 8);

        if (PHEN(10) && IN(pb + 9)) for (int rep = 0; rep < NREP(10); ++rep) { PHASE_IDS(); if (rep) GRID_BAR();
            const float* cw = INP(11) + (size_t)l * 3 * DFF; const float* cb = INP(12) + (size_t)l * DFF;
            const float* EA = EDG; const float* EG = EDG + (size_t)256 * DFF; const float* EL = EDG + (size_t)512 * DFF;
            constexpr int NC4 = DFF / 4;
            for (int it = F.vcu * 512 + tid; it < 128 * NC4; it += F.G * 512) {
                const int seg = it / NC4, c = 4 * (it % NC4); const bool first = (seg % (SEQ / 128)) == 0;
                const f32x4 z = (f32x4){0.f, 0.f, 0.f, 0.f};
                const f32x4 am2 = first ? z : *(const f32x4*)(EL + (size_t)(seg * 2 - 2) * DFF + c), am1 = first ? z : *(const f32x4*)(EL + (size_t)(seg * 2 - 1) * DFF + c);
                const f32x4 a0 = *(const f32x4*)(EA + (size_t)(seg * 2) * DFF + c), a1 = *(const f32x4*)(EA + (size_t)(seg * 2 + 1) * DFF + c);
                const f32x4 g0 = *(const f32x4*)(EG + (size_t)(seg * 2) * DFF + c), g1 = *(const f32x4*)(EG + (size_t)(seg * 2 + 1) * DFF + c);
                const f32x4 w0 = *(const f32x4*)(cw + c), w1 = *(const f32x4*)(cw + DFF + c), w2 = *(const f32x4*)(cw + 2 * DFF + c), bc = *(const f32x4*)(cb + c);
                const f32x4 c0v = bc + w0 * am2 + w1 * am1 + w2 * a0, c1v = bc + w0 * am1 + w1 * a0 + w2 * a1;
                v2u o0, o1;
                o0.x = pk2(gelu1(c0v.x) * g0.x, gelu1(c0v.y) * g0.y); o0.y = pk2(gelu1(c0v.z) * g0.z, gelu1(c0v.w) * g0.w);
                o1.x = pk2(gelu1(c1v.x) * g1.x, gelu1(c1v.y) * g1.y); o1.y = pk2(gelu1(c1v.z) * g1.z, gelu1(c1v.w) * g1.w);
                *(v2u*)(ACT + (size_t)(seg * 128) * DFF + c) = o0; *(v2u*)(ACT + (size_t)(seg * 128 + 1) * DFF + c) = o1;
            }
        }
        SEAM(pb + 9);

        if (PHEN(11) && IN(pb + 10)) for (int rep = 0; rep < NREP(11); ++rep) { PHASE_IDS(); if (rep) GRID_BAR();
            PlainSched S{F.G, (int)blockIdx.x, 16, DFF, ACT, (const bf16*)(ws + WS_WDN + l * WDN_L)};
            EpiBf16 E{MRG, DM};
            pg8::gemm_phase<EpiBf16, PlainSched, true, true>(F.lds, DFF, S, E, tid);
        }
        SEAM(pb + 10);

        if (PHEN(12) && IN(pb + 11)) for (int rep = 0; rep < NREP(12); ++rep) { PHASE_IDS(); if (rep) GRID_BAR();
            const float* g = INP(14) + l * DM; const float* bb = INP(15) + l * DM;
            const bool lastl = (l == DEPTH - 1); float* hout = (float*)INP(16);
            ln_stage_gb(F.lds, g, bb, tid);
            for (int m = gw; m < M; m += NGW)
                ln_row<true>(F.lds, AB + (size_t)m * DM, MRG + (size_t)m * DM, lastl ? hout + (size_t)m * DM : nullptr, lastl ? nullptr : AB + (size_t)m * DM, nullptr, nullptr, lane);
        }
        if (l + 1 < DEPTH) SEAM(pb + 11);
    }
#undef IN
#undef SEAM
}

constexpr int N_PHASES = 1 + 12 * DEPTH;
extern "C" void kernel_launch(void* const* d_in, const int* in_sizes, int n_in, void* d_out, int out_size, void* d_ws, size_t ws_size, hipStream_t stream) {
    static int grid = 0;
    if (grid == 0) {
        if (n_in != 16 || in_sizes[0] != M * DM || out_size != M * DM || ws_size < WS_END) { fprintf(stderr, "kernel_launch: unexpected shapes / workspace (n_in %d, ws %zu < %zu)\n", n_in, ws_size, (size_t)WS_END); grid = -1; return; }
        int dev = 0, cus = 0, per_cu = 0;
        if (hipGetDevice(&dev) != hipSuccess || hipDeviceGetAttribute(&cus, hipDeviceAttributeMultiprocessorCount, dev) != hipSuccess) { grid = -1; return; }
        if (hipFuncSetAttribute((const void*)mk_fwd, hipFuncAttributeMaxDynamicSharedMemorySize, LDS_BYTES) != hipSuccess) { fprintf(stderr, "kernel_launch: hipFuncSetAttribute failed\n"); grid = -1; return; }
        if (hipOccupancyMaxActiveBlocksPerMultiprocessor(&per_cu, (const void*)mk_fwd, NWAVES * 64, LDS_BYTES) != hipSuccess || per_cu < 1)
            fprintf(stderr, "kernel_launch: note: occupancy query reports %d workgroups per CU\n", per_cu);
        (void)hipGetLastError();
        grid = cus;
    }
    if (grid < 0) return;
    if (hipMemsetAsync((char*)d_ws + WS_CTL, 0, CTL_ZERO_BYTES, stream) != hipSuccess) { fprintf(stderr, "kernel_launch: memset failed\n"); return; }
    Args a{};
    for (int i = 0; i < 16; ++i) a.in[i] = (const float*)d_in[i];
    a.out = (float*)d_out; a.ws = (unsigned char*)d_ws;
#if MK_PER_PHASE
    for (int p = 0; p < N_PHASES; ++p) { a.ph_lo = p; a.ph_hi = p + 1; hipLaunchKernelGGL(mk_fwd, dim3(grid), dim3(NWAVES * 64), LDS_BYTES, stream, a); }
#else
    a.ph_lo = 0; a.ph_hi = N_PHASES;
    hipLaunchKernelGGL(mk_fwd, dim3(grid), dim3(NWAVES * 64), LDS_BYTES, stream, a);
#endif
    const hipError_t le = hipPeekAtLastError();
    if (le != hipSuccess) fprintf(stderr, "kernel_launch: launch failed: %s\n", hipGetErrorName(le));
}
```

```cpp
#include <hip/hip_runtime.h>
#include <cstdio>
#include <cstdint>

#ifndef MK_PER_PHASE
#define MK_PER_PHASE 0
#endif
#ifndef PH_MASK
#define PH_MASK 0x1fff
#endif
#define PHEN(k) (((PH_MASK) >> (k)) & 1)
#ifndef REP_MASK
#define REP_MASK 0
#endif
#define NREP(k) ((((REP_MASK) >> (k)) & 1) ? 2 : 1)
#ifndef MIX_REP
#define MIX_REP 0
#endif
#define NMIX(k) ((((MIX_REP) >> (k)) & 1) ? 2 : 1)
#ifndef DUP_BAR
#define DUP_BAR 0
#endif
#ifndef DUP_EPI
#define DUP_EPI 0
#endif

namespace pg8 {
#define PG8_LAS __attribute__((address_space(3)))
typedef unsigned short bf16_t;
typedef short bf16x8 __attribute__((ext_vector_type(8)));
typedef float f32x4 __attribute__((ext_vector_type(4)));
typedef unsigned u32x4 __attribute__((ext_vector_type(4)));
typedef unsigned u32x2 __attribute__((ext_vector_type(2)));
typedef float f32x2 __attribute__((ext_vector_type(2)));
constexpr int BM = 256, BK = 64, HALF = 128, HTB = HALF * BK * 2, STAGE_BYTES = 8 * HTB, NXCD = 8, WGM = 4;

__host__ __device__ __forceinline__ int lds_byte(int r, int c) { const int st = (r >> 4) * 2 + (c >> 5), rr = r & 15, cc = c & 31, ob = rr * 64 + cc * 2; return st * 1024 + (ob ^ (((ob >> 9) & 1) << 5)); }
__host__ __device__ __forceinline__ void stage_rc(int b, int& R, int& C) { const int st = b / 1024, sb = b % 1024, swz = sb ^ (((sb >> 9) & 1) << 5); R = (st >> 1) * 16 + swz / 64; C = (st & 1) * 32 + (swz % 64) / 2; }
__host__ __device__ __forceinline__ int perm32(int rho) { const int n = rho >> 4, i = rho & 15; return 8 * (i >> 2) + 4 * n + (i & 3); }

struct Unit { int pm, pn, kind; };

__device__ __forceinline__ void tile_map(int wgid, int nM, int nN, int& pm, int& pn) {
    const int nwg = nM * nN;
    { const int q = nwg / NXCD, r = nwg % NXCD, xcd = wgid % NXCD, off = wgid / NXCD; wgid = (xcd < r ? xcd * (q + 1) : r * (q + 1) + (xcd - r) * q) + off; }
    const int nig = WGM * nN, gid = wgid / nig, fm = gid * WGM, gsz = (nM - fm) < WGM ? (nM - fm) : WGM;
    pm = fm + ((wgid % nig) % gsz); pn = (wgid % nig) / gsz;
}

__device__ __forceinline__ unsigned cvt_pk_bf16(float lo, float hi) { unsigned r; asm volatile("v_cvt_pk_bf16_f32 %0, %1, %2" : "=v"(r) : "v"(lo), "v"(hi)); return r; }

template <class Epi, class Sched, bool ALIGN_EPI, bool SP2, int BSTRIDE = 1>
__device__ __forceinline__ void gemm_phase(PG8_LAS unsigned char* lds, const int K, const Sched& S, const Epi& E, const int tid) {
    constexpr int bstride = BSTRIDE;
    const int wid = __builtin_amdgcn_readfirstlane(tid >> 6), lane = tid & 63, wr = wid >> 2, wc = wid & 3, fr = lane & 15, fq = lane >> 4;
    const int nt = K / BK;
    unsigned voffA[2], voffB[2];
#pragma unroll
    for (int i = 0; i < 2; ++i) { int R, C; stage_rc(tid * 16 + i * 8192, R, C); const int Rb = Epi::PERM ? ((R & ~31) + perm32(R & 31)) : R;
        const int Ra = Epi::APERM ? (128 * (R >> 6) + 8 * (R & 15) + ((R >> 4) & 3)) : R;
        voffA[i] = (unsigned)(Ra * K + C) * 2u; voffB[i] = (unsigned)(Rb * bstride * K + C) * 2u; }
    const size_t kstep = (size_t)(BK * 2);
    const size_t hstepB = (size_t)HALF * K * 2 * bstride, hstepA = Epi::APERM ? (size_t)4 * K * 2 : (size_t)HALF * K * 2;
    const unsigned ldsw = (unsigned)wid * 1024u;
    const int aoff = lds_byte(wr * 64 + fr, fq * 8), boff = lds_byte(wc * 32 + fr, fq * 8);
#define PG8_SA(b, h) (((b) * 2 + (h)) * HTB)
#define PG8_SB(b, h) ((4 + (b) * 2 + (h)) * HTB)
#define PG8_STAGE(bufoff, gbase, voff) do { _Pragma("unroll") for (int _i = 0; _i < 2; ++_i) \
        __builtin_amdgcn_global_load_lds((const unsigned*)((const char*)(gbase) + (voff)[_i]), (PG8_LAS unsigned*)(lds + (bufoff) + ldsw + _i * 8192), 16, 0, 0); } while (0)
#define PG8_LDA(dst, b, h) do { _Pragma("unroll") for (int m = 0; m < 4; ++m) _Pragma("unroll") for (int k = 0; k < 2; ++k) dst[m][k] = *(const PG8_LAS bf16x8*)(lds + PG8_SA(b, h) + aoff + m * 2048 + k * 1024); } while (0)
#define PG8_LDB(dst, b, h) do { _Pragma("unroll") for (int n = 0; n < 2; ++n) _Pragma("unroll") for (int k = 0; k < 2; ++k) dst[n][k] = *(const PG8_LAS bf16x8*)(lds + PG8_SB(b, h) + boff + n * 2048 + k * 1024); } while (0)
#define PG8_MMA(ai, bj, At, Bt) do { __builtin_amdgcn_s_setprio(1); _Pragma("unroll") for (int m = 0; m < 4; ++m) _Pragma("unroll") for (int n = 0; n < 2; ++n) _Pragma("unroll") for (int k = 0; k < 2; ++k) \
        acc[ai][bj][m][n] = __builtin_amdgcn_mfma_f32_16x16x32_bf16(Bt[n][k], At[m][k], acc[ai][bj][m][n], 0, 0, 0); __builtin_amdgcn_s_setprio(0); } while (0)
#define PG8_WAIT_V(n) asm volatile("s_waitcnt vmcnt(" #n ")" ::: "memory")
#define PG8_WAIT_L(n) asm volatile("s_waitcnt lgkmcnt(" #n ")" ::: "memory")
#define PG8_BAR __builtin_amdgcn_s_barrier()
#define PG8_SCHED __builtin_amdgcn_sched_barrier(0)
    Unit cur, nxt; int ui = 0;
    if (!S.next(0, cur)) return;
    f32x4 acc[2][2][4][2];
#pragma unroll
    for (int a = 0; a < 2; ++a)
#pragma unroll
        for (int b = 0; b < 2; ++b)
#pragma unroll
            for (int m = 0; m < 4; ++m)
#pragma unroll
                for (int n = 0; n < 2; ++n) acc[a][b][m][n] = (f32x4){0.f, 0.f, 0.f, 0.f};
    bf16x8 At[4][2], B0[2][2], B1[2][2];
    const char* cA; const char* cB; S.ptrs(cur, cA, cB);
    if constexpr (SP2) {
        PG8_STAGE(PG8_SB(0, 0), cB, voffB); PG8_STAGE(PG8_SB(0, 1), cB + hstepB, voffB); PG8_STAGE(PG8_SA(0, 0), cA, voffA); PG8_STAGE(PG8_SA(0, 1), cA + hstepA, voffA);
        if (wr == 1) PG8_BAR;
        PG8_WAIT_V(2); PG8_BAR;
        PG8_STAGE(PG8_SB(1, 0), cB + kstep, voffB); PG8_STAGE(PG8_SA(1, 0), cA + kstep, voffA); PG8_STAGE(PG8_SB(1, 1), cB + hstepB + kstep, voffB);
        PG8_WAIT_V(6); PG8_BAR;
    } else {
        PG8_STAGE(PG8_SB(0, 0), cB, voffB); PG8_STAGE(PG8_SA(0, 0), cA, voffA); PG8_STAGE(PG8_SB(0, 1), cB + hstepB, voffB); PG8_STAGE(PG8_SA(0, 1), cA + hstepA, voffA);
        if (wr == 1) PG8_BAR;
        PG8_WAIT_V(4); PG8_BAR;
        PG8_STAGE(PG8_SB(1, 0), cB + kstep, voffB); PG8_STAGE(PG8_SA(1, 0), cA + kstep, voffA); PG8_STAGE(PG8_SB(1, 1), cB + hstepB + kstep, voffB);
        PG8_WAIT_V(6); PG8_BAR;
    }
    for (;;) {
        const bool has_next = S.next(ui + 1, nxt);
        const char* nA = cA; const char* nB = cB; if (has_next) S.ptrs(nxt, nA, nB);
        for (int t = 0; t < nt; t += 2) {
            const bool last = (t == nt - 2);
            const char* a1 = cA + (size_t)(t + 1) * kstep;
            const char* a2 = last ? nA : cA + (size_t)(t + 2) * kstep; const char* b2 = last ? nB : cB + (size_t)(t + 2) * kstep;
            const char* a3 = a2 + kstep; const char* b3 = b2 + kstep;
            if constexpr (SP2) {
            PG8_LDB(B0, 0, 0); PG8_LDB(B1, 0, 1); PG8_SCHED; PG8_LDA(At, 0, 0); PG8_STAGE(PG8_SA(1, 1), a1 + hstepA, voffA);
            PG8_WAIT_V(8); PG8_WAIT_L(0); PG8_BAR; PG8_MMA(0, 0, At, B0); PG8_MMA(0, 1, At, B1); PG8_BAR; PG8_SCHED;
            PG8_LDA(At, 0, 1); PG8_STAGE(PG8_SB(0, 0), b2, voffB); PG8_STAGE(PG8_SB(0, 1), b2 + hstepB, voffB); PG8_STAGE(PG8_SA(0, 0), a2, voffA);
            PG8_WAIT_V(8); PG8_WAIT_L(0); PG8_BAR; PG8_MMA(1, 0, At, B0); PG8_MMA(1, 1, At, B1); PG8_BAR; PG8_SCHED;
            PG8_LDB(B0, 1, 0); PG8_LDB(B1, 1, 1); PG8_SCHED; PG8_LDA(At, 1, 0); PG8_STAGE(PG8_SA(0, 1), a2 + hstepA, voffA);
            PG8_WAIT_V(8); PG8_WAIT_L(0); PG8_BAR; PG8_MMA(0, 0, At, B0); PG8_MMA(0, 1, At, B1); PG8_BAR; PG8_SCHED;
            PG8_LDA(At, 1, 1); PG8_STAGE(PG8_SB(1, 0), b3, voffB); PG8_STAGE(PG8_SB(1, 1), b3 + hstepB, voffB); PG8_STAGE(PG8_SA(1, 0), a3, voffA);
            PG8_WAIT_V(8); PG8_WAIT_L(0); PG8_BAR; PG8_MMA(1, 0, At, B0); PG8_MMA(1, 1, At, B1); PG8_BAR; PG8_SCHED;
            } else {
            PG8_LDB(B0, 0, 0); PG8_SCHED; PG8_LDA(At, 0, 0); PG8_STAGE(PG8_SA(1, 1), a1 + hstepA, voffA);
            PG8_WAIT_L(8); PG8_BAR; PG8_WAIT_L(0); PG8_MMA(0, 0, At, B0); PG8_BAR; PG8_SCHED;
            PG8_LDB(B1, 0, 1); PG8_STAGE(PG8_SB(0, 0), b2, voffB);
            PG8_BAR; PG8_WAIT_L(0); PG8_MMA(0, 1, At, B1); PG8_BAR;
            PG8_LDA(At, 0, 1); PG8_STAGE(PG8_SA(0, 0), a2, voffA);
            PG8_BAR; PG8_WAIT_L(0); PG8_MMA(1, 0, At, B0); PG8_BAR; PG8_SCHED;
            PG8_STAGE(PG8_SB(0, 1), b2 + hstepB, voffB);
            PG8_WAIT_V(6); PG8_BAR; PG8_MMA(1, 1, At, B1); PG8_BAR;
            PG8_LDB(B0, 1, 0); PG8_SCHED; PG8_LDA(At, 1, 0); PG8_STAGE(PG8_SA(0, 1), a2 + hstepA, voffA);
            PG8_WAIT_L(8); PG8_BAR; PG8_WAIT_L(0); PG8_MMA(0, 0, At, B0); PG8_BAR; PG8_SCHED;
            PG8_LDB(B1, 1, 1); PG8_STAGE(PG8_SB(1, 0), b3, voffB);
            PG8_BAR; PG8_WAIT_L(0); PG8_MMA(0, 1, At, B1); PG8_BAR;
            PG8_LDA(At, 1, 1); PG8_STAGE(PG8_SA(1, 0), a3, voffA);
            PG8_BAR; PG8_WAIT_L(0); PG8_MMA(1, 0, At, B0); PG8_BAR; PG8_SCHED;
            PG8_STAGE(PG8_SB(1, 1), b3 + hstepB, voffB);
            PG8_WAIT_V(6); PG8_BAR; PG8_MMA(1, 1, At, B1); PG8_BAR;
            }
        }
        if constexpr (ALIGN_EPI) { if (wr == 0) PG8_BAR; }
        {
            int t2 = threadIdx.x; asm volatile("" : "+v"(t2)); const int l2 = t2 & 63;
            E(acc, cur, wr, wc, l2 & 15, l2 >> 4);
            if constexpr (DUP_EPI && Epi::IDEMP) E(acc, cur, wr, wc, l2 & 15, l2 >> 4);
        }
        if (!has_next) break;
#pragma unroll
        for (int a = 0; a < 2; ++a)
#pragma unroll
            for (int b = 0; b < 2; ++b)
#pragma unroll
                for (int m = 0; m < 4; ++m)
#pragma unroll
                    for (int n = 0; n < 2; ++n) acc[a][b][m][n] = (f32x4){0.f, 0.f, 0.f, 0.f};
        cur = nxt; cA = nA; cB = nB; ++ui;
        if constexpr (ALIGN_EPI) { if (wr == 1) PG8_BAR; }
    }
    PG8_WAIT_V(0);
    if constexpr (!ALIGN_EPI) { if (wr == 0) PG8_BAR; }
    PG8_BAR;
#undef PG8_SA
#undef PG8_SB
#undef PG8_STAGE
#undef PG8_LDA
#undef PG8_LDB
#undef PG8_MMA
#undef PG8_WAIT_V
#undef PG8_WAIT_L
#undef PG8_BAR
#undef PG8_SCHED
}
}

constexpr int NWAVES = 8;
constexpr int BATCH = 2, SEQ = 8192, DM = 4096, M = BATCH * SEQ, NIN = 35840, DFF = 11008, NUP = 2 * DFF, DEPTH = 2;
constexpr float EPS = 1e-5f, LOG2E = 1.4426950408889634f;
constexpr float ALPHA = 1.4142135623730951f;
constexpr int C_DAQ = 0, C_DAK = 1024, C_DAV = 2048, C_RTQ = 3072, C_RTK = 3584, C_RTV = 4096, C_RTG = 5120, C_HGQ = 6144, C_HGF = 7168, C_HGI = 8192, C_HGG = 9216,
              C_DLQ = 10240, C_DLK = 13312, C_DLV = 16384, C_GATE = 19456;
constexpr int VT_DAV = 0, VT_RTV = 1024, VT_HGI = 2048, VT_DLV = 3072, VT_ROWS = 6144;
constexpr int NAT_TILES = 116, SWP_TILES = 16;
constexpr float QS_DA = 0.125f * LOG2E;
constexpr float QS_DL = 0.08838834764831845f * LOG2E;

constexpr size_t MiB = 1u << 20;
constexpr size_t WS_CTL = 0, CTL_ZERO_BYTES = 1 * MiB;
constexpr size_t WS_WIN = 16 * MiB, WIN_L = (size_t)NIN * DM * 2;
constexpr size_t WS_WBR = 576 * MiB, WBR_L = (size_t)4 * DM * 1024 * 2;
constexpr size_t WS_WO = 640 * MiB, WO_L = (size_t)DM * DM * 2;
constexpr size_t WS_WUP = 704 * MiB, WUP_L = (size_t)NUP * DM * 2;
constexpr size_t WS_WDN = 1048 * MiB, WDN_L = (size_t)DM * DFF * 2;
constexpr size_t WS_AB = 1220 * MiB, WS_XP4 = 1348 * MiB, WS_XP16 = 1476 * MiB;
constexpr size_t WS_NAT = 1604 * MiB;
constexpr size_t WS_UUP = WS_NAT, WS_ACT = WS_NAT + 688 * MiB;
constexpr size_t WS_VT = 2724 * MiB;
constexpr size_t WS_HQT = 2932 * MiB, WS_HKT = 2964 * MiB, WS_HQC = 2996 * MiB, WS_HKH = 3028 * MiB, WS_DEC = 3060 * MiB;
constexpr size_t WS_UR = 3062 * MiB, WS_UH = 3094 * MiB, WS_SR = 3222 * MiB, WS_SH = 3238 * MiB;
constexpr size_t WS_Y = 3302 * MiB;
constexpr size_t WS_MRG = 3430 * MiB, WS_MRGB = 3686 * MiB, WS_H1 = 3814 * MiB, WS_H2 = 4070 * MiB, WS_DAK = 4326 * MiB, WS_DLK = 4358 * MiB, WS_END = 4454 * MiB;
static_assert(WS_WIN + 2 * WIN_L <= WS_WBR && WS_WUP + 2 * WUP_L <= WS_WDN && WS_WDN + 2 * WDN_L <= WS_AB, "ws map");
static_assert(WS_NAT + (size_t)M * NIN * 2 <= WS_VT && WS_ACT + (size_t)M * DFF * 2 <= WS_VT && WS_UUP + (size_t)M * NUP * 2 <= WS_ACT, "ws map");
static_assert(WS_VT + (size_t)VT_ROWS * M * 2 <= WS_HQT, "ws map");
static_assert(WS_XP16 - WS_XP4 == WS_XP4 - WS_AB, "the permuted activation copies are equally spaced");
constexpr int CW_TMO = 0, CW_CODE = 1, CW_BAR = 4096, CW_WQ = 16384, CW_NRM = 20480;

constexpr int LDS_BYTES = 147456, LDSCTL_OFF = LDS_BYTES - 512, MISC_OFF = LDSCTL_OFF + 320;

#define GAS __attribute__((address_space(1)))
#define LAS __attribute__((address_space(3)))
typedef unsigned short bf16;
typedef unsigned v4u __attribute__((ext_vector_type(4)));
typedef unsigned v2u __attribute__((ext_vector_type(2)));
typedef float f32x4 __attribute__((ext_vector_type(4)));
typedef float f32x16 __attribute__((ext_vector_type(16)));
typedef short bf16x8 __attribute__((ext_vector_type(8)));
typedef short bf16x4 __attribute__((ext_vector_type(4)));
typedef GAS unsigned gu32;
#define RLX_AGENT __ATOMIC_RELAXED, __HIP_MEMORY_SCOPE_AGENT
#define LDS_WAIT() asm volatile("s_waitcnt lgkmcnt(0)" ::: "memory")
#define VM_WAIT() asm volatile("s_waitcnt vmcnt(0)" ::: "memory")
__device__ __forceinline__ unsigned f2bf(float f) { unsigned u = __builtin_bit_cast(unsigned, f); return (u + 0x7fffu + ((u >> 16) & 1u)) >> 16; }
__device__ __forceinline__ unsigned pk2(float lo, float hi) { return f2bf(lo) | (f2bf(hi) << 16); }
__device__ __forceinline__ float bflo(unsigned u) { return __uint_as_float(u << 16); }
__device__ __forceinline__ float bfhi(unsigned u) { return __uint_as_float(u & 0xffff0000u); }
__device__ __forceinline__ float bf1(bf16 b) { return __uint_as_float((unsigned)b << 16); }
__device__ __forceinline__ float fsigmoid(float x) { return __builtin_amdgcn_rcpf(1.f + __builtin_amdgcn_exp2f(-x * LOG2E)); }

#define XB_TMO      128
#define XB_XCNT(j)  (256  + 64 * (j))
#define XB_XSUB(j)  (1280 + 64 * (j))
#define XB_XGEN(j)  (2304 + 64 * (j))
#define XB_TOP      3328
#define XB_TOPGEN   3392
#define XCD_BAR_WORDS 3456
#define XB_SPIN_CAP (1u << 18)
__device__ __forceinline__ unsigned xb_ld(unsigned* p)              { return __hip_atomic_load(p, __ATOMIC_RELAXED, __HIP_MEMORY_SCOPE_AGENT); }
__device__ __forceinline__ unsigned xb_add(unsigned* p, unsigned v) { return __hip_atomic_fetch_add(p, v, __ATOMIC_RELAXED, __HIP_MEMORY_SCOPE_AGENT); }
__device__ __forceinline__ unsigned xb_xcc_id() { return (unsigned)__builtin_amdgcn_s_getreg((3 << 11) | 20) & 0xFu; }
#define XB_SPIN(cond, bar) do { unsigned _sp = 0; while (cond) { __builtin_amdgcn_s_sleep(1); \
    if ((++_sp & 255u) == 0u) { if (xb_ld(&(bar)[XB_TMO])) break; if (_sp > XB_SPIN_CAP) { atomicAdd(&(bar)[XB_TMO], 1u); break; } } } } while (0)
struct XcdBarrier { unsigned* bar; unsigned x; volatile LAS unsigned* st; };
__device__ __forceinline__ XcdBarrier xcd_barrier_post(unsigned* bar, volatile LAS unsigned* st) {
    XcdBarrier b; b.bar = bar; b.x = xb_xcc_id(); b.st = st;
    if (threadIdx.x == 0) (void)xb_add(&bar[XB_XCNT(b.x)], 1u);
    return b;
}
__device__ __forceinline__ void xcd_barrier_complete(unsigned* bar, unsigned x, unsigned& nloc, unsigned& nx) {
    const unsigned G = gridDim.x * gridDim.y * gridDim.z;
    unsigned sum, cnt, mine, sp = 0u;
    for (;;) {
        sum = 0u; cnt = 0u; mine = 0u;
#pragma unroll
        for (unsigned j = 0; j < 16; ++j) { const unsigned c = xb_ld(&bar[XB_XCNT(j)]); sum += c; cnt += (c > 0u) ? 1u : 0u; mine = (j == x) ? c : mine; }
        if (sum == G) break;
        __builtin_amdgcn_s_sleep(1);
        if ((++sp & 255u) == 0u) { if (xb_ld(&bar[XB_TMO])) break; if (sp > XB_SPIN_CAP) { atomicAdd(&bar[XB_TMO], 1u); break; } }
    }
    nloc = mine > 0u ? mine : 1u; nx = cnt > 0u ? cnt : 1u;
}
__device__ __forceinline__ void xcd_barrier(const XcdBarrier& b) {
    asm volatile("s_waitcnt vmcnt(0)" ::: "memory");
    __syncthreads();
    if (threadIdx.x == 0) {
        unsigned* bar = b.bar;
        __builtin_amdgcn_s_waitcnt(0);
        unsigned nloc = b.st[0], nx = b.st[1];
        if (nloc == 0u) { xcd_barrier_complete(bar, b.x, nloc, nx); b.st[0] = nloc; b.st[1] = nx; }
        const unsigned old = xb_add(&bar[XB_XSUB(b.x)], 1u);
        const unsigned gen = old / nloc;
        if (old + 1u == (gen + 1u) * nloc) {
            __builtin_amdgcn_fence(__ATOMIC_RELEASE, "agent");
            asm volatile("s_waitcnt vmcnt(0)" ::: "memory");
            const unsigned og = xb_add(&bar[XB_TOP], 1u);
            const unsigned tg = og / nx;
            if (og + 1u == (tg + 1u) * nx) xb_add(&bar[XB_TOPGEN], 1u);
            else XB_SPIN(xb_ld(&bar[XB_TOPGEN]) == tg, bar);
            __builtin_amdgcn_fence(__ATOMIC_ACQUIRE, "agent");
            xb_add(&bar[XB_XGEN(b.x)], 1u);
            asm volatile("s_waitcnt vmcnt(0)" ::: "memory");
        } else {
            XB_SPIN(xb_ld(&bar[XB_XGEN(b.x)]) == gen, bar);
            __builtin_amdgcn_fence(__ATOMIC_ACQUIRE, "agent");
            asm volatile("s_waitcnt vmcnt(0)" ::: "memory");
        }
    }
    __syncthreads();
}

struct Frame {
    LAS unsigned char* lds;
    gu32* ctl;
    unsigned char* ws;
    int tid, lane, wave, vcu, G;
};

__device__ __forceinline__ float lane_xor(float v, int o, int lane) { return __int_as_float(__builtin_amdgcn_ds_bpermute((lane ^ o) << 2, __float_as_int(v))); }
__device__ __forceinline__ float wave_sum(float v, int lane) {
#pragma unroll
    for (int o = 1; o < 64; o <<= 1) v += lane_xor(v, o, lane);
    return v;
}
__device__ __forceinline__ float half_sum(float v) { const auto rr = __builtin_amdgcn_permlane32_swap(__float_as_uint(v), __float_as_uint(v), false, false); return __uint_as_float(rr[0]) + __uint_as_float(rr[1]); }
__device__ __forceinline__ float half_max(float v) { const auto rr = __builtin_amdgcn_permlane32_swap(__float_as_uint(v), __float_as_uint(v), false, false); return fmaxf(__uint_as_float(rr[0]), __uint_as_float(rr[1])); }

__device__ __forceinline__ f32x16 mfma32(bf16x8 a, bf16x8 b, f32x16 c) { return __builtin_amdgcn_mfma_f32_32x32x16_bf16(a, b, c, 0, 0, 0); }
__device__ __forceinline__ bf16x8 ld8(const bf16* p) { return *(const bf16x8*)p; }
__device__ __forceinline__ bf16x8 ld44(const bf16* p) { const bf16x4 a = *(const bf16x4*)p, b = *(const bf16x4*)(p + 8); return __builtin_shufflevector(a, b, 0, 1, 2, 3, 4, 5, 6, 7); }
template <int S> __device__ __forceinline__ bf16x8 pack8(const f32x16& p) {
    v4u w; w.x = pg8::cvt_pk_bf16(p[8 * S + 0], p[8 * S + 1]); w.y = pg8::cvt_pk_bf16(p[8 * S + 2], p[8 * S + 3]); w.z = pg8::cvt_pk_bf16(p[8 * S + 4], p[8 * S + 5]); w.w = pg8::cvt_pk_bf16(p[8 * S + 6], p[8 * S + 7]);
    return __builtin_bit_cast(bf16x8, w);
}
__device__ __forceinline__ f32x16 zero16() { f32x16 z; _Pragma("unroll") for (int i = 0; i < 16; ++i) z[i] = 0.f; return z; }
#define ROWOFF(i) (((i) & 3) + 8 * ((i) >> 2))

template <bool UPIL = false>
__device__ __forceinline__ void p0_transpose_item(const float* W, int K, int N, bf16* WT, LAS float* scr, int item, int lane) {
    const int nblk = N / 32, kb = item / nblk, nb = item % nblk, k0 = 64 * kb, n0 = 32 * nb;
    const int cu = n0 < DFF ? n0 : n0 - DFF, d0 = UPIL ? (256 * (cu >> 7) + (n0 < DFF ? 0 : 128) + (cu & 127)) : n0;
    const int lr = lane >> 3, lc = 4 * (lane & 7);
    const GAS f32x4* src = (const GAS f32x4*)(W + (size_t)(k0 + lr) * N + n0 + lc);
    f32x4 v[8];
#pragma unroll
    for (int j = 0; j < 8; ++j) v[j] = src[(size_t)j * 2 * N];
#pragma unroll
    for (int j = 0; j < 8; ++j) { LAS float* d = scr + (8 * j + lr) * 33 + lc; d[0] = v[j].x; d[1] = v[j].y; d[2] = v[j].z; d[3] = v[j].w; }
    LDS_WAIT(); asm volatile("" ::: "memory");
    const int c = lane & 7;
#pragma unroll
    for (int j = 0; j < 4; ++j) { const int n = (lane >> 3) + 8 * j; const LAS float* s = scr + (8 * c) * 33 + n;
        v4u o; o.x = pg8::cvt_pk_bf16(s[0 * 33], s[1 * 33]); o.y = pg8::cvt_pk_bf16(s[2 * 33], s[3 * 33]); o.z = pg8::cvt_pk_bf16(s[4 * 33], s[5 * 33]); o.w = pg8::cvt_pk_bf16(s[6 * 33], s[7 * 33]);
        *(GAS v4u*)(WT + (size_t)(d0 + n) * K + k0 + 8 * c) = o; }
    LDS_WAIT(); asm volatile("" ::: "memory");
}
struct P0Desc { const float* W; bf16* WT; int K, N, item, upil; };
__device__ __forceinline__ void p0_item_load(const P0Desc& D, int lane, f32x4 (&v)[8]) {
    const int nblk = D.N / 32, kb = D.item / nblk, nb = D.item % nblk, k0 = 64 * kb, n0 = 32 * nb;
    const int lr = lane >> 3, lc = 4 * (lane & 7);
    const GAS f32x4* src = (const GAS f32x4*)(D.W + (size_t)(k0 + lr) * D.N + n0 + lc);
#pragma unroll
    for (int j = 0; j < 8; ++j) v[j] = src[(size_t)j * 2 * D.N];
}
__device__ __forceinline__ void p0_item_finish(const P0Desc& D, LAS float* scr, int lane, const f32x4 (&v)[8]) {
    const int nblk = D.N / 32, kb = D.item / nblk, nb = D.item % nblk, k0 = 64 * kb, n0 = 32 * nb;
    const int cu = n0 < DFF ? n0 : n0 - DFF, d0 = D.upil ? (256 * (cu >> 7) + (n0 < DFF ? 0 : 128) + (cu & 127)) : n0;
    const int lr = lane >> 3, lc = 4 * (lane & 7);
#pragma unroll
    for (int j = 0; j < 8; ++j) { LAS float* d = scr + (8 * j + lr) * 33 + lc; d[0] = v[j].x; d[1] = v[j].y; d[2] = v[j].z; d[3] = v[j].w; }
    LDS_WAIT(); asm volatile("" ::: "memory");
    const int c = lane & 7;
#pragma unroll
    for (int j = 0; j < 4; ++j) { const int n = (lane >> 3) + 8 * j; const LAS float* s = scr + (8 * c) * 33 + n;
        v4u o; o.x = pg8::cvt_pk_bf16(s[0 * 33], s[1 * 33]); o.y = pg8::cvt_pk_bf16(s[2 * 33], s[3 * 33]); o.z = pg8::cvt_pk_bf16(s[4 * 33], s[5 * 33]); o.w = pg8::cvt_pk_bf16(s[6 * 33], s[7 * 33]);
        *(GAS v4u*)(D.WT + (size_t)(d0 + n) * D.K + k0 + 8 * c) = o; }
    LDS_WAIT(); asm volatile("" ::: "memory");
}
__device__ __forceinline__ int perm_row(int m, int sh) { const int b = m / SEQ, t = m % SEQ; return b * SEQ + (t & ((1 << sh) - 1)) * (SEQ >> sh) + (t >> sh); }

struct Args { const float* in[16]; float* out; unsigned char* ws; int ph_lo, ph_hi; };
template <int K_> __device__ __forceinline__ const float* karg() {
    const float* p; asm volatile("s_load_dwordx2 %0, %1, %2\n\ts_waitcnt lgkmcnt(0)" : "=s"(p) : "s"(__builtin_amdgcn_kernarg_segment_ptr()), "i"(K_ * 8) : "memory"); return p; }
#define INP(k) (karg<(k)>())

#ifndef NCONV
#define NCONV 32
#endif
#ifndef CONV_S1
#define CONV_S1 24
#endif
template <int PART>
__device__ __forceinline__ void p0_convert(Frame& F, int widx, int nw) {
    LAS float* scr = (LAS float*)(F.lds + F.wave * 16384);
    constexpr int I_IN = (DM / 64) * (NIN / 32), I_BR = (1024 / 64) * (DM / 32), I_O = (DM / 64) * (DM / 32), I_UP = (DM / 64) * (NUP / 32), I_DN = (DFF / 64) * (DM / 32);
    constexpr int I_L = I_IN + 4 * I_BR + I_O + I_UP + I_DN;
    if constexpr (PART == 1) {
        auto decode = [&](int it) -> P0Desc { const int l = it / I_L; int r = it % I_L; P0Desc D; D.upil = 0;
            if (r < I_IN) { D.W = INP(1) + (size_t)l * DM * NIN; D.K = DM; D.N = NIN; D.WT = (bf16*)(F.ws + WS_WIN + l * WIN_L); D.item = r; return D; } r -= I_IN;
            if (r < 4 * I_BR) { const int b = r / I_BR; D.W = INP(6) + ((size_t)l * 4 + b) * 1024 * DM; D.K = 1024; D.N = DM; D.WT = (bf16*)(F.ws + WS_WBR + l * WBR_L) + (size_t)b * DM * 1024; D.item = r % I_BR; return D; } r -= 4 * I_BR;
            if (r < I_O) { D.W = INP(7) + (size_t)l * DM * DM; D.K = DM; D.N = DM; D.WT = (bf16*)(F.ws + WS_WO + l * WO_L); D.item = r; return D; } r -= I_O;
            if (r < I_UP) { D.W = INP(10) + (size_t)l * DM * NUP; D.K = DM; D.N = NUP; D.WT = (bf16*)(F.ws + WS_WUP + l * WUP_L); D.item = r; D.upil = 1; return D; } r -= I_UP;
            D.W = INP(13) + (size_t)l * DFF * DM; D.K = DFF; D.N = DM; D.WT = (bf16*)(F.ws + WS_WDN + l * WDN_L); D.item = r; return D; };
        constexpr int END = DEPTH * I_L;
        int it = I_IN + widx;
        if (it < END) {
            f32x4 v0[8], v1[8]; P0Desc D0 = decode(it), D1 = D0;
            p0_item_load(D0, F.lane, v0);
            for (;;) {
                const int it1 = it + nw; const bool h1 = it1 < END;
                if (h1) { D1 = decode(it1); p0_item_load(D1, F.lane, v1); }
                p0_item_finish(D0, scr, F.lane, v0);
                if (!h1) break;
                it = it1 + nw; const bool h0 = it < END;
                if (h0) { D0 = decode(it); p0_item_load(D0, F.lane, v0); }
                p0_item_finish(D1, scr, F.lane, v1);
                if (!h0) break;
            }
        }
    } else
    for (int it = widx; it < I_IN; it += nw) {
        const int l = it / I_L; int r = it % I_L;
        if (r < I_IN) { p0_transpose_item(INP(1) + (size_t)l * DM * NIN, DM, NIN, (bf16*)(F.ws + WS_WIN + l * WIN_L), scr, r, F.lane); continue; } r -= I_IN;
        if (r < 4 * I_BR) { const int b = r / I_BR; p0_transpose_item(INP(6) + ((size_t)l * 4 + b) * 1024 * DM, 1024, DM, (bf16*)(F.ws + WS_WBR + l * WBR_L) + (size_t)b * DM * 1024, scr, r % I_BR, F.lane); continue; } r -= 4 * I_BR;
        if (r < I_O) { p0_transpose_item(INP(7) + (size_t)l * DM * DM, DM, DM, (bf16*)(F.ws + WS_WO + l * WO_L), scr, r, F.lane); continue; } r -= I_O;
        if (r < I_UP) { p0_transpose_item<true>(INP(10) + (size_t)l * DM * NUP, DM, NUP, (bf16*)(F.ws + WS_WUP + l * WUP_L), scr, r, F.lane); continue; } r -= I_UP;
        p0_transpose_item(INP(13) + (size_t)l * DFF * DM, DFF, DM, (bf16*)(F.ws + WS_WDN + l * WDN_L), scr, r, F.lane);
    }
    if constexpr (PART == 0) {
        const float* x = INP(0);
        for (int m = widx; m < M; m += nw) {
            const GAS f32x4* xr = (const GAS f32x4*)(x + (size_t)m * DM) + F.lane;
            GAS v2u* o0 = (GAS v2u*)((bf16*)(F.ws + WS_AB) + (size_t)m * DM) + F.lane;
#pragma unroll 4
            for (int j = 0; j < 16; ++j) { const f32x4 v = xr[64 * j]; v2u w; w.x = pk2(v.x, v.y); w.y = pk2(v.z, v.w); o0[64 * j] = w; }
        }
    }
}

using pg8::Unit;
template <int mode> struct InProjSched {
    int G, c; const bf16* X; const bf16* Wt; int s1;
    __device__ __forceinline__ bool next(int i, Unit& u) const {
        int L = i * G + c;
        if constexpr (mode == 0) {
            if (s1 > 0) { const int Gg = G - NCONV, ii = i + (c >= Gg ? s1 : 0); L = ii < s1 ? ii * Gg + c : s1 * Gg + (ii - s1) * G + c; }
            if (L < 64 * NAT_TILES) {
                int pm, pn; pg8::tile_map(L, 64, NAT_TILES, pm, pn);
                u.pm = pm; u.pn = pn < 8 ? pn : pn < 12 ? pn + 4 : pn < 24 ? pn + 8 : pn < 52 ? pn + 12 : pn + 24; u.kind = 0; return true;
            }
            const int L2 = L - 64 * NAT_TILES;
            if (L2 >= SWP_TILES * 64) return false;
            int ft, tt; pg8::tile_map(L2, SWP_TILES, 64, ft, tt);
            u.pm = ft; u.pn = tt; u.kind = 1; return true;
        } else {
            if (L >= 4 * 64) return false;
            int ft, tt; pg8::tile_map(L, 4, 64, ft, tt);
            u.pm = 12 + 4 * mode + ft; u.pn = tt; u.kind = 1; return true;
        }
    }
    __device__ __forceinline__ void ptrs(const Unit& u, const char*& A, const char*& B) const {
        if (u.kind == 0) { A = (const char*)(X + (size_t)u.pm * 256 * DM); B = (const char*)(Wt + (size_t)u.pn * 256 * DM); }
        else { const int ft = u.pm, ct = ft < 4 ? 8 + ft : ft < 8 ? 12 + ft : ft < 12 ? 24 + ft : 52 + ft;
            A = (const char*)(Wt + (size_t)ct * 256 * DM);
            const int sh = 2 * mode, b = u.pn >> 5, p = (u.pn & 31) * 256, res = p >> (13 - sh), w0 = p & ((SEQ >> sh) - 1);
            B = (const char*)(X + ((size_t)b * SEQ + ((size_t)w0 << sh) + res) * DM); }
    }
};
struct EpiInProj {
    static constexpr bool APERM = false, PERM = true, IDEMP = true;
    bf16* NAT; bf16* VT; bf16* DAK; bf16* DLK;
    __device__ __forceinline__ void operator()(const pg8::f32x4 (&acc)[2][2][4][2], const Unit& u, int wr, int wc, int fr, int fq) const {
        bf16* base; size_t rs_m, rs_ai, cs_bj; float sc = 1.f;
        const int b = u.kind == 0 ? (u.pm >> 5) : (u.pn >> 5), t0 = ((u.kind == 0 ? u.pm : u.pn) & 31) * 256;
        if (u.kind == 0) { const int ct = u.pn;
            sc = ct < 4 ? QS_DA : (ct == 12 || ct == 13) ? 0.125f : (ct >= 40 && ct < 52) ? QS_DL : 1.f;
            if (ct >= 4 && ct < 8) {
                base = DAK + ((size_t)(b * 8 + 2 * (ct - 4)) * SEQ + t0 + wr * 64 + fr) * 128 + wc * 32 + 8 * fq; rs_m = 16 * 128; rs_ai = 128 * 128; cs_bj = (size_t)SEQ * 128;
            } else if (ct >= 52 && ct < 64) {
                const int g = (ct - 52) >> 2, hq = (ct - 52) & 3, sh = 2 * g, R = 1 << sh;
                const int prow = (fr & (R - 1)) * (SEQ >> sh) + (t0 >> sh) + wr * (64 >> sh) + (fr >> sh);
                base = DLK + ((size_t)((g * 2 + b) * 8 + 2 * hq) * SEQ + prow) * 128 + wc * 32 + 8 * fq; rs_m = (size_t)(16 >> sh) * 128; rs_ai = (size_t)(128 >> sh) * 128; cs_bj = (size_t)SEQ * 128;
            } else { base = NAT + ((size_t)u.pm * 256 + wr * 64 + fr) * NIN + ct * 256 + wc * 32 + 8 * fq; rs_m = (size_t)16 * NIN; rs_ai = (size_t)128 * NIN; cs_bj = 128; }
        } else { const int ft = u.pm;
            if (ft < 4) {
                base = VT + (size_t)VT_DAV * M + ((size_t)((b * 8 + 2 * ft) * 128 + (t0 >> 6) + (wc >> 1)) * 128 + wr * 64 + fr) * 64 + (wc & 1) * 32 + 8 * fq;
                rs_m = 16 * 64; rs_ai = (size_t)128 * 128 * 64; cs_bj = (size_t)2 * 128 * 64;
            } else if (ft >= 12) {
                const int g = (ft - 12) >> 2, hq = (ft - 12) & 3;
                base = VT + (size_t)VT_DLV * M + ((size_t)(((g * 2 + b) * 8 + 2 * hq) * 256 + (t0 >> 5) + wc) * 128 + wr * 64 + fr) * 32 + 8 * fq;
                rs_m = 16 * 32; rs_ai = (size_t)256 * 128 * 32; cs_bj = (size_t)4 * 128 * 32;
            } else { base = VT + ((size_t)ft * 256 + wr * 64 + fr) * M + u.pn * 256 + wc * 32 + 8 * fq; rs_m = (size_t)16 * M; rs_ai = (size_t)128 * M; cs_bj = 128; }
        }
#pragma unroll
        for (int ai = 0; ai < 2; ++ai)
#pragma unroll
            for (int m = 0; m < 4; ++m) { bf16* rowp = base + ai * rs_ai + m * rs_m;
#pragma unroll
                for (int bj = 0; bj < 2; ++bj) { const pg8::f32x4 v0 = acc[ai][bj][m][0] * sc, v1 = acc[ai][bj][m][1] * sc;
                    pg8::u32x4 w; w.x = pg8::cvt_pk_bf16(v0[0], v0[1]); w.y = pg8::cvt_pk_bf16(v0[2], v0[3]); w.z = pg8::cvt_pk_bf16(v1[0], v1[1]); w.w = pg8::cvt_pk_bf16(v1[2], v1[3]);
                    *(pg8::u32x4*)(rowp + bj * cs_bj) = w; } }
    }
};
struct MergeSched {
    int G, c; const bf16* Y; const bf16* Wb;
    __device__ __forceinline__ bool next(int i, Unit& u) const {
        const int L = (i >> 2) * G + c; if (L >= 64 * 16) return false;
        int pm, pn; pg8::tile_map(L, 64, 16, pm, pn); u.pm = pm; u.pn = pn; u.kind = i & 3; return true;
    }
    __device__ __forceinline__ void ptrs(const Unit& u, const char*& A, const char*& B) const {
        A = (const char*)(Y + (size_t)u.kind * M * 1024 + (size_t)u.pm * 256 * 1024); B = (const char*)(Wb + (size_t)u.kind * DM * 1024 + (size_t)u.pn * 256 * 1024);
    }
};
struct EpiMerge {
    static constexpr bool APERM = false, PERM = true, IDEMP = false;
    const bf16* NAT; bf16* MRGB;
    __device__ __forceinline__ void operator()(const pg8::f32x4 (&acc)[2][2][4][2], const Unit& u, int wr, int wc, int fr, int fq) const {
        const int row0 = u.pm * 256 + wr * 64 + fr, col0 = u.pn * 256 + wc * 32 + 8 * fq, b = u.kind;
#pragma unroll
        for (int ai = 0; ai < 2; ++ai) {
            const bf16* gp = NAT + (size_t)(row0 + ai * 128) * NIN + C_GATE + b * DM + col0; bf16* bp = MRGB + (size_t)(row0 + ai * 128) * DM + col0;
            v4u G[4][2], O[4][2];
#pragma unroll
            for (int m = 0; m < 4; ++m)
#pragma unroll
                for (int bj = 0; bj < 2; ++bj) G[m][bj] = *(const v4u*)(gp + (size_t)m * 16 * NIN + bj * 128);
            if (b > 0) {
#pragma unroll
                for (int m = 0; m < 4; ++m)
#pragma unroll
                    for (int bj = 0; bj < 2; ++bj) O[m][bj] = *(const v4u*)(bp + (size_t)m * 16 * DM + bj * 128);
            } else {
#pragma unroll
                for (int m = 0; m < 4; ++m)
#pragma unroll
                    for (int bj = 0; bj < 2; ++bj) O[m][bj] = (v4u){0u, 0u, 0u, 0u};
            }
            __builtin_amdgcn_sched_barrier(0);
#pragma unroll
            for (int m = 0; m < 4; ++m)
#pragma unroll
                for (int bj = 0; bj < 2; ++bj) { const v4u g = G[m][bj], o = O[m][bj];
                    pg8::f32x4 v0 = acc[ai][bj][m][0], v1 = acc[ai][bj][m][1];
                    v0[0] = v0[0] * fsigmoid(bflo(g.x)) + bflo(o.x); v0[1] = v0[1] * fsigmoid(bfhi(g.x)) + bfhi(o.x); v0[2] = v0[2] * fsigmoid(bflo(g.y)) + bflo(o.y); v0[3] = v0[3] * fsigmoid(bfhi(g.y)) + bfhi(o.y);
                    v1[0] = v1[0] * fsigmoid(bflo(g.z)) + bflo(o.z); v1[1] = v1[1] * fsigmoid(bfhi(g.z)) + bfhi(o.z); v1[2] = v1[2] * fsigmoid(bflo(g.w)) + bflo(o.w); v1[3] = v1[3] * fsigmoid(bfhi(g.w)) + bfhi(o.w);
                    v4u w; w.x = pg8::cvt_pk_bf16(v0[0], v0[1]); w.y = pg8::cvt_pk_bf16(v0[2], v0[3]); w.z = pg8::cvt_pk_bf16(v1[0], v1[1]); w.w = pg8::cvt_pk_bf16(v1[2], v1[3]);
                    *(v4u*)(bp + (size_t)m * 16 * DM + bj * 128) = w; }
        }
    }
};
struct PlainSched {
    int G, c, nN, K; const bf16* A; const bf16* Bt;
    __device__ __forceinline__ bool next(int i, Unit& u) const {
        const int L = i * G + c; if (L >= 64 * nN) return false;
        int pm, pn; pg8::tile_map(L, 64, nN, pm, pn); u.pm = pm; u.pn = pn; u.kind = 0; return true;
    }
    __device__ __forceinline__ void ptrs(const Unit& u, const char*& Ap, const char*& Bp) const {
        Ap = (const char*)(A + (size_t)u.pm * 256 * K); Bp = (const char*)(Bt + (size_t)u.pn * 256 * K);
    }
};
struct EpiF32 {
    static constexpr bool APERM = false, PERM = false, IDEMP = true;
    float* C; int ldc;
    __device__ __forceinline__ void operator()(const pg8::f32x4 (&acc)[2][2][4][2], const Unit& u, int wr, int wc, int fr, int fq) const {
        const int row0 = u.pm * 256 + wr * 64 + fr, col0 = u.pn * 256 + wc * 32 + 4 * fq;
#pragma unroll
        for (int ai = 0; ai < 2; ++ai)
#pragma unroll
            for (int m = 0; m < 4; ++m) { float* rowp = C + (size_t)(row0 + ai * 128 + m * 16) * ldc + col0;
#pragma unroll
                for (int bj = 0; bj < 2; ++bj)
#pragma unroll
                    for (int n = 0; n < 2; ++n) *(pg8::f32x4*)(rowp + bj * 128 + n * 16) = acc[ai][bj][m][n]; }
    }
};
struct EpiBf16 {
    static constexpr bool APERM = false, PERM = true, IDEMP = true;
    bf16* O; int ldc;
    __device__ __forceinline__ void operator()(const pg8::f32x4 (&acc)[2][2][4][2], const Unit& u, int wr, int wc, int fr, int fq) const {
        const int row0 = u.pm * 256 + wr * 64 + fr, col0 = u.pn * 256 + wc * 32 + 8 * fq;
#pragma unroll
        for (int ai = 0; ai < 2; ++ai)
#pragma unroll
            for (int m = 0; m < 4; ++m) { bf16* rowp = O + (size_t)(row0 + ai * 128 + m * 16) * ldc + col0;
#pragma unroll
                for (int bj = 0; bj < 2; ++bj) { const pg8::f32x4 v0 = acc[ai][bj][m][0], v1 = acc[ai][bj][m][1];
                    pg8::u32x4 w; w.x = pg8::cvt_pk_bf16(v0[0], v0[1]); w.y = pg8::cvt_pk_bf16(v0[2], v0[3]); w.z = pg8::cvt_pk_bf16(v1[0], v1[1]); w.w = pg8::cvt_pk_bf16(v1[2], v1[3]);
                    *(pg8::u32x4*)(rowp + bj * 128) = w; } }
    }
};

__device__ __forceinline__ float gelu1(float v) {
    const float av = fabsf(v), t = __builtin_amdgcn_rcpf(av * 0.2316418882f + 1.0f);
    float q = t * 0.5307027145f + (-0.7265760135f); q = q * t + 0.7107068705f; q = q * t + (-0.142248368f); q = q * t + 0.127414796f; q = q * t;
    const float e = __builtin_amdgcn_exp2f((v * v) * (-0.72134752044f));
    const float mm = v * (q * e);
    return v < 0.f ? mm : v - mm;
}
__device__ __forceinline__ float dpp_shr1(float v) { return __int_as_float(__builtin_amdgcn_update_dpp(0, __float_as_int(v), 0x111, 0xf, 0xf, true)); }
struct EpiAct {
    static constexpr bool APERM = true, PERM = true, IDEMP = true;
    bf16* ACT; const float* cw; const float* cb; float* EA; float* EG; float* EL;
    __device__ __forceinline__ void operator()(const pg8::f32x4 (&acc)[2][2][4][2], const Unit& u, int wr, int wc, int fr, int fq) const {
        const int c0 = u.pn * 128 + wc * 32 + 8 * fq, seg = u.pm * 2 + wr;
        bf16* op = ACT + ((size_t)u.pm * 256 + 128 * wr + 8 * fr) * DFF + c0;
        pg8::f32x4 w0[2], w1[2], w2[2], bc[2], p2[2], p1[2];
#pragma unroll
        for (int n = 0; n < 2; ++n) { w0[n] = *(const GAS pg8::f32x4*)(cw + c0 + 4 * n); w1[n] = *(const GAS pg8::f32x4*)(cw + DFF + c0 + 4 * n); w2[n] = *(const GAS pg8::f32x4*)(cw + 2 * DFF + c0 + 4 * n); bc[n] = *(const GAS pg8::f32x4*)(cb + c0 + 4 * n);
#pragma unroll
            for (int e = 0; e < 4; ++e) { p2[n][e] = dpp_shr1(acc[1][0][2][n][e]); p1[n][e] = dpp_shr1(acc[1][0][3][n][e]); } }
#pragma unroll
        for (int j = 0; j < 8; ++j) {
            pg8::f32x4 o[2];
#pragma unroll
            for (int n = 0; n < 2; ++n) { const pg8::f32x4 a0 = acc[j >> 2][0][j & 3][n], gl = acc[j >> 2][1][j & 3][n];
                const pg8::f32x4 cv = bc[n] + w0[n] * p2[n] + w1[n] * p1[n] + w2[n] * a0;
#pragma unroll
                for (int e = 0; e < 4; ++e) o[n][e] = gelu1(cv[e]) * gl[e];
                p2[n] = p1[n]; p1[n] = a0;
                if (j < 2 && fr == 0) { *(pg8::f32x4*)(EA + (size_t)(seg * 2 + j) * DFF + c0 + 4 * n) = a0; *(pg8::f32x4*)(EG + (size_t)(seg * 2 + j) * DFF + c0 + 4 * n) = gl; }
                if (j >= 6 && fr == 15) *(pg8::f32x4*)(EL + (size_t)(seg * 2 + j - 6) * DFF + c0 + 4 * n) = a0; }
            pg8::u32x4 w; w.x = pg8::cvt_pk_bf16(o[0][0], o[0][1]); w.y = pg8::cvt_pk_bf16(o[0][2], o[0][3]); w.z = pg8::cvt_pk_bf16(o[1][0], o[1][1]); w.w = pg8::cvt_pk_bf16(o[1][2], o[1][3]);
            *(pg8::u32x4*)(op + (size_t)j * DFF) = w;
        }
    }
};

__device__ __forceinline__ int wq_pull(gu32* cnt, int lane) {
    unsigned v = 0; if (lane == 0) v = __hip_atomic_fetch_add(cnt, 1u, RLX_AGENT);
    return (int)__builtin_amdgcn_readfirstlane(v);
}

constexpr int OT_ROW = 272;
__device__ __forceinline__ void ot_put(LAS unsigned char* wl, int r, int hh, int d0, v2u w) { *(LAS v2u*)(wl + r * OT_ROW + (d0 + 4 * hh) * 2) = w; }
__device__ __forceinline__ void ot_emit(const LAS unsigned char* wl, bf16* yb  , int rstride  , int lane) {
#pragma unroll
    for (int k = 0; k < 8; ++k) { const int row = (lane >> 4) + 4 * k; const v4u v = *(const LAS v4u*)(wl + row * OT_ROW + (lane & 15) * 16);
        *(v4u*)(yb + (size_t)row * rstride * 1024 + (lane & 15) * 8) = v; }
}

__device__ __forceinline__ void diff_unit(const bf16* NAT, const bf16* VT, bf16* YA, const float* normg, float lam, float oscale, int b, int h, int qt, int lane) {
    const int r = lane & 31, hh = lane >> 5;
    const float slope2 = __builtin_amdgcn_exp2f(-(float)h - 0.25f) * LOG2E;
    const size_t tok0 = (size_t)b * SEQ;
    const int q = qt * 32 + r;
    const bf16* qp = NAT + (tok0 + q) * NIN + C_DAQ + h * 128 + 8 * hh;
    f32x16 O1[4], O2[4];
#pragma unroll
    for (int d = 0; d < 4; ++d) { O1[d] = zero16(); O2[d] = zero16(); }
    float m1 = -INFINITY, m2 = -INFINITY, l1 = 0.f, l2 = 0.f;
    for (int kt = qt; kt >= 0; --kt) {
        const int k0 = kt * 32;
        const bf16* kp = NAT + (tok0 + k0 + r) * NIN + C_DAK + h * 128 + 8 * hh;
        const bf16* vp = VT + (size_t)(VT_DAV + h * 128 + r) * M + tok0 + k0 + 4 * hh;
        const float base = slope2 * (float)(k0 + 4 * hh - q);
        const bool diag = (kt == qt);
        bf16x8 pf1[2], pf2[2];
        const bf16* qq = qp; asm volatile("" : "+v"(qq));
        {
            f32x16 s1 = zero16();
#pragma unroll
            for (int s = 0; s < 4; ++s) s1 = mfma32(ld8(kp + 16 * s), ld8(qq + 16 * s), s1);
            float mx = -INFINITY;
#pragma unroll
            for (int i = 0; i < 16; ++i) { float v = s1[i] + (base + slope2 * (float)ROWOFF(i)); if (diag && (k0 + 4 * hh + ROWOFF(i) > q)) v = -INFINITY; s1[i] = v; mx = fmaxf(mx, v); }
            mx = half_max(mx);
            const float mn = fmaxf(m1, mx), al = __builtin_amdgcn_exp2f(m1 - mn); m1 = mn;
            float ps = 0.f;
#pragma unroll
            for (int i = 0; i < 16; ++i) { const float p = __builtin_amdgcn_exp2f(s1[i] - mn); s1[i] = p; ps += p; }
            l1 = l1 * al + half_sum(ps);
            if (!__all(al == 1.f)) {
#pragma unroll
                for (int d = 0; d < 4; ++d) O1[d] *= al; }
            pf1[0] = pack8<0>(s1); pf1[1] = pack8<1>(s1);
        }
        {
            f32x16 s2 = zero16();
#pragma unroll
            for (int s = 0; s < 4; ++s) s2 = mfma32(ld8(kp + 64 + 16 * s), ld8(qq + 64 + 16 * s), s2);
            float mx = -INFINITY;
#pragma unroll
            for (int i = 0; i < 16; ++i) { float v = s2[i] + (base + slope2 * (float)ROWOFF(i)); if (diag && (k0 + 4 * hh + ROWOFF(i) > q)) v = -INFINITY; s2[i] = v; mx = fmaxf(mx, v); }
            mx = half_max(mx);
            const float mn = fmaxf(m2, mx), al = __builtin_amdgcn_exp2f(m2 - mn); m2 = mn;
            float ps = 0.f;
#pragma unroll
            for (int i = 0; i < 16; ++i) { const float p = __builtin_amdgcn_exp2f(s2[i] - mn); s2[i] = p; ps += p; }
            l2 = l2 * al + half_sum(ps);
            if (!__all(al == 1.f)) {
#pragma unroll
                for (int d = 0; d < 4; ++d) O2[d] *= al; }
            pf2[0] = pack8<0>(s2); pf2[1] = pack8<1>(s2);
        }
#pragma unroll
        for (int d = 0; d < 4; ++d)
#pragma unroll
            for (int s = 0; s < 2; ++s) { const bf16x8 vf = ld44(vp + (size_t)d * 32 * M + 16 * s); O1[d] = mfma32(vf, pf1[s], O1[d]); O2[d] = mfma32(vf, pf2[s], O2[d]); }
    }
    const float i1 = 1.f / l1, i2 = lam / l2;
    float ss = 0.f;
#pragma unroll
    for (int d = 0; d < 4; ++d)
#pragma unroll
        for (int i = 0; i < 16; ++i) { const float o = O1[d][i] * i1 - O2[d][i] * i2; O1[d][i] = o; ss += o * o; }
    ss = half_sum(ss);
    const float rs = __builtin_amdgcn_rsqf(ss * (1.f / 128.f) + EPS) * oscale;
    bf16* yp = YA + (tok0 + q) * 1024 + h * 128 + 4 * hh;
#pragma unroll
    for (int d = 0; d < 4; ++d)
#pragma unroll
        for (int g = 0; g < 4; ++g) { const int d0 = 32 * d + 8 * g; const f32x4 gv = *(const f32x4*)(normg + d0 + 4 * hh);
            v2u w; w.x = pg8::cvt_pk_bf16(O1[d][4 * g] * rs * gv.x, O1[d][4 * g + 1] * rs * gv.y); w.y = pg8::cvt_pk_bf16(O1[d][4 * g + 2] * rs * gv.z, O1[d][4 * g + 3] * rs * gv.w);
            *(v2u*)(yp + d0) = w; }
}

constexpr int DA_KROW = 272, DA_VROW = 136;
constexpr int DA_KBUF = 64 * DA_KROW, DA_VBUF = 128 * DA_VROW, DA_STAGE = DA_KBUF + DA_VBUF, DA_QOFF = 2 * DA_STAGE, DA_END = DA_QOFF + 256 * DA_KROW;
static_assert(DA_END <= LDSCTL_OFF, "diff-attention LDS map");
typedef LAS unsigned char* ldsp;
__device__ __forceinline__ bf16x8 lds8(const LAS unsigned char* p) { return *(const LAS bf16x8*)p; }
__device__ __forceinline__ bf16x8 lds44(const LAS unsigned char* p) { const bf16x4 a = *(const LAS bf16x4*)p, b = *(const LAS bf16x4*)(p + 16); return __builtin_shufflevector(a, b, 0, 1, 2, 3, 4, 5, 6, 7); }
__device__ __forceinline__ void da_softmax(f32x16& s, float slope2, float base, bool diag, int dq, float& m, float& l, f32x16 (&O)[4], bf16x8& p0, bf16x8& p1) {
    float mx = -INFINITY;
#pragma unroll
    for (int i = 0; i < 16; ++i) { float v = __builtin_fmaf(slope2, (float)ROWOFF(i), s[i]); if (diag && (ROWOFF(i) > dq)) v = -INFINITY; s[i] = v; mx = fmaxf(mx, v); }
    mx = half_max(mx + base);
    const float mn = fmaxf(m, mx), al = __builtin_amdgcn_exp2f(m - mn), sm = mn - base; m = mn;
    float ps = 0.f;
#pragma unroll
    for (int i = 0; i < 16; ++i) { const float p = __builtin_amdgcn_exp2f(s[i] - sm); s[i] = p; ps += p; }
    l = l * al + half_sum(ps);
    if (!__all(al == 1.f)) {
#pragma unroll
        for (int d = 0; d < 4; ++d) O[d] *= al; }
    p0 = pack8<0>(s); p1 = pack8<1>(s);
}
__device__ __forceinline__ void diff_block(LAS unsigned char* lds, volatile LAS unsigned* flags, const unsigned* nrm, const bf16* NAT, const bf16* DAK, const bf16* VT, bf16* YA, const float* normg, float lam, float oscale, int b, int h, int qb, int tid) {
    const int lane = tid & 63, w = __builtin_amdgcn_readfirstlane(tid >> 6), r = lane & 31, hh = lane >> 5;
    const float slope2 = __builtin_amdgcn_exp2f(-(float)h - 0.25f) * LOG2E;
    const float sub = sqrtf(fmaxf(__uint_as_float(nrm[4 * h + 0]) * __uint_as_float(nrm[4 * h + 2]), __uint_as_float(nrm[4 * h + 1]) * __uint_as_float(nrm[4 * h + 3]))) * 1.01f;
    const size_t tok0 = (size_t)b * SEQ;
    const int q0 = 256 * qb, q = q0 + 32 * w + r, qt_w = 8 * qb + w;
    const bf16* kg = DAK + (size_t)(b * 8 + h) * SEQ * 128 + 8 * tid;
    const bf16* vg = VT + (size_t)VT_DAV * M + (size_t)(b * 8 + h) * SEQ * 128 + 8 * tid;
    const int kw = (tid >> 4) * DA_KROW + (tid & 15) * 16, vw = DA_KBUF + (tid >> 3) * DA_VROW + (tid & 7) * 16;
    {
        const bf16* qg = NAT + (tok0 + q0 + (tid >> 4)) * NIN + C_DAQ + h * 128 + 8 * (tid & 15);
#pragma unroll
        for (int i = 0; i < 8; ++i) *(LAS v4u*)(lds + DA_QOFF + kw + i * 32 * DA_KROW) = *(const v4u*)(qg + (size_t)i * 32 * NIN);
    }
    int kt = 4 * qb + 3;
    v4u g0, g1, g2, g3;
#define DA_LOAD(KT) do { const size_t k0_ = (size_t)(KT) * 8192; g0 = *(const v4u*)(kg + k0_); g1 = *(const v4u*)(kg + k0_ + 4096); g2 = *(const v4u*)(vg + k0_); g3 = *(const v4u*)(vg + k0_ + 4096); } while (0)
#define DA_STORE(BUF) do { LAS unsigned char* s_ = lds + (BUF) * DA_STAGE; *(LAS v4u*)(s_ + kw) = g0; *(LAS v4u*)(s_ + kw + 32 * DA_KROW) = g1; \
        *(LAS v2u*)(s_ + vw) = (v2u){g2.x, g2.y}; *(LAS v2u*)(s_ + vw + 8) = (v2u){g2.z, g2.w}; *(LAS v2u*)(s_ + vw + 64 * DA_VROW) = (v2u){g3.x, g3.y}; *(LAS v2u*)(s_ + vw + 64 * DA_VROW + 8) = (v2u){g3.z, g3.w}; } while (0)
    DA_LOAD(kt); DA_STORE(0);
    __syncthreads();
    f32x16 O1[4], O2[4];
#pragma unroll
    for (int d = 0; d < 4; ++d) { O1[d] = zero16(); O2[d] = zero16(); }
    float m1 = -INFINITY, m2 = -INFINITY, l1 = 0.f, l2 = 0.f;
    const LAS unsigned char* qa = lds + DA_QOFF + (32 * w + r) * DA_KROW + 16 * hh;
    int cur = 0;
    for (; kt >= 0; --kt) {
        if (kt > 0) DA_LOAD(kt - 1);
        const LAS unsigned char* Kb = lds + cur * DA_STAGE; const LAS unsigned char* Vb = Kb + DA_KBUF;
#pragma unroll
        for (int sub = 1; sub >= 0; --sub) {
            const int st = 2 * kt + sub;
            if (st <= qt_w) {
                const bool diag = (st == qt_w);
                const float base = slope2 * (float)(32 * st + 4 * hh - q);
                const int dq = q - 32 * st - 4 * hh;
                const LAS unsigned char* ka = Kb + (32 * sub + r) * DA_KROW + 16 * hh;
                bf16x8 pf1[2], pf2[2];
                { f32x16 s1 = zero16();
#pragma unroll
                  for (int s = 0; s < 4; ++s) s1 = mfma32(lds8(ka + 32 * s), lds8(qa + 32 * s), s1);
                  da_softmax(s1, slope2, base, diag, dq, m1, l1, O1, pf1[0], pf1[1]); }
                { f32x16 s2 = zero16();
#pragma unroll
                  for (int s = 0; s < 4; ++s) s2 = mfma32(lds8(ka + 128 + 32 * s), lds8(qa + 128 + 32 * s), s2);
                  da_softmax(s2, slope2, base, diag, dq, m2, l2, O2, pf2[0], pf2[1]); }
                const LAS unsigned char* va = Vb + r * DA_VROW + (32 * sub + 4 * hh) * 2;
#pragma unroll
                for (int d = 0; d < 4; ++d)
#pragma unroll
                    for (int s = 0; s < 2; ++s) { const bf16x8 vf = lds44(va + d * 32 * DA_VROW + 32 * s); O1[d] = mfma32(vf, pf1[s], O1[d]); O2[d] = mfma32(vf, pf2[s], O2[d]); }
            }
        }
        const bool can = (sub - slope2 * (float)(q - 64 * kt + 1)) < fminf(m1, m2) - 32.f;
        const bool wcan = __all(can);
        if (lane == 0) flags[(kt & 1) * 8 + w] = wcan ? 1u : 0u;
        if (kt > 0) DA_STORE(cur ^ 1);
        __syncthreads();
        cur ^= 1;
        {   const LAS v4u* fp = (const LAS v4u*)(const_cast<LAS unsigned*>(flags) + (kt & 1) * 8); const v4u fa = fp[0], fb = fp[1];
            if ((fa.x & fa.y & fa.z & fa.w & fb.x & fb.y & fb.z & fb.w) != 0u) break; }
    }
#undef DA_LOAD
#undef DA_STORE
    const float i1 = 1.f / l1, i2 = lam / l2;
    float ss = 0.f;
#pragma unroll
    for (int d = 0; d < 4; ++d)
#pragma unroll
        for (int i = 0; i < 16; ++i) { const float o = O1[d][i] * i1 - O2[d][i] * i2; O1[d][i] = o; ss += o * o; }
    ss = half_sum(ss);
    const float rs = __builtin_amdgcn_rsqf(ss * (1.f / 128.f) + EPS) * oscale;
    LAS unsigned char* ot = lds + w * (32 * OT_ROW);
#pragma unroll
    for (int d = 0; d < 4; ++d)
#pragma unroll
        for (int g = 0; g < 4; ++g) { const int d0 = 32 * d + 8 * g; const f32x4 gv = *(const f32x4*)(normg + d0 + 4 * hh);
            v2u w2; w2.x = pg8::cvt_pk_bf16(O1[d][4 * g] * rs * gv.x, O1[d][4 * g + 1] * rs * gv.y); w2.y = pg8::cvt_pk_bf16(O1[d][4 * g + 2] * rs * gv.z, O1[d][4 * g + 3] * rs * gv.w);
            ot_put(ot, r, hh, d0, w2); }
    ot_emit(ot, YA + (tok0 + q0 + 32 * w) * 1024 + h * 128, 1, lane);
}

constexpr int DL_KROW = 272, DL_VROW = 72, DL_KBUF = 32 * DL_KROW, DL_WAVE = DL_KBUF + 128 * DL_VROW;
static_assert(8 * DL_WAVE <= LDSCTL_OFF, "dilated-attention LDS map");
template <int G_> __device__ __forceinline__ void dil_group(LAS unsigned char* wl, const bf16* NAT, const bf16* DLK, const bf16* VT, size_t tok0, int h, int rho, int ut, int lane, f32x16 (&O)[4], float& m, float& l) {
    constexpr int SH = G_ == 0 ? 0 : G_ == 1 ? 2 : 4, RATE = 1 << SH;
    const int r = lane & 31, hh = lane >> 5;
    const int tq = rho + 16 * (32 * ut + r);
    const int res = rho & (RATE - 1);
    const int wq = (tq - res) >> SH;
    const int wq0 = ((rho - res) >> SH) + (16 >> SH) * (32 * ut), wq31 = wq0 + (16 >> SH) * 31;
    const int kt_hi = wq31 >> 5; int kt_lo = (wq0 - 128) >> 5; kt_lo = kt_lo < 0 ? 0 : kt_lo;
    const float slope2 = __builtin_amdgcn_exp2f(-(float)(4 * h + 2 + G_) * 0.25f) * LOG2E * (float)RATE;
    const bf16* qp = NAT + (tok0 + tq) * NIN + C_DLQ + G_ * 1024 + h * 128 + 8 * hh;
    bf16x8 qf[8];
#pragma unroll
    for (int s = 0; s < 8; ++s) qf[s] = ld8(qp + 16 * s);
    const int bb = (int)(tok0 / SEQ);
    const bf16* kg = DLK + ((size_t)((G_ * 2 + bb) * 8 + h) * SEQ + (size_t)res * (SEQ >> SH)) * 128 + 8 * lane;
    const bf16* vg = VT + (size_t)VT_DLV * M + ((size_t)((G_ * 2 + bb) * 8 + h) * SEQ + (size_t)res * (SEQ >> SH)) * 128 + 8 * lane;
    LAS unsigned char* kw = wl + (lane >> 4) * DL_KROW + (lane & 15) * 16;
    LAS unsigned char* vw = wl + DL_KBUF + (lane >> 2) * DL_VROW + (lane & 3) * 16;
    v4u gk[8], gv[8];
#define DL_LOAD(KT) do { _Pragma("unroll") for (int i_ = 0; i_ < 8; ++i_) { gk[i_] = *(const v4u*)(kg + (size_t)(KT) * 4096 + 512 * i_); gv[i_] = *(const v4u*)(vg + (size_t)(KT) * 4096 + 512 * i_); } } while (0)
#define DL_STORE() do { _Pragma("unroll") for (int i_ = 0; i_ < 8; ++i_) { *(LAS v4u*)(kw + 4 * i_ * DL_KROW) = gk[i_]; \
        *(LAS v2u*)(vw + 16 * i_ * DL_VROW) = (v2u){gv[i_].x, gv[i_].y}; *(LAS v2u*)(vw + 16 * i_ * DL_VROW + 8) = (v2u){gv[i_].z, gv[i_].w}; } } while (0)
    DL_LOAD(kt_hi); DL_STORE();
    const LAS unsigned char* ka = wl + r * DL_KROW + 16 * hh;
    const LAS unsigned char* va = wl + DL_KBUF + r * DL_VROW + 8 * hh;
    for (int kt = kt_hi; kt >= kt_lo; --kt) {
        const int w0 = kt * 32;
        if (kt > kt_lo) DL_LOAD(kt - 1);
        f32x16 s = zero16();
#pragma unroll
        for (int ks = 0; ks < 8; ++ks) s = mfma32(lds8(ka + 32 * ks), qf[ks], s);
        float mx = -INFINITY;
        const int dq = wq - w0 - 4 * hh;
#pragma unroll
        for (int i = 0; i < 16; ++i) { const int d = dq - ROWOFF(i); const float v = (d >= 0 && d <= 128) ? s[i] - slope2 * (float)d : -INFINITY; s[i] = v; mx = fmaxf(mx, v); }
        mx = half_max(mx);
        const float mn = fmaxf(m, mx), mu = (mn == -INFINITY) ? 0.f : mn, al = __builtin_amdgcn_exp2f(m - mu); m = mn;
        float ps = 0.f;
#pragma unroll
        for (int i = 0; i < 16; ++i) { const float p = __builtin_amdgcn_exp2f(s[i] - mu); s[i] = p; ps += p; }
        l = l * al + half_sum(ps);
        if (!__all(al == 1.f)) {
#pragma unroll
            for (int d = 0; d < 4; ++d) O[d] *= al; }
        const bf16x8 pf0 = pack8<0>(s), pf1 = pack8<1>(s);
#pragma unroll
        for (int d = 0; d < 4; ++d) { O[d] = mfma32(lds44(va + d * 32 * DL_VROW), pf0, O[d]); O[d] = mfma32(lds44(va + d * 32 * DL_VROW + 32), pf1, O[d]); }
        if (kt > kt_lo) DL_STORE();
    }
#undef DL_LOAD
#undef DL_STORE
}
__device__ __forceinline__ void dil_unit(LAS unsigned char* wl, const bf16* NAT, const bf16* DLK, const bf16* VT, bf16* YD, int b, int h, int rho, int ut, int lane) {
    const int r = lane & 31, hh = lane >> 5;
    const size_t tok0 = (size_t)b * SEQ;
    f32x16 O[4];
#pragma unroll
    for (int d = 0; d < 4; ++d) O[d] = zero16();
    float m = -INFINITY, l = 0.f;
    dil_group<2>(wl, NAT, DLK, VT, tok0, h, rho, ut, lane, O, m, l);
    dil_group<1>(wl, NAT, DLK, VT, tok0, h, rho, ut, lane, O, m, l);
    dil_group<0>(wl, NAT, DLK, VT, tok0, h, rho, ut, lane, O, m, l);
    const float il = 1.f / l;
    const int tq = rho + 16 * (32 * ut + r);
    bf16* yp = YD + (tok0 + tq) * 1024 + h * 128 + 4 * hh;
#pragma unroll
    for (int d = 0; d < 4; ++d)
#pragma unroll
        for (int g = 0; g < 4; ++g) { v2u w; w.x = pg8::cvt_pk_bf16(O[d][4 * g] * il, O[d][4 * g + 1] * il); w.y = pg8::cvt_pk_bf16(O[d][4 * g + 2] * il, O[d][4 * g + 3] * il);
            *(v2u*)(yp + 32 * d + 8 * g) = w; }
}

__device__ __forceinline__ float ret_log2g(int h) { return __builtin_amdgcn_logf(1.f - __builtin_amdgcn_exp2f(-(float)(5 + h))); }
constexpr int RU_ROW = 132, RU_WAVE = 128 * RU_ROW;
__device__ __forceinline__ void retu_unit(LAS unsigned char* wl, const bf16* NAT, const bf16* VT, float* UR, int bh, int n, int lane) {
    const int r = lane & 31, hh = lane >> 5, b = bh >> 3, h = bh & 7;
    const size_t tokc = (size_t)b * SEQ + 128 * n;
    {   const bf16* kg = NAT + (tokc + (lane >> 3)) * NIN + C_RTK + h * 64 + 8 * (lane & 7);
        LAS unsigned* kw = (LAS unsigned*)(wl + (lane >> 3) * RU_ROW + (lane & 7) * 16);
#pragma unroll 1
        for (int i0 = 0; i0 < 16; i0 += 8) { v4u kv[8];
#pragma unroll
            for (int i = 0; i < 8; ++i) kv[i] = *(const v4u*)(kg + (size_t)8 * (i0 + i) * NIN);
#pragma unroll
            for (int i = 0; i < 8; ++i) { LAS unsigned* d = kw + 8 * (i0 + i) * (RU_ROW / 4); d[0] = kv[i].x; d[1] = kv[i].y; d[2] = kv[i].z; d[3] = kv[i].w; } } }
    bf16x8 kf[2][8];
    const float l2g = ret_log2g(h);
    float ge[8];
#pragma unroll
    for (int e = 0; e < 8; ++e) ge[e] = __builtin_amdgcn_exp2f(-(float)e * l2g);
#pragma unroll
    for (int s = 0; s < 8; ++s) { const float fs = __builtin_amdgcn_exp2f((float)(127 - 16 * s - 8 * hh) * l2g);
#pragma unroll
        for (int dt = 0; dt < 2; ++dt) { const LAS unsigned short* p = (const LAS unsigned short*)(wl + (16 * s + 8 * hh) * RU_ROW + (32 * dt + r) * 2);
            v4u w;
            w.x = pg8::cvt_pk_bf16(bf1(p[0 * (RU_ROW / 2)]) * (fs * ge[0]), bf1(p[1 * (RU_ROW / 2)]) * (fs * ge[1])); w.y = pg8::cvt_pk_bf16(bf1(p[2 * (RU_ROW / 2)]) * (fs * ge[2]), bf1(p[3 * (RU_ROW / 2)]) * (fs * ge[3]));
            w.z = pg8::cvt_pk_bf16(bf1(p[4 * (RU_ROW / 2)]) * (fs * ge[4]), bf1(p[5 * (RU_ROW / 2)]) * (fs * ge[5])); w.w = pg8::cvt_pk_bf16(bf1(p[6 * (RU_ROW / 2)]) * (fs * ge[6]), bf1(p[7 * (RU_ROW / 2)]) * (fs * ge[7]));
            kf[dt][s] = __builtin_bit_cast(bf16x8, w); __builtin_amdgcn_sched_barrier(0); } }
#pragma unroll 1
    for (int et = 0; et < 4; ++et) {
        const bf16* ap = VT + (size_t)(VT_RTV + h * 128 + 32 * et + r) * M + tokc + 8 * hh;
        f32x16 a0 = zero16(), a1 = zero16();
#pragma unroll
        for (int s = 0; s < 8; ++s) { const bf16x8 af = ld8(ap + 16 * s); a0 = mfma32(af, kf[0][s], a0); a1 = mfma32(af, kf[1][s], a1); }
        float* up = UR + ((size_t)(bh * 64 + n) * 128 + 32 * et + 4 * hh) * 64 + r;
#pragma unroll
        for (int i = 0; i < 16; ++i) { up[ROWOFF(i) * 64] = a0[i]; up[ROWOFF(i) * 64 + 32] = a1[i]; }
    }
}
__device__ __forceinline__ void ret_out_unit(LAS unsigned char* wl, const bf16* NAT, const bf16* VT, const bf16* SR, bf16* YR, int bh, int n, int it, int lane) {
    const int r = lane & 31, hh = lane >> 5, b = bh >> 3, h = bh & 7;
    const size_t tok0 = (size_t)b * SEQ + 128 * n;
    const int il = 32 * it + r;
    const float l2g = ret_log2g(h);
    const bf16* qp = NAT + (tok0 + il) * NIN + C_RTQ + h * 64 + 8 * hh;
    bf16x8 qf[4];
#pragma unroll
    for (int s = 0; s < 4; ++s) qf[s] = ld8(qp + 16 * s);
    f32x16 O[4];
    const bf16* sp = SR + ((size_t)(bh * 64 + n) * 128 + r) * 64 + 8 * hh;
    const float qd = __builtin_amdgcn_exp2f((float)(il + 1) * l2g);
#pragma unroll
    for (int e = 0; e < 4; ++e) { f32x16 a = zero16();
#pragma unroll
        for (int s = 0; s < 4; ++s) a = mfma32(ld8(sp + e * 32 * 64 + 16 * s), qf[s], a);
        O[e] = a * qd; }
    for (int jt = 0; jt <= it; ++jt) {
        const bf16* kp = NAT + (tok0 + 32 * jt + r) * NIN + C_RTK + h * 64 + 8 * hh;
        f32x16 s = zero16();
#pragma unroll
        for (int ks = 0; ks < 4; ++ks) s = mfma32(ld8(kp + 16 * ks), qf[ks], s);
        const int dq = il - 32 * jt - 4 * hh;
#pragma unroll
        for (int i = 0; i < 16; ++i) { const int d = dq - ROWOFF(i); s[i] = d >= 0 ? s[i] * __builtin_amdgcn_exp2f((float)d * l2g) : 0.f; }
        const bf16x8 pf0 = pack8<0>(s), pf1 = pack8<1>(s);
        const bf16* vp = VT + (size_t)(VT_RTV + h * 128 + r) * M + tok0 + 32 * jt + 4 * hh;
#pragma unroll
        for (int e = 0; e < 4; ++e) { O[e] = mfma32(ld44(vp + (size_t)e * 32 * M), pf0, O[e]); O[e] = mfma32(ld44(vp + (size_t)e * 32 * M + 16), pf1, O[e]); }
    }
    float sm = 0.f;
#pragma unroll
    for (int e = 0; e < 4; ++e)
#pragma unroll
        for (int i = 0; i < 16; ++i) sm += O[e][i];
    const float mean = half_sum(sm) * (1.f / 128.f);
    float sq = 0.f;
#pragma unroll
    for (int e = 0; e < 4; ++e)
#pragma unroll
        for (int i = 0; i < 16; ++i) { const float d = O[e][i] - mean; O[e][i] = d; sq += d * d; }
    const float rs = __builtin_amdgcn_rsqf(half_sum(sq) * (1.f / 128.f) + EPS);
    const bf16* gp = NAT + (tok0 + il) * NIN + C_RTG + h * 128 + 4 * hh;
#pragma unroll
    for (int e = 0; e < 4; ++e)
#pragma unroll
        for (int g = 0; g < 4; ++g) { const int d0 = 32 * e + 8 * g; const v2u gw = *(const v2u*)(gp + d0);
            const float g0 = bflo(gw.x), g1 = bfhi(gw.x), g2 = bflo(gw.y), g3 = bfhi(gw.y);
            v2u w; w.x = pg8::cvt_pk_bf16(O[e][4 * g] * rs * g0 * fsigmoid(g0), O[e][4 * g + 1] * rs * g1 * fsigmoid(g1));
            w.y = pg8::cvt_pk_bf16(O[e][4 * g + 2] * rs * g2 * fsigmoid(g2), O[e][4 * g + 3] * rs * g3 * fsigmoid(g3));
            ot_put(wl, r, hh, d0, w); }
    ot_emit(wl, YR + (tok0 + 32 * it) * 1024 + h * 128, 1, lane);
}

constexpr int HP_ROW = 136, HP_WAVE = 128 * HP_ROW;
static_assert(8 * HP_WAVE <= LDSCTL_OFF, "HGRN prep LDS map");
__device__ __forceinline__ float lb_of(const float* lbl, int layer, int c) {
    if (layer == 0) return 0.f;
    float mx = -INFINITY; for (int d = 0; d < DEPTH; ++d) mx = fmaxf(mx, lbl[d * 1024 + c]);
    float den = 0.f, num = 0.f;
    for (int d = 0; d < DEPTH; ++d) { const float e = __expf(lbl[d * 1024 + c] - mx); den += e; if (d >= 1 && d <= layer) num += e; }
    return num / den;
}
__device__ __forceinline__ void hgpu_unit(LAS unsigned char* wl, const bf16* NAT, const bf16* VT, const float* lbl, int layer, bf16* QT, bf16* KT, bf16* QC, float* DEC, float* UH, int bh, int n, int lane) {
    const int r = lane & 31, hh = lane >> 5, b = bh >> 3, h = bh & 7;
    const size_t t0 = (size_t)b * SEQ + 64 * n;
    const int c2 = h * 128 + 2 * lane;
    const float lb0 = lb_of(lbl, layer, c2), lb1 = lb_of(lbl, layer, c2 + 1), om0 = 1.f - lb0, om1 = 1.f - lb1;
    const unsigned* fp = (const unsigned*)(NAT + t0 * NIN + C_HGF + c2); const unsigned* qp = (const unsigned*)(NAT + t0 * NIN + C_HGQ + c2);
    float run0 = 0.f, run1 = 0.f, ref0 = 0.f, ref1 = 0.f;
#pragma unroll 1
    for (int jb = 0; jb < 4; ++jb) { unsigned fv[16];
#pragma unroll
        for (int k = 0; k < 16; ++k) fv[k] = fp[(size_t)(16 * jb + k) * (NIN / 2)];
#pragma unroll
        for (int k = 0; k < 16; ++k) { run0 += __logf(lb0 + om0 / (1.f + __expf(-bflo(fv[k])))); run1 += __logf(lb1 + om1 / (1.f + __expf(-bfhi(fv[k])))); }
        if (jb == 1) { ref0 = run0; ref1 = run1; } }
    const float bl0 = run0, bl1 = run1; run0 = 0.f; run1 = 0.f;
    unsigned* const QTu = (unsigned*)QT + (t0 * 1024 + c2) / 2; unsigned* const KTu = (unsigned*)KT + (t0 * 1024 + c2) / 2; unsigned* const QCu = (unsigned*)QC + (t0 * 1024 + c2) / 2;
    LAS unsigned char* kw = wl + (2 * lane) * HP_ROW;
#pragma unroll 1
    for (int jb = 0; jb < 4; ++jb) { unsigned fv[16], qv[16];
#pragma unroll
        for (int k = 0; k < 16; ++k) { fv[k] = fp[(size_t)(16 * jb + k) * (NIN / 2)]; qv[k] = qp[(size_t)(16 * jb + k) * (NIN / 2)]; }
        unsigned kp0 = 0u, kp1 = 0u;
#pragma unroll
        for (int k = 0; k < 16; ++k) { const int j = 16 * jb + k;
            const float lf0 = __logf(lb0 + om0 / (1.f + __expf(-bflo(fv[k])))), lf1 = __logf(lb1 + om1 / (1.f + __expf(-bfhi(fv[k]))));
            run0 += lf0; run1 += lf1;
            const float q0 = bflo(qv[k]), q1 = bfhi(qv[k]);
            const float qs0 = q0 / (1.f + __expf(-q0)), qs1 = q1 / (1.f + __expf(-q1)), kin0 = 1.f - __expf(lf0), kin1 = 1.f - __expf(lf1);
            QTu[(size_t)j * 512] = pk2(qs0 * __expf(run0 - ref0), qs1 * __expf(run1 - ref1));
            KTu[(size_t)j * 512] = pk2(kin0 * __expf(ref0 - run0), kin1 * __expf(ref1 - run1));
            QCu[(size_t)j * 512] = pk2(qs0 * __expf(run0), qs1 * __expf(run1));
            const unsigned k0b = f2bf(kin0 * __expf(bl0 - run0)), k1b = f2bf(kin1 * __expf(bl1 - run1));
            if (k & 1) { *(LAS unsigned*)(kw + 2 * (j - 1)) = kp0 | (k0b << 16); *(LAS unsigned*)(kw + HP_ROW + 2 * (j - 1)) = kp1 | (k1b << 16); } else { kp0 = k0b; kp1 = k1b; } } }
    { float2 dv; dv.x = __expf(bl0); dv.y = __expf(bl1); *(float2*)(DEC + (size_t)(b * 128 + n) * 1024 + c2) = dv; }
    const LAS unsigned char* kr = wl + r * HP_ROW + 16 * hh;
#pragma unroll 1
    for (int et = 0; et < 4; ++et) {
        const bf16* ap = VT + (size_t)(VT_HGI + h * 128 + 32 * et + r) * M + t0 + 8 * hh;
        bf16x8 af[4];
#pragma unroll
        for (int s2 = 0; s2 < 4; ++s2) af[s2] = ld8(ap + 16 * s2);
        float* up = UH + ((size_t)(bh * 128 + n) * 128 + 32 * et + 4 * hh) * 128 + r;
#pragma unroll
        for (int ct = 0; ct < 4; ++ct) { f32x16 a = zero16();
#pragma unroll
            for (int s2 = 0; s2 < 4; ++s2) { const LAS unsigned char* p = kr + ct * 32 * HP_ROW + 32 * s2;
                const bf16x4 lo = *(const LAS bf16x4*)p, hi = *(const LAS bf16x4*)(p + 8);
                a = mfma32(af[s2], __builtin_shufflevector(lo, hi, 0, 1, 2, 3, 4, 5, 6, 7), a); }
#pragma unroll
            for (int i = 0; i < 16; ++i) up[ROWOFF(i) * 128 + 32 * ct] = a[i]; }
    }
}
__device__ __forceinline__ void hg_out_unit(LAS unsigned char* wl, const bf16* NAT, const bf16* VT, const bf16* QT, const bf16* KT, const bf16* QC, const bf16* SH, const float* normg, bf16* YC, int bh, int n, int it, int lane) {
    const int r = lane & 31, hh = lane >> 5, b = bh >> 3, h = bh & 7;
    const size_t tok0 = (size_t)b * SEQ + 64 * n;
    const int il = 32 * it + r;
    f32x16 O[4];
#pragma unroll
    for (int e = 0; e < 4; ++e) O[e] = zero16();
    {
        const bf16* sp = SH + ((size_t)(bh * 128 + n) * 128 + r) * 128 + 8 * hh;
        const bf16* qc = QC + (tok0 + il) * 1024 + h * 128 + 8 * hh;
#pragma unroll
        for (int s = 0; s < 8; ++s) { const bf16x8 qf = ld8(qc + 16 * s);
#pragma unroll
            for (int e = 0; e < 4; ++e) O[e] = mfma32(ld8(sp + e * 32 * 128 + 16 * s), qf, O[e]); }
    }
    const bf16* qp = QT + (tok0 + il) * 1024 + h * 128 + 8 * hh;
    bf16x8 qf[8];
#pragma unroll
    for (int s = 0; s < 8; ++s) qf[s] = ld8(qp + 16 * s);
    for (int jt = 0; jt <= it; ++jt) {
        const bf16* kp = KT + (tok0 + 32 * jt + r) * 1024 + h * 128 + 8 * hh;
        f32x16 s = zero16();
#pragma unroll
        for (int ks = 0; ks < 8; ++ks) s = mfma32(ld8(kp + 16 * ks), qf[ks], s);
        const int dq = il - 32 * jt - 4 * hh;
#pragma unroll
        for (int i = 0; i < 16; ++i) s[i] = (dq - ROWOFF(i) >= 0) ? s[i] : 0.f;
        const bf16x8 pf0 = pack8<0>(s), pf1 = pack8<1>(s);
        const bf16* vp = VT + (size_t)(VT_HGI + h * 128 + r) * M + tok0 + 32 * jt + 4 * hh;
#pragma unroll
        for (int e = 0; e < 4; ++e) { O[e] = mfma32(ld44(vp + (size_t)e * 32 * M), pf0, O[e]); O[e] = mfma32(ld44(vp + (size_t)e * 32 * M + 16), pf1, O[e]); }
    }
    float sq = 0.f;
#pragma unroll
    for (int e = 0; e < 4; ++e)
#pragma unroll
        for (int i = 0; i < 16; ++i) sq += O[e][i] * O[e][i];
    const float rs = __builtin_amdgcn_rsqf(half_sum(sq) * (1.f / 128.f) + EPS);
    const bf16* gp = NAT + (tok0 + il) * NIN + C_HGG + h * 128 + 4 * hh;
#pragma unroll
    for (int e = 0; e < 4; ++e)
#pragma unroll
        for (int g = 0; g < 4; ++g) { const int d0 = 32 * e + 8 * g; const v2u gw = *(const v2u*)(gp + d0); const f32x4 ng = *(const f32x4*)(normg + d0 + 4 * hh);
            const float g0 = bflo(gw.x), g1 = bfhi(gw.x), g2 = bflo(gw.y), g3 = bfhi(gw.y);
            v2u w; w.x = pg8::cvt_pk_bf16(O[e][4 * g] * rs * ng.x * g0 * fsigmoid(g0), O[e][4 * g + 1] * rs * ng.y * g1 * fsigmoid(g1));
            w.y = pg8::cvt_pk_bf16(O[e][4 * g + 2] * rs * ng.z * g2 * fsigmoid(g2), O[e][4 * g + 3] * rs * ng.w * g3 * fsigmoid(g3));
            ot_put(wl, r, hh, d0, w); }
    ot_emit(wl, YC + (tok0 + 32 * it) * 1024 + h * 128, 1, lane);
}

__device__ __forceinline__ void ln_stage_gb(LAS unsigned char* lds, const float* g, const float* bb, int tid) {
    const GAS f32x4* gs = (const GAS f32x4*)g; const GAS f32x4* bs = (const GAS f32x4*)bb;
#pragma unroll
    for (int j = 0; j < 2; ++j) { ((LAS f32x4*)lds)[tid + 512 * j] = gs[tid + 512 * j]; ((LAS f32x4*)(lds + DM * 4))[tid + 512 * j] = bs[tid + 512 * j]; }
    __syncthreads();
}
__device__ __forceinline__ void unpack8(const v4u a, f32x4& lo, f32x4& hi) { lo = (f32x4){bflo(a.x), bfhi(a.x), bflo(a.y), bfhi(a.y)}; hi = (f32x4){bflo(a.z), bfhi(a.z), bflo(a.w), bfhi(a.w)}; }
template <bool HBF>
__device__ __forceinline__ void ln_row(const LAS unsigned char* lds, const void* hin, const bf16* add, float* of, bf16* ob, bf16* op4, bf16* op16, int lane) {
    const GAS v4u* ar = (const GAS v4u*)add + lane;
    f32x4 v[16]; float s = 0.f;
    if constexpr (HBF) { const GAS v4u* hr = (const GAS v4u*)hin + lane;
        v4u ha[8], aa[8];
#pragma unroll
        for (int j = 0; j < 8; ++j) { ha[j] = hr[64 * j]; aa[j] = ar[64 * j]; }
#pragma unroll
        for (int j = 0; j < 8; ++j) { f32x4 h0, h1, a0, a1; unpack8(ha[j], h0, h1); unpack8(aa[j], a0, a1); v[2 * j] = h0 * ALPHA + a0; v[2 * j + 1] = h1 * ALPHA + a1; }
    } else { const GAS f32x4* hr = (const GAS f32x4*)hin + 2 * lane;
        v4u aa[8];
#pragma unroll
        for (int j = 0; j < 8; ++j) { v[2 * j] = hr[128 * j]; v[2 * j + 1] = hr[128 * j + 1]; aa[j] = ar[64 * j]; }
#pragma unroll
        for (int j = 0; j < 8; ++j) { f32x4 a0, a1; unpack8(aa[j], a0, a1); v[2 * j] = v[2 * j] * ALPHA + a0; v[2 * j + 1] = v[2 * j + 1] * ALPHA + a1; }
    }
#pragma unroll
    for (int j = 0; j < 16; ++j) s += (v[j].x + v[j].y) + (v[j].z + v[j].w);
    const float mean = wave_sum(s, lane) * (1.f / DM); float s2 = 0.f;
#pragma unroll
    for (int j = 0; j < 16; ++j) { v[j] = v[j] - mean; s2 += (v[j].x * v[j].x + v[j].y * v[j].y) + (v[j].z * v[j].z + v[j].w * v[j].w); }
    const float rstd = 1.f / sqrtf(wave_sum(s2, lane) * (1.f / DM) + EPS);
    const LAS f32x4* gr = (const LAS f32x4*)lds + 2 * lane; const LAS f32x4* br = (const LAS f32x4*)(lds + DM * 4) + 2 * lane;
#pragma unroll
    for (int j = 0; j < 8; ++j) { const f32x4 o0 = v[2 * j] * rstd * gr[128 * j] + br[128 * j], o1 = v[2 * j + 1] * rstd * gr[128 * j + 1] + br[128 * j + 1];
        if (of) { ((GAS f32x4*)of + 2 * lane)[128 * j] = o0; ((GAS f32x4*)of + 2 * lane)[128 * j + 1] = o1; }
        v4u w; w.x = pk2(o0.x, o0.y); w.y = pk2(o0.z, o0.w); w.z = pk2(o1.x, o1.y); w.w = pk2(o1.z, o1.w);
        if (ob) ((GAS v4u*)ob + lane)[64 * j] = w;
        if (op4) { ((GAS v4u*)op4 + lane)[64 * j] = w; ((GAS v4u*)op16 + lane)[64 * j] = w; }
        if (j & 1) __builtin_amdgcn_sched_barrier(0); }
}

constexpr int WPRIV = 17920;
static_assert(WPRIV >= DL_WAVE && WPRIV >= HP_WAVE && WPRIV >= RU_WAVE && 8 * WPRIV <= LDSCTL_OFF, "wave-private LDS stride");
__global__ void __launch_bounds__(NWAVES * 64, 2) mk_fwd(Args args) {
    extern __shared__ __attribute__((aligned(16))) unsigned char lds[];
    Frame F;
    F.lds = (LAS unsigned char*)lds;
    volatile LAS unsigned* MISC = (volatile LAS unsigned*)(F.lds + MISC_OFF);
    F.tid = threadIdx.x; F.lane = F.tid & 63; F.wave = __builtin_amdgcn_readfirstlane(F.tid >> 6);
    F.G = gridDim.x; { const int bx = blockIdx.x; F.vcu = (F.G % 8 == 0) ? (bx % 8) * (F.G / 8) + bx / 8 : bx; }
    F.ws = args.ws; F.ctl = (gu32*)(args.ws + WS_CTL);
    unsigned char* ws = args.ws;
    for (int u = F.tid; u < (LDS_BYTES - LDSCTL_OFF) / 4; u += NWAVES * 64) ((LAS unsigned*)(F.lds + LDSCTL_OFF))[u] = 0u;
    __syncthreads();
#if MK_PER_PHASE
    XcdBarrier bar; bar.bar = nullptr; bar.x = 0; bar.st = nullptr;
#define GRID_BAR() do { } while (0)
#else
    XcdBarrier bar = xcd_barrier_post((unsigned*)(F.ctl + CW_BAR), MISC + 8);
#define GRID_BAR() do { xcd_barrier(bar); if (DUP_BAR) xcd_barrier(bar); } while (0)
#endif
    const int lo = args.ph_lo, hi = args.ph_hi;
#define IN(k) (lo <= (k) && (k) < hi)
#define SEAM(k) do { if (IN(k) && IN((k) + 1)) GRID_BAR(); } while (0)
    const int NGW = F.G * NWAVES;
#define PHASE_IDS() int tid = threadIdx.x; asm volatile("" : "+v"(tid)); const int lane = tid & 63; const int gw = F.vcu * NWAVES + __builtin_amdgcn_readfirstlane(tid >> 6); (void)lane; (void)gw

#define AB   ((bf16*)(ws + WS_AB))
#define XP4  ((bf16*)(ws + WS_XP4))
#define XP16 ((bf16*)(ws + WS_XP16))
#define NAT  ((bf16*)(ws + WS_NAT))
#define VT   ((bf16*)(ws + WS_VT))
#define HQT  ((bf16*)(ws + WS_HQT))
#define HKT  ((bf16*)(ws + WS_HKT))
#define HQC  ((bf16*)(ws + WS_HQC))
#define HKH  ((bf16*)(ws + WS_HKH))
#define DEC  ((float*)(ws + WS_DEC))
#define UR   ((float*)(ws + WS_UR))
#define UH   ((float*)(ws + WS_UH))
#define SR   ((bf16*)(ws + WS_SR))
#define SH   ((bf16*)(ws + WS_SH))
#define YB   ((bf16*)(ws + WS_Y))
#define MRG  ((bf16*)(ws + WS_MRG))
#define MRGB ((bf16*)(ws + WS_MRGB))
#define H1   ((float*)(ws + WS_H1))
#define H2   ((float*)(ws + WS_H2))
#define EDG  ((float*)(ws + WS_UUP))
#define ACT  ((bf16*)(ws + WS_ACT))

    if (PHEN(0) && IN(0)) { for (int rep = 0; rep < NREP(0); ++rep) {
        if (F.G == 256) p0_convert<0>(F, F.vcu * NWAVES + F.wave, F.G * NWAVES);
        else { p0_convert<0>(F, F.vcu * NWAVES + F.wave, F.G * NWAVES); p0_convert<1>(F, F.vcu * NWAVES + F.wave, F.G * NWAVES); }
        if (rep + 1 < NREP(0)) GRID_BAR(); } }
    SEAM(0);
    if (PHEN(0) && IN(1) && F.G == 256 && (int)blockIdx.x >= F.G - NCONV) { p0_convert<1>(F, ((int)blockIdx.x - (F.G - NCONV)) * NWAVES + F.wave, NCONV * NWAVES); __syncthreads(); }

    for (int l = 0; l < DEPTH; ++l) {
        const int pb = 1 + 12 * l;


        if (PHEN(1) && IN(pb + 0)) for (int rep = 0; rep < NREP(1); ++rep) { PHASE_IDS(); if (rep) GRID_BAR();
            EpiInProj E{NAT, VT, (bf16*)(ws + WS_DAK), (bf16*)(ws + WS_DLK)};
            const bool split = (l == 0) && (F.G == 256);
            { InProjSched<0> S{F.G, (int)blockIdx.x, AB, (const bf16*)(ws + WS_WIN + l * WIN_L), split ? CONV_S1 : 0}; pg8::gemm_phase<EpiInProj, InProjSched<0>, true, true, 1>(F.lds, DM, S, E, tid); }
            { InProjSched<1> S{F.G, (int)blockIdx.x, AB, (const bf16*)(ws + WS_WIN + l * WIN_L), 0}; pg8::gemm_phase<EpiInProj, InProjSched<1>, true, true, 4>(F.lds, DM, S, E, tid); }
            { InProjSched<2> S{F.G, (int)blockIdx.x, AB, (const bf16*)(ws + WS_WIN + l * WIN_L), 0}; pg8::gemm_phase<EpiInProj, InProjSched<2>, true, true, 16>(F.lds, DM, S, E, tid); }
        }
        SEAM(pb + 0);

        if (PHEN(2) && IN(pb + 1)) for (int rep = 0; rep < NREP(2); ++rep) { PHASE_IDS(); if (rep) GRID_BAR();
            for (int it = gw; it < 16 * 128; it += NGW) hgpu_unit(F.lds + (tid >> 6) * WPRIV, NAT, VT, INP(4), l, HQT, HKT, HQC, DEC, UH, it >> 7, it & 127, lane);
            if ((gw & 7) < 4)
                for (int it = (gw >> 3) * 4 + (gw & 7); it < 16 * 64; it += (NGW >> 1)) retu_unit(F.lds + (tid >> 6) * WPRIV, NAT, VT, UR, it >> 6, it & 63, lane);
            {
                float mq = 0.f, mk = 0.f;
                for (int m0 = gw; m0 < M; m0 += 4 * NGW) {
                    v4u a0[4], a1[4], b0[4], b1[4];
#pragma unroll
                    for (int i = 0; i < 4; ++i) { const int m = (m0 + i * NGW) < M ? m0 + i * NGW : m0;
                        const bf16* qr = NAT + (size_t)m * NIN + C_DAQ + 16 * lane;
                        const bf16* kr = (const bf16*)(ws + WS_DAK) + ((size_t)((m / SEQ) * 8 + (lane >> 3)) * SEQ + (m % SEQ)) * 128 + 16 * (lane & 7);
                        a0[i] = *(const v4u*)qr; a1[i] = *(const v4u*)(qr + 8); b0[i] = *(const v4u*)kr; b1[i] = *(const v4u*)(kr + 8); }
#pragma unroll
                    for (int i = 0; i < 4; ++i) { float sq = 0.f, sk = 0.f;
#pragma unroll
                        for (int e = 0; e < 4; ++e) { sq += bflo(a0[i][e]) * bflo(a0[i][e]) + bfhi(a0[i][e]) * bfhi(a0[i][e]) + bflo(a1[i][e]) * bflo(a1[i][e]) + bfhi(a1[i][e]) * bfhi(a1[i][e]);
                                                      sk += bflo(b0[i][e]) * bflo(b0[i][e]) + bfhi(b0[i][e]) * bfhi(b0[i][e]) + bflo(b1[i][e]) * bflo(b1[i][e]) + bfhi(b1[i][e]) * bfhi(b1[i][e]); }
                        sq += lane_xor(sq, 1, lane); sq += lane_xor(sq, 2, lane); sk += lane_xor(sk, 1, lane); sk += lane_xor(sk, 2, lane);
                        mq = fmaxf(mq, sq); mk = fmaxf(mk, sk); }
                }
                if ((lane & 3) == 0) { gu32* nb = F.ctl + CW_NRM + 64 * l + (lane >> 3) * 4 + ((lane >> 2) & 1);
                    __hip_atomic_fetch_max(nb, __float_as_uint(mq), RLX_AGENT); __hip_atomic_fetch_max(nb + 2, __float_as_uint(mk), RLX_AGENT); }
            }
        }
        SEAM(pb + 1);

        if ((PHEN(3) || PHEN(4)) && IN(pb + 2)) for (int rep = 0; rep < NREP(3); ++rep) { PHASE_IDS(); if (rep) GRID_BAR();
            for (int e = F.vcu * 512 + tid; e < 16 * 8192; e += F.G * 512) {
                const int bh = e >> 13, h = bh & 7; const float cd = __builtin_amdgcn_exp2f(128.f * ret_log2g(h));
                const float* up = UR + (size_t)bh * 64 * 8192 + (e & 8191); bf16* sp = SR + (size_t)bh * 64 * 8192 + (e & 8191);
                float s = 0.f;
                for (int n0 = 0; n0 < 64; n0 += 32) { float uv[32];
#pragma unroll
                    for (int k = 0; k < 32; ++k) uv[k] = up[(size_t)(n0 + k) * 8192];
#pragma unroll
                    for (int k = 0; k < 32; ++k) { sp[(size_t)(n0 + k) * 8192] = (bf16)f2bf(s); s = cd * s + uv[k]; } }
            }
            {
                const int stride = F.G * 512;
                for (int e = F.vcu * 512 + tid; e < 16 * 16384; e += 2 * stride) {
                    const bool two = (e + stride) < 16 * 16384; const int e1 = two ? e + stride : e;
                    const int bh0 = e >> 14, bh1 = e1 >> 14;
                    const float* up0 = UH + (size_t)bh0 * 128 * 16384 + (e & 16383); bf16* sp0 = SH + (size_t)bh0 * 128 * 16384 + (e & 16383);
                    const float* up1 = UH + (size_t)bh1 * 128 * 16384 + (e1 & 16383); bf16* sp1 = SH + (size_t)bh1 * 128 * 16384 + (e1 & 16383);
                    const float* dp0 = DEC + (size_t)(bh0 >> 3) * 128 * 1024 + (bh0 & 7) * 128 + (e & 127);
                    const float* dp1 = DEC + (size_t)(bh1 >> 3) * 128 * 1024 + (bh1 & 7) * 128 + (e1 & 127);
                    float s0 = 0.f, s1 = 0.f;
                    for (int n0 = 0; n0 < 128; n0 += 32) { float u0[32], d0[32], u1[32], d1[32];
#pragma unroll
                        for (int k = 0; k < 32; ++k) { u0[k] = up0[(size_t)(n0 + k) * 16384]; d0[k] = dp0[(size_t)(n0 + k) * 1024]; u1[k] = up1[(size_t)(n0 + k) * 16384]; d1[k] = dp1[(size_t)(n0 + k) * 1024]; }
#pragma unroll
                        for (int k = 0; k < 32; ++k) { sp0[(size_t)(n0 + k) * 16384] = (bf16)f2bf(s0); s0 = d0[k] * s0 + u0[k];
                            if (two) sp1[(size_t)(n0 + k) * 16384] = (bf16)f2bf(s1); s1 = d1[k] * s1 + u1[k]; } }
                }
            }
        }
        SEAM(pb + 2); if (IN(pb + 2) && !IN(pb + 3) && IN(pb + 4)) GRID_BAR();

        if (PHEN(5) && IN(pb + 4)) for (int rep = 0; rep < NREP(5); ++rep) { PHASE_IDS(); if (rep) GRID_BAR();
            gu32* wq = F.ctl + CW_WQ + 64 * 4 * (l + 2 * rep);
            {
                const float* lv = INP(2) + l * 256;
                const float p01 = wave_sum(lv[lane] * lv[64 + lane], lane), p23 = wave_sum(lv[128 + lane] * lv[192 + lane], lane);
                const float lam_init = 0.8f - 0.6f * __expf(-0.3f * (float)l);
                const float lam = __expf(p01) - __expf(p23) + lam_init;
                const float* ng = INP(3) + l * 128;
                volatile LAS unsigned* wqw = (volatile LAS unsigned*)(F.lds + MISC_OFF);
                for (int rp = 0; rp < NMIX(0); ++rp)
                for (;;) {
                    if (tid == 0) wqw[0] = __hip_atomic_fetch_add(wq + 2048 * rp, 1u, RLX_AGENT);
                    __syncthreads();
                    const int it = (int)wqw[0];
                    if (it >= 16 * 32) break;
                    diff_block(F.lds, (volatile LAS unsigned*)(F.lds + MISC_OFF + 64), (const unsigned*)(F.ctl + CW_NRM + 64 * l), NAT, (const bf16*)(ws + WS_DAK), VT, YB, ng, lam, 1.f - lam_init, (it & 15) >> 3, it & 7, 31 - (it >> 4), tid);
                }
            }
            __syncthreads();
            for (int rp = 0; rp < NMIX(1); ++rp)
            for (;;) { const int it = wq_pull(wq + 64 + 2048 * rp, lane); if (it >= 16 * 256) break;
                dil_unit(F.lds + (tid >> 6) * WPRIV, NAT, (const bf16*)(ws + WS_DLK), VT, YB + (size_t)3 * M * 1024, it >> 11, (it >> 8) & 7, (it >> 4) & 15, it & 15, lane); }
            for (int rp = 0; rp < NMIX(2); ++rp)
            for (;;) { const int it = wq_pull(wq + 128 + 2048 * rp, lane); if (it >= 16 * 64 * 4) break;
                ret_out_unit(F.lds + (tid >> 6) * WPRIV, NAT, VT, SR, YB + (size_t)1 * M * 1024, it >> 8, (it >> 2) & 63, it & 3, lane); }
            {   const float* ng = INP(5) + l * 128;
                for (int rp = 0; rp < NMIX(3); ++rp)
                for (;;) { const int it = wq_pull(wq + 192 + 2048 * rp, lane); if (it >= 16 * 128 * 2) break;
                    hg_out_unit(F.lds + (tid >> 6) * WPRIV, NAT, VT, HQT, HKT, HQC, SH, ng, YB + (size_t)2 * M * 1024, it >> 8, (it >> 1) & 127, it & 1, lane); } }
        }
        SEAM(pb + 4);

        if (PHEN(6) && IN(pb + 5)) for (int rep = 0; rep < NREP(6); ++rep) { PHASE_IDS(); if (rep) GRID_BAR();
            MergeSched S{F.G, (int)blockIdx.x, YB, (const bf16*)(ws + WS_WBR + l * WBR_L)};
            EpiMerge E{NAT, MRGB};
            pg8::gemm_phase<EpiMerge, MergeSched, true, true>(F.lds, 1024, S, E, tid);
        }
        SEAM(pb + 5);

        if (PHEN(7) && IN(pb + 6)) for (int rep = 0; rep < NREP(7); ++rep) { PHASE_IDS(); if (rep) GRID_BAR();
            PlainSched S{F.G, (int)blockIdx.x, 16, DM, MRGB, (const bf16*)(ws + WS_WO + l * WO_L)};
            EpiBf16 E{MRG, DM};
            pg8::gemm_phase<EpiBf16, PlainSched, true, true>(F.lds, DM, S, E, tid);
        }
        SEAM(pb + 6);

        if (PHEN(8) && IN(pb + 7)) for (int rep = 0; rep < NREP(8); ++rep) { PHASE_IDS(); if (rep) GRID_BAR();
            const float* g = INP(8) + l * DM; const float* bb = INP(9) + l * DM;
            ln_stage_gb(F.lds, g, bb, tid);
            if (l == 0) { const float* hin = INP(0);
                for (int m = gw; m < M; m += NGW) ln_row<false>(F.lds, hin + (size_t)m * DM, MRG + (size_t)m * DM, nullptr, AB + (size_t)m * DM, nullptr, nullptr, lane);
            } else {
                for (int m = gw; m < M; m += NGW) ln_row<true>(F.lds, AB + (size_t)m * DM, MRG + (size_t)m * DM, nullptr, AB + (size_t)m * DM, nullptr, nullptr, lane); }
        }
        SEAM(pb + 7);

        if (PHEN(9) && IN(pb + 8)) for (int rep = 0; rep < NREP(9); ++rep) { PHASE_IDS(); if (rep) GRID_BAR();
            PlainSched S{F.G, (int)blockIdx.x, NUP / 256, DM, AB, (const bf16*)(ws + WS_WUP + l * WUP_L)};
            EpiAct E{ACT, INP(11) + (size_t)l * 3 * DFF, INP(12) + (size_t)l * DFF, EDG, EDG + (size_t)256 * DFF, EDG + (size_t)512 * DFF};
            pg8::gemm_phase<EpiAct, PlainSched, true, true>(F.lds, DM, S, E, tid);
        }
        SEAM(pb + 8);

        if (PHEN(10) && IN(pb + 9)) for (int rep = 0; rep < NREP(10); ++rep) { PHASE_IDS(); if (rep) GRID_BAR();
            const float* cw = INP(11) + (size_t)l * 3 * DFF; const float* cb = INP(12) + (size_t)l * DFF;
            const float* EA = EDG; const float* EG = EDG + (size_t)256 * DFF; const float* EL = EDG + (size_t)512 * DFF;
            constexpr int NC4 = DFF / 4;
            for (int it = F.vcu * 512 + tid; it < 128 * NC4; it += F.G * 512) {
                const int seg = it / NC4, c = 4 * (it % NC4); const bool first = (seg % (SEQ / 128)) == 0;
                const f32x4 z = (f32x4){0.f, 0.f, 0.f, 0.f};
                const f32x4 am2 = first ? z : *(const f32x4*)(EL + (size_t)(seg * 2 - 2) * DFF + c), am1 = first ? z : *(const f32x4*)(EL + (size_t)(seg * 2 - 1) * DFF + c);
                const f32x4 a0 = *(const f32x4*)(EA + (size_t)(seg * 2) * DFF + c), a1 = *(const f32x4*)(EA + (size_t)(seg * 2 + 1) * DFF + c);
                const f32x4 g0 = *(const f32x4*)(EG + (size_t)(seg * 2) * DFF + c), g1 = *(const f32x4*)(EG + (size_t)(seg * 2 + 1) * DFF + c);
                const f32x4 w0 = *(const f32x4*)(cw + c), w1 = *(const f32x4*)(cw + DFF + c), w2 = *(const f32x4*)(cw + 2 * DFF + c), bc = *(const f32x4*)(cb + c);
                const f32x4 c0v = bc + w0 * am2 + w1 * am1 + w2 * a0, c1v = bc + w0 * am1 + w1 * a0 + w2 * a1;
                v2u o0, o1;
                o0.x = pk2(gelu1(c0v.x) * g0.x, gelu1(c0v.y) * g0.y); o0.y = pk2(gelu1(c0v.z) * g0.z, gelu1(c0v.w) * g0.w);
                o1.x = pk2(gelu1(c1v.x) * g1.x, gelu1(c1v.y) * g1.y); o1.y = pk2(gelu1(c1v.z) * g1.z, gelu1(c1v.w) * g1.w);
                *(v2u*)(ACT + (size_t)(seg * 128) * DFF + c) = o0; *(v2u*)(ACT + (size_t)(seg * 128 + 1) * DFF + c) = o1;
            }
        }
        SEAM(pb + 9);

        if (PHEN(11) && IN(pb + 10)) for (int rep = 0; rep < NREP(11); ++rep) { PHASE_IDS(); if (rep) GRID_BAR();
            PlainSched S{F.G, (int)blockIdx.x, 16, DFF, ACT, (const bf16*)(ws + WS_WDN + l * WDN_L)};
            EpiBf16 E{MRG, DM};
            pg8::gemm_phase<EpiBf16, PlainSched, true, true>(F.lds, DFF, S, E, tid);
        }
        SEAM(pb + 10);

        if (PHEN(12) && IN(pb + 11)) for (int rep = 0; rep < NREP(12); ++rep) { PHASE_IDS(); if (rep) GRID_BAR();
            const float* g = INP(14) + l * DM; const float* bb = INP(15) + l * DM;
            const bool lastl = (l == DEPTH - 1); float* hout = (float*)INP(16);
            ln_stage_gb(F.lds, g, bb, tid);
            for (int m = gw; m < M; m += NGW)
                ln_row<true>(F.lds, AB + (size_t)m * DM, MRG + (size_t)m * DM, lastl ? hout + (size_t)m * DM : nullptr, lastl ? nullptr : AB + (size_t)m * DM, nullptr, nullptr, lane);
        }
        if (l + 1 < DEPTH) SEAM(pb + 11);
    }
#undef IN
#undef SEAM
}

constexpr int N_PHASES = 1 + 12 * DEPTH;
extern "C" void kernel_launch(void* const* d_in, const int* in_sizes, int n_in, void* d_out, int out_size, void* d_ws, size_t ws_size, hipStream_t stream) {
    static int grid = 0;
    if (grid == 0) {
        if (n_in != 16 || in_sizes[0] != M * DM || out_size != M * DM || ws_size < WS_END) { fprintf(stderr, "kernel_launch: unexpected shapes / workspace (n_in %d, ws %zu < %zu)\n", n_in, ws_size, (size_t)WS_END); grid = -1; return; }
        int dev = 0, cus = 0, per_cu = 0;
        if (hipGetDevice(&dev) != hipSuccess || hipDeviceGetAttribute(&cus, hipDeviceAttributeMultiprocessorCount, dev) != hipSuccess) { grid = -1; return; }
        if (hipFuncSetAttribute((const void*)mk_fwd, hipFuncAttributeMaxDynamicSharedMemorySize, LDS_BYTES) != hipSuccess) { fprintf(stderr, "kernel_launch: hipFuncSetAttribute failed\n"); grid = -1; return; }
        if (hipOccupancyMaxActiveBlocksPerMultiprocessor(&per_cu, (const void*)mk_fwd, NWAVES * 64, LDS_BYTES) != hipSuccess || per_cu < 1)
            fprintf(stderr, "kernel_launch: note: occupancy query reports %d workgroups per CU\n", per_cu);
        (void)hipGetLastError();
        grid = cus;
    }
    if (grid < 0) return;
    if (hipMemsetAsync((char*)d_ws + WS_CTL, 0, CTL_ZERO_BYTES, stream) != hipSuccess) { fprintf(stderr, "kernel_launch: memset failed\n"); return; }
    Args a{};
    for (int i = 0; i < 16; ++i) a.in[i] = (const float*)d_in[i];
    a.out = (float*)d_out; a.ws = (unsigned char*)d_ws;
#if MK_PER_PHASE
    for (int p = 0; p < N_PHASES; ++p) { a.ph_lo = p; a.ph_hi = p + 1; hipLaunchKernelGGL(mk_fwd, dim3(grid), dim3(NWAVES * 64), LDS_BYTES, stream, a); }
#else
    a.ph_lo = 0; a.ph_hi = N_PHASES;
    hipLaunchKernelGGL(mk_fwd, dim3(grid), dim3(NWAVES * 64), LDS_BYTES, stream, a);
#endif
    const hipError_t le = hipPeekAtLastError();
    if (le != hipSuccess) fprintf(stderr, "kernel_launch: launch failed: %s\n", hipGetErrorName(le));
}
```

```cpp
#include <hip/hip_runtime.h>
#include <cstdio>
#include <cstdint>

#ifndef MK_PER_PHASE
#define MK_PER_PHASE 0
#endif
#ifndef PH_MASK
#define PH_MASK 0x1fff
#endif
#define PHEN(k) (((PH_MASK) >> (k)) & 1)
#ifndef REP_MASK
#define REP_MASK 0
#endif
#define NREP(k) ((((REP_MASK) >> (k)) & 1) ? 2 : 1)
#ifndef MIX_REP
#define MIX_REP 0
#endif
#define NMIX(k) ((((MIX_REP) >> (k)) & 1) ? 2 : 1)
#ifndef DUP_BAR
#define DUP_BAR 0
#endif
#ifndef DUP_EPI
#define DUP_EPI 0
#endif

namespace pg8 {
#define PG8_LAS __attribute__((address_space(3)))
typedef unsigned short bf16_t;
typedef short bf16x8 __attribute__((ext_vector_type(8)));
typedef float f32x4 __attribute__((ext_vector_type(4)));
typedef unsigned u32x4 __attribute__((ext_vector_type(4)));
typedef unsigned u32x2 __attribute__((ext_vector_type(2)));
typedef float f32x2 __attribute__((ext_vector_type(2)));
constexpr int BM = 256, BK = 64, HALF = 128, HTB = HALF * BK * 2, STAGE_BYTES = 8 * HTB, NXCD = 8, WGM = 4;

__host__ __device__ __forceinline__ int lds_byte(int r, int c) { const int st = (r >> 4) * 2 + (c >> 5), rr = r & 15, cc = c & 31, ob = rr * 64 + cc * 2; return st * 1024 + (ob ^ (((ob >> 9) & 1) << 5)); }
__host__ __device__ __forceinline__ void stage_rc(int b, int& R, int& C) { const int st = b / 1024, sb = b % 1024, swz = sb ^ (((sb >> 9) & 1) << 5); R = (st >> 1) * 16 + swz / 64; C = (st & 1) * 32 + (swz % 64) / 2; }
__host__ __device__ __forceinline__ int perm32(int rho) { const int n = rho >> 4, i = rho & 15; return 8 * (i >> 2) + 4 * n + (i & 3); }

struct Unit { int pm, pn, kind; };

__device__ __forceinline__ void tile_map(int wgid, int nM, int nN, int& pm, int& pn) {
    const int nwg = nM * nN;
    { const int q = nwg / NXCD, r = nwg % NXCD, xcd = wgid % NXCD, off = wgid / NXCD; wgid = (xcd < r ? xcd * (q + 1) : r * (q + 1) + (xcd - r) * q) + off; }
    const int nig = WGM * nN, gid = wgid / nig, fm = gid * WGM, gsz = (nM - fm) < WGM ? (nM - fm) : WGM;
    pm = fm + ((wgid % nig) % gsz); pn = (wgid % nig) / gsz;
}

__device__ __forceinline__ unsigned cvt_pk_bf16(float lo, float hi) { unsigned r; asm volatile("v_cvt_pk_bf16_f32 %0, %1, %2" : "=v"(r) : "v"(lo), "v"(hi)); return r; }

template <class Epi, class Sched, bool ALIGN_EPI, bool SP2, int BSTRIDE = 1>
__device__ __forceinline__ void gemm_phase(PG8_LAS unsigned char* lds, const int K, const Sched& S, const Epi& E, const int tid) {
    constexpr int bstride = BSTRIDE;
    const int wid = __builtin_amdgcn_readfirstlane(tid >> 6), lane = tid & 63, wr = wid >> 2, wc = wid & 3, fr = lane & 15, fq = lane >> 4;
    const int nt = K / BK;
    unsigned voffA[2], voffB[2];
#pragma unroll
    for (int i = 0; i < 2; ++i) { int R, C; stage_rc(tid * 16 + i * 8192, R, C); const int Rb = Epi::PERM ? ((R & ~31) + perm32(R & 31)) : R;
        const int Ra = Epi::APERM ? (128 * (R >> 6) + 8 * (R & 15) + ((R >> 4) & 3)) : R;
        voffA[i] = (unsigned)(Ra * K + C) * 2u; voffB[i] = (unsigned)(Rb * bstride * K + C) * 2u; }
    const size_t kstep = (size_t)(BK * 2);
    const size_t hstepB = (size_t)HALF * K * 2 * bstride, hstepA = Epi::APERM ? (size_t)4 * K * 2 : (size_t)HALF * K * 2;
    const unsigned ldsw = (unsigned)wid * 1024u;
    const int aoff = lds_byte(wr * 64 + fr, fq * 8), boff = lds_byte(wc * 32 + fr, fq * 8);
#define PG8_SA(b, h) (((b) * 2 + (h)) * HTB)
#define PG8_SB(b, h) ((4 + (b) * 2 + (h)) * HTB)
#define PG8_STAGE(bufoff, gbase, voff) do { _Pragma("unroll") for (int _i = 0; _i < 2; ++_i) \
        __builtin_amdgcn_global_load_lds((const unsigned*)((const char*)(gbase) + (voff)[_i]), (PG8_LAS unsigned*)(lds + (bufoff) + ldsw + _i * 8192), 16, 0, 0); } while (0)
#define PG8_LDA(dst, b, h) do { _Pragma("unroll") for (int m = 0; m < 4; ++m) _Pragma("unroll") for (int k = 0; k < 2; ++k) dst[m][k] = *(const PG8_LAS bf16x8*)(lds + PG8_SA(b, h) + aoff + m * 2048 + k * 1024); } while (0)
#define PG8_LDB(dst, b, h) do { _Pragma("unroll") for (int n = 0; n < 2; ++n) _Pragma("unroll") for (int k = 0; k < 2; ++k) dst[n][k] = *(const PG8_LAS bf16x8*)(lds + PG8_SB(b, h) + boff + n * 2048 + k * 1024); } while (0)
#define PG8_MMA(ai, bj, At, Bt) do { __builtin_amdgcn_s_setprio(1); _Pragma("unroll") for (int m = 0; m < 4; ++m) _Pragma("unroll") for (int n = 0; n < 2; ++n) _Pragma("unroll") for (int k = 0; k < 2; ++k) \
        acc[ai][bj][m][n] = __builtin_amdgcn_mfma_f32_16x16x32_bf16(Bt[n][k], At[m][k], acc[ai][bj][m][n], 0, 0, 0); __builtin_amdgcn_s_setprio(0); } while (0)
#define PG8_WAIT_V(n) asm volatile("s_waitcnt vmcnt(" #n ")" ::: "memory")
#define PG8_WAIT_L(n) asm volatile("s_waitcnt lgkmcnt(" #n ")" ::: "memory")
#define PG8_BAR __builtin_amdgcn_s_barrier()
#define PG8_SCHED __builtin_amdgcn_sched_barrier(0)
    Unit cur, nxt; int ui = 0;
    if (!S.next(0, cur)) return;
    f32x4 acc[2][2][4][2];
#pragma unroll
    for (int a = 0; a < 2; ++a)
#pragma unroll
        for (int b = 0; b < 2; ++b)
#pragma unroll
            for (int m = 0; m < 4; ++m)
#pragma unroll
                for (int n = 0; n < 2; ++n) acc[a][b][m][n] = (f32x4){0.f, 0.f, 0.f, 0.f};
    bf16x8 At[4][2], B0[2][2], B1[2][2];
    const char* cA; const char* cB; S.ptrs(cur, cA, cB);
    if constexpr (SP2) {
        PG8_STAGE(PG8_SB(0, 0), cB, voffB); PG8_STAGE(PG8_SB(0, 1), cB + hstepB, voffB); PG8_STAGE(PG8_SA(0, 0), cA, voffA); PG8_STAGE(PG8_SA(0, 1), cA + hstepA, voffA);
        if (wr == 1) PG8_BAR;
        PG8_WAIT_V(2); PG8_BAR;
        PG8_STAGE(PG8_SB(1, 0), cB + kstep, voffB); PG8_STAGE(PG8_SA(1, 0), cA + kstep, voffA); PG8_STAGE(PG8_SB(1, 1), cB + hstepB + kstep, voffB);
        PG8_WAIT_V(6); PG8_BAR;
    } else {
        PG8_STAGE(PG8_SB(0, 0), cB, voffB); PG8_STAGE(PG8_SA(0, 0), cA, voffA); PG8_STAGE(PG8_SB(0, 1), cB + hstepB, voffB); PG8_STAGE(PG8_SA(0, 1), cA + hstepA, voffA);
        if (wr == 1) PG8_BAR;
        PG8_WAIT_V(4); PG8_BAR;
        PG8_STAGE(PG8_SB(1, 0), cB + kstep, voffB); PG8_STAGE(PG8_SA(1, 0), cA + kstep, voffA); PG8_STAGE(PG8_SB(1, 1), cB + hstepB + kstep, voffB);
        PG8_WAIT_V(6); PG8_BAR;
    }
    for (;;) {
        const bool has_next = S.next(ui + 1, nxt);
        const char* nA = cA; const char* nB = cB; if (has_next) S.ptrs(nxt, nA, nB);
        for (int t = 0; t < nt; t += 2) {
            const bool last = (t == nt - 2);
            const char* a1 = cA + (size_t)(t + 1) * kstep;
            const char* a2 = last ? nA : cA + (size_t)(t + 2) * kstep; const char* b2 = last ? nB : cB + (size_t)(t + 2) * kstep;
            const char* a3 = a2 + kstep; const char* b3 = b2 + kstep;
            if constexpr (SP2) {
            PG8_LDB(B0, 0, 0); PG8_LDB(B1, 0, 1); PG8_SCHED; PG8_LDA(At, 0, 0); PG8_STAGE(PG8_SA(1, 1), a1 + hstepA, voffA);
            PG8_WAIT_V(8); PG8_WAIT_L(0); PG8_BAR; PG8_MMA(0, 0, At, B0); PG8_MMA(0, 1, At, B1); PG8_BAR; PG8_SCHED;
            PG8_LDA(At, 0, 1); PG8_STAGE(PG8_SB(0, 0), b2, voffB); PG8_STAGE(PG8_SB(0, 1), b2 + hstepB, voffB); PG8_STAGE(PG8_SA(0, 0), a2, voffA);
            PG8_WAIT_V(8); PG8_WAIT_L(0); PG8_BAR; PG8_MMA(1, 0, At, B0); PG8_MMA(1, 1, At, B1); PG8_BAR; PG8_SCHED;
            PG8_LDB(B0, 1, 0); PG8_LDB(B1, 1, 1); PG8_SCHED; PG8_LDA(At, 1, 0); PG8_STAGE(PG8_SA(0, 1), a2 + hstepA, voffA);
            PG8_WAIT_V(8); PG8_WAIT_L(0); PG8_BAR; PG8_MMA(0, 0, At, B0); PG8_MMA(0, 1, At, B1); PG8_BAR; PG8_SCHED;
            PG8_LDA(At, 1, 1); PG8_STAGE(PG8_SB(1, 0), b3, voffB); PG8_STAGE(PG8_SB(1, 1), b3 + hstepB, voffB); PG8_STAGE(PG8_SA(1, 0), a3, voffA);
            PG8_WAIT_V(8); PG8_WAIT_L(0); PG8_BAR; PG8_MMA(1, 0, At, B0); PG8_MMA(1, 1, At, B1); PG8_BAR; PG8_SCHED;
            } else {
            PG8_LDB(B0, 0, 0); PG8_SCHED; PG8_LDA(At, 0, 0); PG8_STAGE(PG8_SA(1, 1), a1 + hstepA, voffA);
            PG8_WAIT_L(8); PG8_BAR; PG8_WAIT_L(0); PG8_MMA(0, 0, At, B0); PG8_BAR; PG8_SCHED;
            PG8_LDB(B1, 0, 1); PG8_STAGE(PG8_SB(0, 0), b2, voffB);
            PG8_BAR; PG8_WAIT_L(0); PG8_MMA(0, 1, At, B1); PG8_BAR;
            PG8_LDA(At, 0, 1); PG8_STAGE(PG8_SA(0, 0), a2, voffA);
            PG8_BAR; PG8_WAIT_L(0); PG8_MMA(1, 0, At, B0); PG8_BAR; PG8_SCHED;
            PG8_STAGE(PG8_SB(0, 1), b2 + hstepB, voffB);
            PG8_WAIT_V(6); PG8_BAR; PG8_MMA(1, 1, At, B1); PG8_BAR;
            PG8_LDB(B0, 1, 0); PG8_SCHED; PG8_LDA(At, 1, 0); PG8_STAGE(PG8_SA(0, 1), a2 + hstepA, voffA);
            PG8_WAIT_L(8); PG8_BAR; PG8_WAIT_L(0); PG8_MMA(0, 0, At, B0); PG8_BAR; PG8_SCHED;
            PG8_LDB(B1, 1, 1); PG8_STAGE(PG8_SB(1, 0), b3, voffB);
            PG8_BAR; PG8_WAIT_L(0); PG8_MMA(0, 1, At, B1); PG8_BAR;
            PG8_LDA(At, 1, 1); PG8_STAGE(PG8_SA(1, 0), a3, voffA);
            PG8_BAR; PG8_WAIT_L(0); PG8_MMA(1, 0, At, B0); PG8_BAR; PG8_SCHED;
            PG8_STAGE(PG8_SB(1, 1), b3 + hstepB, voffB);
            PG8_WAIT_V(6); PG8_BAR; PG8_MMA(1, 1, At, B1); PG8_BAR;
            }
        }
        if constexpr (ALIGN_EPI) { if (wr == 0) PG8_BAR; }
        {
            int t2 = threadIdx.x; asm volatile("" : "+v"(t2)); const int l2 = t2 & 63;
            E(acc, cur, wr, wc, l2 & 15, l2 >> 4);
            if constexpr (DUP_EPI && Epi::IDEMP) E(acc, cur, wr, wc, l2 & 15, l2 >> 4);
        }
        if (!has_next) break;
#pragma unroll
        for (int a = 0; a < 2; ++a)
#pragma unroll
            for (int b = 0; b < 2; ++b)
#pragma unroll
                for (int m = 0; m < 4; ++m)
#pragma unroll
                    for (int n = 0; n < 2; ++n) acc[a][b][m][n] = (f32x4){0.f, 0.f, 0.f, 0.f};
        cur = nxt; cA = nA; cB = nB; ++ui;
        if constexpr (ALIGN_EPI) { if (wr == 1) PG8_BAR; }
    }
    PG8_WAIT_V(0);
    if constexpr (!ALIGN_EPI) { if (wr == 0) PG8_BAR; }
    PG8_BAR;
#undef PG8_SA
#undef PG8_SB
#undef PG8_STAGE
#undef PG8_LDA
#undef PG8_LDB
#undef PG8_MMA
#undef PG8_WAIT_V
#undef PG8_WAIT_L
#undef PG8_BAR
#undef PG8_SCHED
}
}

constexpr int NWAVES = 8;
constexpr int BATCH = 2, SEQ = 8192, DM = 4096, M = BATCH * SEQ, NIN = 35840, DFF = 11008, NUP = 2 * DFF, DEPTH = 2;
constexpr float EPS = 1e-5f, LOG2E = 1.4426950408889634f;
constexpr float ALPHA = 1.4142135623730951f;
constexpr int C_DAQ = 0, C_DAK = 1024, C_DAV = 2048, C_RTQ = 3072, C_RTK = 3584, C_RTV = 4096, C_RTG = 5120, C_HGQ = 6144, C_HGF = 7168, C_HGI = 8192, C_HGG = 9216,
              C_DLQ = 10240, C_DLK = 13312, C_DLV = 16384, C_GATE = 19456;
constexpr int VT_DAV = 0, VT_RTV = 1024, VT_HGI = 2048, VT_DLV = 3072, VT_ROWS = 6144;
constexpr int NAT_TILES = 116, SWP_TILES = 16;
constexpr float QS_DA = 0.125f * LOG2E;
constexpr float QS_DL = 0.08838834764831845f * LOG2E;

constexpr size_t MiB = 1u << 20;
constexpr size_t WS_CTL = 0, CTL_ZERO_BYTES = 1 * MiB;
constexpr size_t WS_WIN = 16 * MiB, WIN_L = (size_t)NIN * DM * 2;
constexpr size_t WS_WBR = 576 * MiB, WBR_L = (size_t)4 * DM * 1024 * 2;
constexpr size_t WS_WO = 640 * MiB, WO_L = (size_t)DM * DM * 2;
constexpr size_t WS_WUP = 704 * MiB, WUP_L = (size_t)NUP * DM * 2;
constexpr size_t WS_WDN = 1048 * MiB, WDN_L = (size_t)DM * DFF * 2;
constexpr size_t WS_AB = 1220 * MiB, WS_XP4 = 1348 * MiB, WS_XP16 = 1476 * MiB;
constexpr size_t WS_NAT = 1604 * MiB;
constexpr size_t WS_UUP = WS_NAT, WS_ACT = WS_NAT + 688 * MiB;
constexpr size_t WS_VT = 2724 * MiB;
constexpr size_t WS_HQT = 2932 * MiB, WS_HKT = 2964 * MiB, WS_HQC = 2996 * MiB, WS_HKH = 3028 * MiB, WS_DEC = 3060 * MiB;
constexpr size_t WS_UR = 3062 * MiB, WS_UH = 3094 * MiB, WS_SR = 3222 * MiB, WS_SH = 3238 * MiB;
constexpr size_t WS_Y = 3302 * MiB;
constexpr size_t WS_MRG = 3430 * MiB, WS_MRGB = 3686 * MiB, WS_H1 = 3814 * MiB, WS_H2 = 4070 * MiB, WS_DAK = 4326 * MiB, WS_DLK = 4358 * MiB, WS_END = 4454 * MiB;
static_assert(WS_WIN + 2 * WIN_L <= WS_WBR && WS_WUP + 2 * WUP_L <= WS_WDN && WS_WDN + 2 * WDN_L <= WS_AB, "ws map");
static_assert(WS_NAT + (size_t)M * NIN * 2 <= WS_VT && WS_ACT + (size_t)M * DFF * 2 <= WS_VT && WS_UUP + (size_t)M * NUP * 2 <= WS_ACT, "ws map");
static_assert(WS_VT + (size_t)VT_ROWS * M * 2 <= WS_HQT, "ws map");
static_assert(WS_XP16 - WS_XP4 == WS_XP4 - WS_AB, "the permuted activation copies are equally spaced");
constexpr int CW_TMO = 0, CW_CODE = 1, CW_BAR = 4096, CW_WQ = 16384, CW_NRM = 20480;

constexpr int LDS_BYTES = 147456, LDSCTL_OFF = LDS_BYTES - 512, MISC_OFF = LDSCTL_OFF + 320;

#define GAS __attribute__((address_space(1)))
#define LAS __attribute__((address_space(3)))
typedef unsigned short bf16;
typedef unsigned v4u __attribute__((ext_vector_type(4)));
typedef unsigned v2u __attribute__((ext_vector_type(2)));
typedef float f32x4 __attribute__((ext_vector_type(4)));
typedef float f32x16 __attribute__((ext_vector_type(16)));
typedef short bf16x8 __attribute__((ext_vector_type(8)));
typedef short bf16x4 __attribute__((ext_vector_type(4)));
typedef GAS unsigned gu32;
#define RLX_AGENT __ATOMIC_RELAXED, __HIP_MEMORY_SCOPE_AGENT
#define LDS_WAIT() asm volatile("s_waitcnt lgkmcnt(0)" ::: "memory")
#define VM_WAIT() asm volatile("s_waitcnt vmcnt(0)" ::: "memory")
__device__ __forceinline__ unsigned f2bf(float f) { unsigned u = __builtin_bit_cast(unsigned, f); return (u + 0x7fffu + ((u >> 16) & 1u)) >> 16; }
__device__ __forceinline__ unsigned pk2(float lo, float hi) { return f2bf(lo) | (f2bf(hi) << 16); }
__device__ __forceinline__ float bflo(unsigned u) { return __uint_as_float(u << 16); }
__device__ __forceinline__ float bfhi(unsigned u) { return __uint_as_float(u & 0xffff0000u); }
__device__ __forceinline__ float bf1(bf16 b) { return __uint_as_float((unsigned)b << 16); }
__device__ __forceinline__ float fsigmoid(float x) { return __builtin_amdgcn_rcpf(1.f + __builtin_amdgcn_exp2f(-x * LOG2E)); }

#define XB_TMO      128
#define XB_XCNT(j)  (256  + 64 * (j))
#define XB_XSUB(j)  (1280 + 64 * (j))
#define XB_XGEN(j)  (2304 + 64 * (j))
#define XB_TOP      3328
#define XB_TOPGEN   3392
#define XCD_BAR_WORDS 3456
#define XB_SPIN_CAP (1u << 18)
__device__ __forceinline__ unsigned xb_ld(unsigned* p)              { return __hip_atomic_load(p, __ATOMIC_RELAXED, __HIP_MEMORY_SCOPE_AGENT); }
__device__ __forceinline__ unsigned xb_add(unsigned* p, unsigned v) { return __hip_atomic_fetch_add(p, v, __ATOMIC_RELAXED, __HIP_MEMORY_SCOPE_AGENT); }
__device__ __forceinline__ unsigned xb_xcc_id() { return (unsigned)__builtin_amdgcn_s_getreg((3 << 11) | 20) & 0xFu; }
#define XB_SPIN(cond, bar) do { unsigned _sp = 0; while (cond) { __builtin_amdgcn_s_sleep(1); \
    if ((++_sp & 255u) == 0u) { if (xb_ld(&(bar)[XB_TMO])) break; if (_sp > XB_SPIN_CAP) { atomicAdd(&(bar)[XB_TMO], 1u); break; } } } } while (0)
struct XcdBarrier { unsigned* bar; unsigned x; volatile LAS unsigned* st; };
__device__ __forceinline__ XcdBarrier xcd_barrier_post(unsigned* bar, volatile LAS unsigned* st) {
    XcdBarrier b; b.bar = bar; b.x = xb_xcc_id(); b.st = st;
    if (threadIdx.x == 0) (void)xb_add(&bar[XB_XCNT(b.x)], 1u);
    return b;
}
__device__ __forceinline__ void xcd_barrier_complete(unsigned* bar, unsigned x, unsigned& nloc, unsigned& nx) {
    const unsigned G = gridDim.x * gridDim.y * gridDim.z;
    unsigned sum, cnt, mine, sp = 0u;
    for (;;) {
        sum = 0u; cnt = 0u; mine = 0u;
#pragma unroll
        for (unsigned j = 0; j < 16; ++j) { const unsigned c = xb_ld(&bar[XB_XCNT(j)]); sum += c; cnt += (c > 0u) ? 1u : 0u; mine = (j == x) ? c : mine; }
        if (sum == G) break;
        __builtin_amdgcn_s_sleep(1);
        if ((++sp & 255u) == 0u) { if (xb_ld(&bar[XB_TMO])) break; if (sp > XB_SPIN_CAP) { atomicAdd(&bar[XB_TMO], 1u); break; } }
    }
    nloc = mine > 0u ? mine : 1u; nx = cnt > 0u ? cnt : 1u;
}
__device__ __forceinline__ void xcd_barrier(const XcdBarrier& b) {
    asm volatile("s_waitcnt vmcnt(0)" ::: "memory");
    __syncthreads();
    if (threadIdx.x == 0) {
        unsigned* bar = b.bar;
        __builtin_amdgcn_s_waitcnt(0);
        unsigned nloc = b.st[0], nx = b.st[1];
        if (nloc == 0u) { xcd_barrier_complete(bar, b.x, nloc, nx); b.st[0] = nloc; b.st[1] = nx; }
        const unsigned old = xb_add(&bar[XB_XSUB(b.x)], 1u);
        const unsigned gen = old / nloc;
        if (old + 1u == (gen + 1u) * nloc) {
            __builtin_amdgcn_fence(__ATOMIC_RELEASE, "agent");
            asm volatile("s_waitcnt vmcnt(0)" ::: "memory");
            const unsigned og = xb_add(&bar[XB_TOP], 1u);
            const unsigned tg = og / nx;
            if (og + 1u == (tg + 1u) * nx) xb_add(&bar[XB_TOPGEN], 1u);
            else XB_SPIN(xb_ld(&bar[XB_TOPGEN]) == tg, bar);
            __builtin_amdgcn_fence(__ATOMIC_ACQUIRE, "agent");
            xb_add(&bar[XB_XGEN(b.x)], 1u);
            asm volatile("s_waitcnt vmcnt(0)" ::: "memory");
        } else {
            XB_SPIN(xb_ld(&bar[XB_XGEN(b.x)]) == gen, bar);
            __builtin_amdgcn_fence(__ATOMIC_ACQUIRE, "agent");
            asm volatile("s_waitcnt vmcnt(0)" ::: "memory");
        }
    }
    __syncthreads();
}

struct Frame {
    LAS unsigned char* lds;
    gu32* ctl;
    unsigned char* ws;
    int tid, lane, wave, vcu, G;
};

__device__ __forceinline__ float lane_xor(float v, int o, int lane) { return __int_as_float(__builtin_amdgcn_ds_bpermute((lane ^ o) << 2, __float_as_int(v))); }
__device__ __forceinline__ float wave_sum(float v, int lane) {
#pragma unroll
    for (int o = 1; o < 64; o <<= 1) v += lane_xor(v, o, lane);
    return v;
}
__device__ __forceinline__ float half_sum(float v) { const auto rr = __builtin_amdgcn_permlane32_swap(__float_as_uint(v), __float_as_uint(v), false, false); return __uint_as_float(rr[0]) + __uint_as_float(rr[1]); }
__device__ __forceinline__ float half_max(float v) { const auto rr = __builtin_amdgcn_permlane32_swap(__float_as_uint(v), __float_as_uint(v), false, false); return fmaxf(__uint_as_float(rr[0]), __uint_as_float(rr[1])); }

__device__ __forceinline__ f32x16 mfma32(bf16x8 a, bf16x8 b, f32x16 c) { return __builtin_amdgcn_mfma_f32_32x32x16_bf16(a, b, c, 0, 0, 0); }
__device__ __forceinline__ bf16x8 ld8(const bf16* p) { return *(const bf16x8*)p; }
__device__ __forceinline__ bf16x8 ld44(const bf16* p) { const bf16x4 a = *(const bf16x4*)p, b = *(const bf16x4*)(p + 8); return __builtin_shufflevector(a, b, 0, 1, 2, 3, 4, 5, 6, 7); }
template <int S> __device__ __forceinline__ bf16x8 pack8(const f32x16& p) {
    v4u w; w.x = pg8::cvt_pk_bf16(p[8 * S + 0], p[8 * S + 1]); w.y = pg8::cvt_pk_bf16(p[8 * S + 2], p[8 * S + 3]); w.z = pg8::cvt_pk_bf16(p[8 * S + 4], p[8 * S + 5]); w.w = pg8::cvt_pk_bf16(p[8 * S + 6], p[8 * S + 7]);
    return __builtin_bit_cast(bf16x8, w);
}
__device__ __forceinline__ f32x16 zero16() { f32x16 z; _Pragma("unroll") for (int i = 0; i < 16; ++i) z[i] = 0.f; return z; }
#define ROWOFF(i) (((i) & 3) + 8 * ((i) >> 2))

template <bool UPIL = false>
__device__ __forceinline__ void p0_transpose_item(const float* W, int K, int N, bf16* WT, LAS float* scr, int item, int lane) {
    const int nblk = N / 32, kb = item / nblk, nb = item % nblk, k0 = 64 * kb, n0 = 32 * nb;
    const int cu = n0 < DFF ? n0 : n0 - DFF, d0 = UPIL ? (256 * (cu >> 7) + (n0 < DFF ? 0 : 128) + (cu & 127)) : n0;
    const int lr = lane >> 3, lc = 4 * (lane & 7);
    const GAS f32x4* src = (const GAS f32x4*)(W + (size_t)(k0 + lr) * N + n0 + lc);
    f32x4 v[8];
#pragma unroll
    for (int j = 0; j < 8; ++j) v[j] = __builtin_nontemporal_load(src + (size_t)j * 2 * N);
#pragma unroll
    for (int j = 0; j < 8; ++j) { LAS float* d = scr + (8 * j + lr) * 33 + lc; d[0] = v[j].x; d[1] = v[j].y; d[2] = v[j].z; d[3] = v[j].w; }
    LDS_WAIT(); asm volatile("" ::: "memory");
    const int c = lane & 7;
#pragma unroll
    for (int j = 0; j < 4; ++j) { const int n = (lane >> 3) + 8 * j; const LAS float* s = scr + (8 * c) * 33 + n;
        v4u o; o.x = pg8::cvt_pk_bf16(s[0 * 33], s[1 * 33]); o.y = pg8::cvt_pk_bf16(s[2 * 33], s[3 * 33]); o.z = pg8::cvt_pk_bf16(s[4 * 33], s[5 * 33]); o.w = pg8::cvt_pk_bf16(s[6 * 33], s[7 * 33]);
        *(GAS v4u*)(WT + (size_t)(d0 + n) * K + k0 + 8 * c) = o; }
    LDS_WAIT(); asm volatile("" ::: "memory");
}
struct P0Desc { const float* W; bf16* WT; int K, N, item, upil; };
__device__ __forceinline__ void p0_item_load(const P0Desc& D, int lane, f32x4 (&v)[8]) {
    const int nblk = D.N / 32, kb = D.item / nblk, nb = D.item % nblk, k0 = 64 * kb, n0 = 32 * nb;
    const int lr = lane >> 3, lc = 4 * (lane & 7);
    const GAS f32x4* src = (const GAS f32x4*)(D.W + (size_t)(k0 + lr) * D.N + n0 + lc);
#pragma unroll
    for (int j = 0; j < 8; ++j) v[j] = __builtin_nontemporal_load(src + (size_t)j * 2 * D.N);
}
__device__ __forceinline__ void p0_item_finish(const P0Desc& D, LAS float* scr, int lane, const f32x4 (&v)[8]) {
    const int nblk = D.N / 32, kb = D.item / nblk, nb = D.item % nblk, k0 = 64 * kb, n0 = 32 * nb;
    const int cu = n0 < DFF ? n0 : n0 - DFF, d0 = D.upil ? (256 * (cu >> 7) + (n0 < DFF ? 0 : 128) + (cu & 127)) : n0;
    const int lr = lane >> 3, lc = 4 * (lane & 7);
#pragma unroll
    for (int j = 0; j < 8; ++j) { LAS float* d = scr + (8 * j + lr) * 33 + lc; d[0] = v[j].x; d[1] = v[j].y; d[2] = v[j].z; d[3] = v[j].w; }
    LDS_WAIT(); asm volatile("" ::: "memory");
    const int c = lane & 7;
#pragma unroll
    for (int j = 0; j < 4; ++j) { const int n = (lane >> 3) + 8 * j; const LAS float* s = scr + (8 * c) * 33 + n;
        v4u o; o.x = pg8::cvt_pk_bf16(s[0 * 33], s[1 * 33]); o.y = pg8::cvt_pk_bf16(s[2 * 33], s[3 * 33]); o.z = pg8::cvt_pk_bf16(s[4 * 33], s[5 * 33]); o.w = pg8::cvt_pk_bf16(s[6 * 33], s[7 * 33]);
        *(GAS v4u*)(D.WT + (size_t)(d0 + n) * D.K + k0 + 8 * c) = o; }
    LDS_WAIT(); asm volatile("" ::: "memory");
}
__device__ __forceinline__ int perm_row(int m, int sh) { const int b = m / SEQ, t = m % SEQ; return b * SEQ + (t & ((1 << sh) - 1)) * (SEQ >> sh) + (t >> sh); }

struct Args { const float* in[16]; float* out; unsigned char* ws; int ph_lo, ph_hi; };
template <int K_> __device__ __forceinline__ const float* karg() {
    const float* p; asm volatile("s_load_dwordx2 %0, %1, %2\n\ts_waitcnt lgkmcnt(0)" : "=s"(p) : "s"(__builtin_amdgcn_kernarg_segment_ptr()), "i"(K_ * 8) : "memory"); return p; }
#define INP(k) (karg<(k)>())

#ifndef NCONV
#define NCONV 32
#endif
#ifndef CONV_S1
#define CONV_S1 24
#endif
template <int PART>
__device__ __forceinline__ void p0_convert(Frame& F, int widx, int nw) {
    LAS float* scr = (LAS float*)(F.lds + F.wave * 16384);
    constexpr int I_IN = (DM / 64) * (NIN / 32), I_BR = (1024 / 64) * (DM / 32), I_O = (DM / 64) * (DM / 32), I_UP = (DM / 64) * (NUP / 32), I_DN = (DFF / 64) * (DM / 32);
    constexpr int I_L = I_IN + 4 * I_BR + I_O + I_UP + I_DN;
    if constexpr (PART == 1) {
        auto decode = [&](int it) -> P0Desc { const int l = it / I_L; int r = it % I_L; P0Desc D; D.upil = 0;
            if (r < I_IN) { D.W = INP(1) + (size_t)l * DM * NIN; D.K = DM; D.N = NIN; D.WT = (bf16*)(F.ws + WS_WIN + l * WIN_L); D.item = r; return D; } r -= I_IN;
            if (r < 4 * I_BR) { const int b = r / I_BR; D.W = INP(6) + ((size_t)l * 4 + b) * 1024 * DM; D.K = 1024; D.N = DM; D.WT = (bf16*)(F.ws + WS_WBR + l * WBR_L) + (size_t)b * DM * 1024; D.item = r % I_BR; return D; } r -= 4 * I_BR;
            if (r < I_O) { D.W = INP(7) + (size_t)l * DM * DM; D.K = DM; D.N = DM; D.WT = (bf16*)(F.ws + WS_WO + l * WO_L); D.item = r; return D; } r -= I_O;
            if (r < I_UP) { D.W = INP(10) + (size_t)l * DM * NUP; D.K = DM; D.N = NUP; D.WT = (bf16*)(F.ws + WS_WUP + l * WUP_L); D.item = r; D.upil = 1; return D; } r -= I_UP;
            D.W = INP(13) + (size_t)l * DFF * DM; D.K = DFF; D.N = DM; D.WT = (bf16*)(F.ws + WS_WDN + l * WDN_L); D.item = r; return D; };
        constexpr int END = DEPTH * I_L;
        int it = I_IN + widx;
        if (it < END) {
            f32x4 v0[8], v1[8]; P0Desc D0 = decode(it), D1 = D0;
            p0_item_load(D0, F.lane, v0);
            for (;;) {
                const int it1 = it + nw; const bool h1 = it1 < END;
                if (h1) { D1 = decode(it1); p0_item_load(D1, F.lane, v1); }
                p0_item_finish(D0, scr, F.lane, v0);
                if (!h1) break;
                it = it1 + nw; const bool h0 = it < END;
                if (h0) { D0 = decode(it); p0_item_load(D0, F.lane, v0); }
                p0_item_finish(D1, scr, F.lane, v1);
                if (!h0) break;
            }
        }
    } else
    for (int it = widx; it < I_IN; it += nw) {
        const int l = it / I_L; int r = it % I_L;
        if (r < I_IN) { p0_transpose_item(INP(1) + (size_t)l * DM * NIN, DM, NIN, (bf16*)(F.ws + WS_WIN + l * WIN_L), scr, r, F.lane); continue; } r -= I_IN;
        if (r < 4 * I_BR) { const int b = r / I_BR; p0_transpose_item(INP(6) + ((size_t)l * 4 + b) * 1024 * DM, 1024, DM, (bf16*)(F.ws + WS_WBR + l * WBR_L) + (size_t)b * DM * 1024, scr, r % I_BR, F.lane); continue; } r -= 4 * I_BR;
        if (r < I_O) { p0_transpose_item(INP(7) + (size_t)l * DM * DM, DM, DM, (bf16*)(F.ws + WS_WO + l * WO_L), scr, r, F.lane); continue; } r -= I_O;
        if (r < I_UP) { p0_transpose_item<true>(INP(10) + (size_t)l * DM * NUP, DM, NUP, (bf16*)(F.ws + WS_WUP + l * WUP_L), scr, r, F.lane); continue; } r -= I_UP;
        p0_transpose_item(INP(13) + (size_t)l * DFF * DM, DFF, DM, (bf16*)(F.ws + WS_WDN + l * WDN_L), scr, r, F.lane);
    }
    if constexpr (PART == 0) {
        const float* x = INP(0);
        for (int m = widx; m < M; m += nw) {
            const GAS f32x4* xr = (const GAS f32x4*)(x + (size_t)m * DM) + F.lane;
            GAS v2u* o0 = (GAS v2u*)((bf16*)(F.ws + WS_AB) + (size_t)m * DM) + F.lane;
#pragma unroll 4
            for (int j = 0; j < 16; ++j) { const f32x4 v = __builtin_nontemporal_load(xr + 64 * j); v2u w; w.x = pk2(v.x, v.y); w.y = pk2(v.z, v.w); o0[64 * j] = w; }
        }
    }
}

using pg8::Unit;
template <int mode> struct InProjSched {
    int G, c; const bf16* X; const bf16* Wt; int s1;
    __device__ __forceinline__ bool next(int i, Unit& u) const {
        int L = i * G + c;
        if constexpr (mode == 0) {
            if (s1 > 0) { const int Gg = G - NCONV, ii = i + (c >= Gg ? s1 : 0); L = ii < s1 ? ii * Gg + c : s1 * Gg + (ii - s1) * G + c; }
            if (L < 64 * NAT_TILES) {
                int pm, pn; pg8::tile_map(L, 64, NAT_TILES, pm, pn);
                u.pm = pm; u.pn = pn < 8 ? pn : pn < 12 ? pn + 4 : pn < 24 ? pn + 8 : pn < 52 ? pn + 12 : pn + 24; u.kind = 0; return true;
            }
            const int L2 = L - 64 * NAT_TILES;
            if (L2 >= SWP_TILES * 64) return false;
            int ft, tt; pg8::tile_map(L2, SWP_TILES, 64, ft, tt);
            u.pm = ft; u.pn = tt; u.kind = 1; return true;
        } else {
            if (L >= 4 * 64) return false;
            int ft, tt; pg8::tile_map(L, 4, 64, ft, tt);
            u.pm = 12 + 4 * mode + ft; u.pn = tt; u.kind = 1; return true;
        }
    }
    __device__ __forceinline__ void ptrs(const Unit& u, const char*& A, const char*& B) const {
        if (u.kind == 0) { A = (const char*)(X + (size_t)u.pm * 256 * DM); B = (const char*)(Wt + (size_t)u.pn * 256 * DM); }
        else { const int ft = u.pm, ct = ft < 4 ? 8 + ft : ft < 8 ? 12 + ft : ft < 12 ? 24 + ft : 52 + ft;
            A = (const char*)(Wt + (size_t)ct * 256 * DM);
            const int sh = 2 * mode, b = u.pn >> 5, p = (u.pn & 31) * 256, res = p >> (13 - sh), w0 = p & ((SEQ >> sh) - 1);
            B = (const char*)(X + ((size_t)b * SEQ + ((size_t)w0 << sh) + res) * DM); }
    }
};
struct EpiInProj {
    static constexpr bool APERM = false, PERM = true, IDEMP = true;
    bf16* NAT; bf16* VT; bf16* DAK; bf16* DLK;
    __device__ __forceinline__ void operator()(const pg8::f32x4 (&acc)[2][2][4][2], const Unit& u, int wr, int wc, int fr, int fq) const {
        bf16* base; size_t rs_m, rs_ai, cs_bj; float sc = 1.f;
        const int b = u.kind == 0 ? (u.pm >> 5) : (u.pn >> 5), t0 = ((u.kind == 0 ? u.pm : u.pn) & 31) * 256;
        if (u.kind == 0) { const int ct = u.pn;
            sc = ct < 4 ? QS_DA : (ct == 12 || ct == 13) ? 0.125f : (ct >= 40 && ct < 52) ? QS_DL : 1.f;
            if (ct >= 4 && ct < 8) {
                base = DAK + ((size_t)(b * 8 + 2 * (ct - 4)) * SEQ + t0 + wr * 64 + fr) * 128 + wc * 32 + 8 * fq; rs_m = 16 * 128; rs_ai = 128 * 128; cs_bj = (size_t)SEQ * 128;
            } else if (ct >= 52 && ct < 64) {
                const int g = (ct - 52) >> 2, hq = (ct - 52) & 3, sh = 2 * g, R = 1 << sh;
                const int prow = (fr & (R - 1)) * (SEQ >> sh) + (t0 >> sh) + wr * (64 >> sh) + (fr >> sh);
                base = DLK + ((size_t)((g * 2 + b) * 8 + 2 * hq) * SEQ + prow) * 128 + wc * 32 + 8 * fq; rs_m = (size_t)(16 >> sh) * 128; rs_ai = (size_t)(128 >> sh) * 128; cs_bj = (size_t)SEQ * 128;
            } else { base = NAT + ((size_t)u.pm * 256 + wr * 64 + fr) * NIN + ct * 256 + wc * 32 + 8 * fq; rs_m = (size_t)16 * NIN; rs_ai = (size_t)128 * NIN; cs_bj = 128; }
        } else { const int ft = u.pm;
            if (ft < 4) {
                base = VT + (size_t)VT_DAV * M + ((size_t)((b * 8 + 2 * ft) * 128 + (t0 >> 6) + (wc >> 1)) * 128 + wr * 64 + fr) * 64 + (wc & 1) * 32 + 8 * fq;
                rs_m = 16 * 64; rs_ai = (size_t)128 * 128 * 64; cs_bj = (size_t)2 * 128 * 64;
            } else if (ft >= 12) {
                const int g = (ft - 12) >> 2, hq = (ft - 12) & 3;
                base = VT + (size_t)VT_DLV * M + ((size_t)(((g * 2 + b) * 8 + 2 * hq) * 256 + (t0 >> 5) + wc) * 128 + wr * 64 + fr) * 32 + 8 * fq;
                rs_m = 16 * 32; rs_ai = (size_t)256 * 128 * 32; cs_bj = (size_t)4 * 128 * 32;
            } else { base = VT + ((size_t)ft * 256 + wr * 64 + fr) * M + u.pn * 256 + wc * 32 + 8 * fq; rs_m = (size_t)16 * M; rs_ai = (size_t)128 * M; cs_bj = 128; }
        }
#pragma unroll
        for (int ai = 0; ai < 2; ++ai)
#pragma unroll
            for (int m = 0; m < 4; ++m) { bf16* rowp = base + ai * rs_ai + m * rs_m;
#pragma unroll
                for (int bj = 0; bj < 2; ++bj) { const pg8::f32x4 v0 = acc[ai][bj][m][0] * sc, v1 = acc[ai][bj][m][1] * sc;
                    pg8::u32x4 w; w.x = pg8::cvt_pk_bf16(v0[0], v0[1]); w.y = pg8::cvt_pk_bf16(v0[2], v0[3]); w.z = pg8::cvt_pk_bf16(v1[0], v1[1]); w.w = pg8::cvt_pk_bf16(v1[2], v1[3]);
                    *(pg8::u32x4*)(rowp + bj * cs_bj) = w; } }
    }
};
struct MergeSched {
    int G, c; const bf16* Y; const bf16* Wb;
    __device__ __forceinline__ bool next(int i, Unit& u) const {
        const int L = (i >> 2) * G + c; if (L >= 64 * 16) return false;
        int pm, pn; pg8::tile_map(L, 64, 16, pm, pn); u.pm = pm; u.pn = pn; u.kind = i & 3; return true;
    }
    __device__ __forceinline__ void ptrs(const Unit& u, const char*& A, const char*& B) const {
        A = (const char*)(Y + (size_t)u.kind * M * 1024 + (size_t)u.pm * 256 * 1024); B = (const char*)(Wb + (size_t)u.kind * DM * 1024 + (size_t)u.pn * 256 * 1024);
    }
};
struct EpiMerge {
    static constexpr bool APERM = false, PERM = true, IDEMP = false;
    const bf16* NAT; bf16* MRGB;
    __device__ __forceinline__ void operator()(const pg8::f32x4 (&acc)[2][2][4][2], const Unit& u, int wr, int wc, int fr, int fq) const {
        const int row0 = u.pm * 256 + wr * 64 + fr, col0 = u.pn * 256 + wc * 32 + 8 * fq, b = u.kind;
#pragma unroll
        for (int ai = 0; ai < 2; ++ai) {
            const bf16* gp = NAT + (size_t)(row0 + ai * 128) * NIN + C_GATE + b * DM + col0; bf16* bp = MRGB + (size_t)(row0 + ai * 128) * DM + col0;
            v4u G[4][2], O[4][2];
#pragma unroll
            for (int m = 0; m < 4; ++m)
#pragma unroll
                for (int bj = 0; bj < 2; ++bj) G[m][bj] = __builtin_nontemporal_load((const v4u*)(gp + (size_t)m * 16 * NIN + bj * 128));
            if (b > 0) {
#pragma unroll
                for (int m = 0; m < 4; ++m)
#pragma unroll
                    for (int bj = 0; bj < 2; ++bj) O[m][bj] = *(const v4u*)(bp + (size_t)m * 16 * DM + bj * 128);
            } else {
#pragma unroll
                for (int m = 0; m < 4; ++m)
#pragma unroll
                    for (int bj = 0; bj < 2; ++bj) O[m][bj] = (v4u){0u, 0u, 0u, 0u};
            }
            __builtin_amdgcn_sched_barrier(0);
#pragma unroll
            for (int m = 0; m < 4; ++m)
#pragma unroll
                for (int bj = 0; bj < 2; ++bj) { const v4u g = G[m][bj], o = O[m][bj];
                    pg8::f32x4 v0 = acc[ai][bj][m][0], v1 = acc[ai][bj][m][1];
                    v0[0] = v0[0] * fsigmoid(bflo(g.x)) + bflo(o.x); v0[1] = v0[1] * fsigmoid(bfhi(g.x)) + bfhi(o.x); v0[2] = v0[2] * fsigmoid(bflo(g.y)) + bflo(o.y); v0[3] = v0[3] * fsigmoid(bfhi(g.y)) + bfhi(o.y);
                    v1[0] = v1[0] * fsigmoid(bflo(g.z)) + bflo(o.z); v1[1] = v1[1] * fsigmoid(bfhi(g.z)) + bfhi(o.z); v1[2] = v1[2] * fsigmoid(bflo(g.w)) + bflo(o.w); v1[3] = v1[3] * fsigmoid(bfhi(g.w)) + bfhi(o.w);
                    v4u w; w.x = pg8::cvt_pk_bf16(v0[0], v0[1]); w.y = pg8::cvt_pk_bf16(v0[2], v0[3]); w.z = pg8::cvt_pk_bf16(v1[0], v1[1]); w.w = pg8::cvt_pk_bf16(v1[2], v1[3]);
                    *(v4u*)(bp + (size_t)m * 16 * DM + bj * 128) = w; }
        }
    }
};
struct PlainSched {
    int G, c, nN, K; const bf16* A; const bf16* Bt;
    __device__ __forceinline__ bool next(int i, Unit& u) const {
        const int L = i * G + c; if (L >= 64 * nN) return false;
        int pm, pn; pg8::tile_map(L, 64, nN, pm, pn); u.pm = pm; u.pn = pn; u.kind = 0; return true;
    }
    __device__ __forceinline__ void ptrs(const Unit& u, const char*& Ap, const char*& Bp) const {
        Ap = (const char*)(A + (size_t)u.pm * 256 * K); Bp = (const char*)(Bt + (size_t)u.pn * 256 * K);
    }
};
struct EpiF32 {
    static constexpr bool APERM = false, PERM = false, IDEMP = true;
    float* C; int ldc;
    __device__ __forceinline__ void operator()(const pg8::f32x4 (&acc)[2][2][4][2], const Unit& u, int wr, int wc, int fr, int fq) const {
        const int row0 = u.pm * 256 + wr * 64 + fr, col0 = u.pn * 256 + wc * 32 + 4 * fq;
#pragma unroll
        for (int ai = 0; ai < 2; ++ai)
#pragma unroll
            for (int m = 0; m < 4; ++m) { float* rowp = C + (size_t)(row0 + ai * 128 + m * 16) * ldc + col0;
#pragma unroll
                for (int bj = 0; bj < 2; ++bj)
#pragma unroll
                    for (int n = 0; n < 2; ++n) *(pg8::f32x4*)(rowp + bj * 128 + n * 16) = acc[ai][bj][m][n]; }
    }
};
struct EpiBf16 {
    static constexpr bool APERM = false, PERM = true, IDEMP = true;
    bf16* O; int ldc;
    __device__ __forceinline__ void operator()(const pg8::f32x4 (&acc)[2][2][4][2], const Unit& u, int wr, int wc, int fr, int fq) const {
        const int row0 = u.pm * 256 + wr * 64 + fr, col0 = u.pn * 256 + wc * 32 + 8 * fq;
#pragma unroll
        for (int ai = 0; ai < 2; ++ai)
#pragma unroll
            for (int m = 0; m < 4; ++m) { bf16* rowp = O + (size_t)(row0 + ai * 128 + m * 16) * ldc + col0;
#pragma unroll
                for (int bj = 0; bj < 2; ++bj) { const pg8::f32x4 v0 = acc[ai][bj][m][0], v1 = acc[ai][bj][m][1];
                    pg8::u32x4 w; w.x = pg8::cvt_pk_bf16(v0[0], v0[1]); w.y = pg8::cvt_pk_bf16(v0[2], v0[3]); w.z = pg8::cvt_pk_bf16(v1[0], v1[1]); w.w = pg8::cvt_pk_bf16(v1[2], v1[3]);
                    *(pg8::u32x4*)(rowp + bj * 128) = w; } }
    }
};

__device__ __forceinline__ float gelu1(float v) {
    const float av = fabsf(v), t = __builtin_amdgcn_rcpf(av * 0.2316418882f + 1.0f);
    float q = t * 0.5307027145f + (-0.7265760135f); q = q * t + 0.7107068705f; q = q * t + (-0.142248368f); q = q * t + 0.127414796f; q = q * t;
    const float e = __builtin_amdgcn_exp2f((v * v) * (-0.72134752044f));
    const float mm = v * (q * e);
    return v < 0.f ? mm : v - mm;
}
__device__ __forceinline__ float dpp_shr1(float v) { return __int_as_float(__builtin_amdgcn_update_dpp(0, __float_as_int(v), 0x111, 0xf, 0xf, true)); }
struct EpiAct {
    static constexpr bool APERM = true, PERM = true, IDEMP = true;
    bf16* ACT; const float* cw; const float* cb; float* EA; float* EG; float* EL;
    __device__ __forceinline__ void operator()(const pg8::f32x4 (&acc)[2][2][4][2], const Unit& u, int wr, int wc, int fr, int fq) const {
        const int c0 = u.pn * 128 + wc * 32 + 8 * fq, seg = u.pm * 2 + wr;
        bf16* op = ACT + ((size_t)u.pm * 256 + 128 * wr + 8 * fr) * DFF + c0;
        pg8::f32x4 w0[2], w1[2], w2[2], bc[2], p2[2], p1[2];
#pragma unroll
        for (int n = 0; n < 2; ++n) { w0[n] = *(const GAS pg8::f32x4*)(cw + c0 + 4 * n); w1[n] = *(const GAS pg8::f32x4*)(cw + DFF + c0 + 4 * n); w2[n] = *(const GAS pg8::f32x4*)(cw + 2 * DFF + c0 + 4 * n); bc[n] = *(const GAS pg8::f32x4*)(cb + c0 + 4 * n);
#pragma unroll
            for (int e = 0; e < 4; ++e) { p2[n][e] = dpp_shr1(acc[1][0][2][n][e]); p1[n][e] = dpp_shr1(acc[1][0][3][n][e]); } }
#pragma unroll
        for (int j = 0; j < 8; ++j) {
            pg8::f32x4 o[2];
#pragma unroll
            for (int n = 0; n < 2; ++n) { const pg8::f32x4 a0 = acc[j >> 2][0][j & 3][n], gl = acc[j >> 2][1][j & 3][n];
                const pg8::f32x4 cv = bc[n] + w0[n] * p2[n] + w1[n] * p1[n] + w2[n] * a0;
#pragma unroll
                for (int e = 0; e < 4; ++e) o[n][e] = gelu1(cv[e]) * gl[e];
                p2[n] = p1[n]; p1[n] = a0;
                if (j < 2 && fr == 0) { *(pg8::f32x4*)(EA + (size_t)(seg * 2 + j) * DFF + c0 + 4 * n) = a0; *(pg8::f32x4*)(EG + (size_t)(seg * 2 + j) * DFF + c0 + 4 * n) = gl; }
                if (j >= 6 && fr == 15) *(pg8::f32x4*)(EL + (size_t)(seg * 2 + j - 6) * DFF + c0 + 4 * n) = a0; }
            pg8::u32x4 w; w.x = pg8::cvt_pk_bf16(o[0][0], o[0][1]); w.y = pg8::cvt_pk_bf16(o[0][2], o[0][3]); w.z = pg8::cvt_pk_bf16(o[1][0], o[1][1]); w.w = pg8::cvt_pk_bf16(o[1][2], o[1][3]);
            *(pg8::u32x4*)(op + (size_t)j * DFF) = w;
        }
    }
};

__device__ __forceinline__ int wq_pull(gu32* cnt, int lane) {
    unsigned v = 0; if (lane == 0) v = __hip_atomic_fetch_add(cnt, 1u, RLX_AGENT);
    return (int)__builtin_amdgcn_readfirstlane(v);
}

constexpr int OT_ROW = 272;
__device__ __forceinline__ void ot_put(LAS unsigned char* wl, int r, int hh, int d0, v2u w) { *(LAS v2u*)(wl + r * OT_ROW + (d0 + 4 * hh) * 2) = w; }
__device__ __forceinline__ void ot_emit(const LAS unsigned char* wl, bf16* yb  , int rstride  , int lane) {
#pragma unroll
    for (int k = 0; k < 8; ++k) { const int row = (lane >> 4) + 4 * k; const v4u v = *(const LAS v4u*)(wl + row * OT_ROW + (lane & 15) * 16);
        *(v4u*)(yb + (size_t)row * rstride * 1024 + (lane & 15) * 8) = v; }
}

__device__ __forceinline__ void diff_unit(const bf16* NAT, const bf16* VT, bf16* YA, const float* normg, float lam, float oscale, int b, int h, int qt, int lane) {
    const int r = lane & 31, hh = lane >> 5;
    const float slope2 = __builtin_amdgcn_exp2f(-(float)h - 0.25f) * LOG2E;
    const size_t tok0 = (size_t)b * SEQ;
    const int q = qt * 32 + r;
    const bf16* qp = NAT + (tok0 + q) * NIN + C_DAQ + h * 128 + 8 * hh;
    f32x16 O1[4], O2[4];
#pragma unroll
    for (int d = 0; d < 4; ++d) { O1[d] = zero16(); O2[d] = zero16(); }
    float m1 = -INFINITY, m2 = -INFINITY, l1 = 0.f, l2 = 0.f;
    for (int kt = qt; kt >= 0; --kt) {
        const int k0 = kt * 32;
        const bf16* kp = NAT + (tok0 + k0 + r) * NIN + C_DAK + h * 128 + 8 * hh;
        const bf16* vp = VT + (size_t)(VT_DAV + h * 128 + r) * M + tok0 + k0 + 4 * hh;
        const float base = slope2 * (float)(k0 + 4 * hh - q);
        const bool diag = (kt == qt);
        bf16x8 pf1[2], pf2[2];
        const bf16* qq = qp; asm volatile("" : "+v"(qq));
        {
            f32x16 s1 = zero16();
#pragma unroll
            for (int s = 0; s < 4; ++s) s1 = mfma32(ld8(kp + 16 * s), ld8(qq + 16 * s), s1);
            float mx = -INFINITY;
#pragma unroll
            for (int i = 0; i < 16; ++i) { float v = s1[i] + (base + slope2 * (float)ROWOFF(i)); if (diag && (k0 + 4 * hh + ROWOFF(i) > q)) v = -INFINITY; s1[i] = v; mx = fmaxf(mx, v); }
            mx = half_max(mx);
            const float mn = fmaxf(m1, mx), al = __builtin_amdgcn_exp2f(m1 - mn); m1 = mn;
            float ps = 0.f;
#pragma unroll
            for (int i = 0; i < 16; ++i) { const float p = __builtin_amdgcn_exp2f(s1[i] - mn); s1[i] = p; ps += p; }
            l1 = l1 * al + half_sum(ps);
            if (!__all(al == 1.f)) {
#pragma unroll
                for (int d = 0; d < 4; ++d) O1[d] *= al; }
            pf1[0] = pack8<0>(s1); pf1[1] = pack8<1>(s1);
        }
        {
            f32x16 s2 = zero16();
#pragma unroll
            for (int s = 0; s < 4; ++s) s2 = mfma32(ld8(kp + 64 + 16 * s), ld8(qq + 64 + 16 * s), s2);
            float mx = -INFINITY;
#pragma unroll
            for (int i = 0; i < 16; ++i) { float v = s2[i] + (base + slope2 * (float)ROWOFF(i)); if (diag && (k0 + 4 * hh + ROWOFF(i) > q)) v = -INFINITY; s2[i] = v; mx = fmaxf(mx, v); }
            mx = half_max(mx);
            const float mn = fmaxf(m2, mx), al = __builtin_amdgcn_exp2f(m2 - mn); m2 = mn;
            float ps = 0.f;
#pragma unroll
            for (int i = 0; i < 16; ++i) { const float p = __builtin_amdgcn_exp2f(s2[i] - mn); s2[i] = p; ps += p; }
            l2 = l2 * al + half_sum(ps);
            if (!__all(al == 1.f)) {
#pragma unroll
                for (int d = 0; d < 4; ++d) O2[d] *= al; }
            pf2[0] = pack8<0>(s2); pf2[1] = pack8<1>(s2);
        }
#pragma unroll
        for (int d = 0; d < 4; ++d)
#pragma unroll
            for (int s = 0; s < 2; ++s) { const bf16x8 vf = ld44(vp + (size_t)d * 32 * M + 16 * s); O1[d] = mfma32(vf, pf1[s], O1[d]); O2[d] = mfma32(vf, pf2[s], O2[d]); }
    }
    const float i1 = 1.f / l1, i2 = lam / l2;
    float ss = 0.f;
#pragma unroll
    for (int d = 0; d < 4; ++d)
#pragma unroll
        for (int i = 0; i < 16; ++i) { const float o = O1[d][i] * i1 - O2[d][i] * i2; O1[d][i] = o; ss += o * o; }
    ss = half_sum(ss);
    const float rs = __builtin_amdgcn_rsqf(ss * (1.f / 128.f) + EPS) * oscale;
    bf16* yp = YA + (tok0 + q) * 1024 + h * 128 + 4 * hh;
#pragma unroll
    for (int d = 0; d < 4; ++d)
#pragma unroll
        for (int g = 0; g < 4; ++g) { const int d0 = 32 * d + 8 * g; const f32x4 gv = *(const f32x4*)(normg + d0 + 4 * hh);
            v2u w; w.x = pg8::cvt_pk_bf16(O1[d][4 * g] * rs * gv.x, O1[d][4 * g + 1] * rs * gv.y); w.y = pg8::cvt_pk_bf16(O1[d][4 * g + 2] * rs * gv.z, O1[d][4 * g + 3] * rs * gv.w);
            *(v2u*)(yp + d0) = w; }
}

constexpr int DA_KROW = 272, DA_VROW = 136;
constexpr int DA_KBUF = 64 * DA_KROW, DA_VBUF = 128 * DA_VROW, DA_STAGE = DA_KBUF + DA_VBUF, DA_QOFF = 2 * DA_STAGE, DA_END = DA_QOFF + 256 * DA_KROW;
static_assert(DA_END <= LDSCTL_OFF, "diff-attention LDS map");
typedef LAS unsigned char* ldsp;
__device__ __forceinline__ bf16x8 lds8(const LAS unsigned char* p) { return *(const LAS bf16x8*)p; }
__device__ __forceinline__ bf16x8 lds44(const LAS unsigned char* p) { const bf16x4 a = *(const LAS bf16x4*)p, b = *(const LAS bf16x4*)(p + 16); return __builtin_shufflevector(a, b, 0, 1, 2, 3, 4, 5, 6, 7); }
__device__ __forceinline__ void da_softmax(f32x16& s, float slope2, float base, bool diag, int dq, float& m, float& l, f32x16 (&O)[4], bf16x8& p0, bf16x8& p1) {
    float mx = -INFINITY;
#pragma unroll
    for (int i = 0; i < 16; ++i) { float v = __builtin_fmaf(slope2, (float)ROWOFF(i), s[i]); if (diag && (ROWOFF(i) > dq)) v = -INFINITY; s[i] = v; mx = fmaxf(mx, v); }
    mx = half_max(mx + base);
    const float mn = fmaxf(m, mx), al = __builtin_amdgcn_exp2f(m - mn), sm = mn - base; m = mn;
    float ps = 0.f;
#pragma unroll
    for (int i = 0; i < 16; ++i) { const float p = __builtin_amdgcn_exp2f(s[i] - sm); s[i] = p; ps += p; }
    l = l * al + half_sum(ps);
    if (!__all(al == 1.f)) {
#pragma unroll
        for (int d = 0; d < 4; ++d) O[d] *= al; }
    p0 = pack8<0>(s); p1 = pack8<1>(s);
}
__device__ __forceinline__ void diff_block(LAS unsigned char* lds, volatile LAS unsigned* flags, const unsigned* nrm, const bf16* NAT, const bf16* DAK, const bf16* VT, bf16* YA, const float* normg, float lam, float oscale, int b, int h, int qb, int tid) {
    const int lane = tid & 63, w = __builtin_amdgcn_readfirstlane(tid >> 6), r = lane & 31, hh = lane >> 5;
    const float slope2 = __builtin_amdgcn_exp2f(-(float)h - 0.25f) * LOG2E;
    const float sub = sqrtf(fmaxf(__uint_as_float(nrm[4 * h + 0]) * __uint_as_float(nrm[4 * h + 2]), __uint_as_float(nrm[4 * h + 1]) * __uint_as_float(nrm[4 * h + 3]))) * 1.01f;
    const size_t tok0 = (size_t)b * SEQ;
    const int q0 = 256 * qb, q = q0 + 32 * w + r, qt_w = 8 * qb + w;
    const bf16* kg = DAK + (size_t)(b * 8 + h) * SEQ * 128 + 8 * tid;
    const bf16* vg = VT + (size_t)VT_DAV * M + (size_t)(b * 8 + h) * SEQ * 128 + 8 * tid;
    const int kw = (tid >> 4) * DA_KROW + (tid & 15) * 16, vw = DA_KBUF + (tid >> 3) * DA_VROW + (tid & 7) * 16;
    {
        const bf16* qg = NAT + (tok0 + q0 + (tid >> 4)) * NIN + C_DAQ + h * 128 + 8 * (tid & 15);
#pragma unroll
        for (int i = 0; i < 8; ++i) *(LAS v4u*)(lds + DA_QOFF + kw + i * 32 * DA_KROW) = *(const v4u*)(qg + (size_t)i * 32 * NIN);
    }
    int kt = 4 * qb + 3;
    v4u g0, g1, g2, g3;
#define DA_LOAD(KT) do { const size_t k0_ = (size_t)(KT) * 8192; g0 = *(const v4u*)(kg + k0_); g1 = *(const v4u*)(kg + k0_ + 4096); g2 = *(const v4u*)(vg + k0_); g3 = *(const v4u*)(vg + k0_ + 4096); } while (0)
#define DA_STORE(BUF) do { LAS unsigned char* s_ = lds + (BUF) * DA_STAGE; *(LAS v4u*)(s_ + kw) = g0; *(LAS v4u*)(s_ + kw + 32 * DA_KROW) = g1; \
        *(LAS v2u*)(s_ + vw) = (v2u){g2.x, g2.y}; *(LAS v2u*)(s_ + vw + 8) = (v2u){g2.z, g2.w}; *(LAS v2u*)(s_ + vw + 64 * DA_VROW) = (v2u){g3.x, g3.y}; *(LAS v2u*)(s_ + vw + 64 * DA_VROW + 8) = (v2u){g3.z, g3.w}; } while (0)
    DA_LOAD(kt); DA_STORE(0);
    __syncthreads();
    f32x16 O1[4], O2[4];
#pragma unroll
    for (int d = 0; d < 4; ++d) { O1[d] = zero16(); O2[d] = zero16(); }
    float m1 = -INFINITY, m2 = -INFINITY, l1 = 0.f, l2 = 0.f;
    const LAS unsigned char* qa = lds + DA_QOFF + (32 * w + r) * DA_KROW + 16 * hh;
    int cur = 0;
    for (; kt >= 0; --kt) {
        if (kt > 0) DA_LOAD(kt - 1);
        const LAS unsigned char* Kb = lds + cur * DA_STAGE; const LAS unsigned char* Vb = Kb + DA_KBUF;
#pragma unroll
        for (int sub = 1; sub >= 0; --sub) {
            const int st = 2 * kt + sub;
            if (st <= qt_w) {
                const bool diag = (st == qt_w);
                const float base = slope2 * (float)(32 * st + 4 * hh - q);
                const int dq = q - 32 * st - 4 * hh;
                const LAS unsigned char* ka = Kb + (32 * sub + r) * DA_KROW + 16 * hh;
                bf16x8 pf1[2], pf2[2];
                { f32x16 s1 = zero16();
#pragma unroll
                  for (int s = 0; s < 4; ++s) s1 = mfma32(lds8(ka + 32 * s), lds8(qa + 32 * s), s1);
                  da_softmax(s1, slope2, base, diag, dq, m1, l1, O1, pf1[0], pf1[1]); }
                { f32x16 s2 = zero16();
#pragma unroll
                  for (int s = 0; s < 4; ++s) s2 = mfma32(lds8(ka + 128 + 32 * s), lds8(qa + 128 + 32 * s), s2);
                  da_softmax(s2, slope2, base, diag, dq, m2, l2, O2, pf2[0], pf2[1]); }
                const LAS unsigned char* va = Vb + r * DA_VROW + (32 * sub + 4 * hh) * 2;
#pragma unroll
                for (int d = 0; d < 4; ++d)
#pragma unroll
                    for (int s = 0; s < 2; ++s) { const bf16x8 vf = lds44(va + d * 32 * DA_VROW + 32 * s); O1[d] = mfma32(vf, pf1[s], O1[d]); O2[d] = mfma32(vf, pf2[s], O2[d]); }
            }
        }
        const bool can = (sub - slope2 * (float)(q - 64 * kt + 1)) < fminf(m1, m2) - 32.f;
        const bool wcan = __all(can);
        if (lane == 0) flags[(kt & 1) * 8 + w] = wcan ? 1u : 0u;
        if (kt > 0) DA_STORE(cur ^ 1);
        __syncthreads();
        cur ^= 1;
        {   const LAS v4u* fp = (const LAS v4u*)(const_cast<LAS unsigned*>(flags) + (kt & 1) * 8); const v4u fa = fp[0], fb = fp[1];
            if ((fa.x & fa.y & fa.z & fa.w & fb.x & fb.y & fb.z & fb.w) != 0u) break; }
    }
#undef DA_LOAD
#undef DA_STORE
    const float i1 = 1.f / l1, i2 = lam / l2;
    float ss = 0.f;
#pragma unroll
    for (int d = 0; d < 4; ++d)
#pragma unroll
        for (int i = 0; i < 16; ++i) { const float o = O1[d][i] * i1 - O2[d][i] * i2; O1[d][i] = o; ss += o * o; }
    ss = half_sum(ss);
    const float rs = __builtin_amdgcn_rsqf(ss * (1.f / 128.f) + EPS) * oscale;
    LAS unsigned char* ot = lds + w * (32 * OT_ROW);
#pragma unroll
    for (int d = 0; d < 4; ++d)
#pragma unroll
        for (int g = 0; g < 4; ++g) { const int d0 = 32 * d + 8 * g; const f32x4 gv = *(const f32x4*)(normg + d0 + 4 * hh);
            v2u w2; w2.x = pg8::cvt_pk_bf16(O1[d][4 * g] * rs * gv.x, O1[d][4 * g + 1] * rs * gv.y); w2.y = pg8::cvt_pk_bf16(O1[d][4 * g + 2] * rs * gv.z, O1[d][4 * g + 3] * rs * gv.w);
            ot_put(ot, r, hh, d0, w2); }
    ot_emit(ot, YA + (tok0 + q0 + 32 * w) * 1024 + h * 128, 1, lane);
}

constexpr int DL_KROW = 272, DL_VROW = 72, DL_KBUF = 32 * DL_KROW, DL_WAVE = DL_KBUF + 128 * DL_VROW;
static_assert(8 * DL_WAVE <= LDSCTL_OFF, "dilated-attention LDS map");
template <int G_> __device__ __forceinline__ void dil_group(LAS unsigned char* wl, const bf16* NAT, const bf16* DLK, const bf16* VT, size_t tok0, int h, int rho, int ut, int lane, f32x16 (&O)[4], float& m, float& l) {
    constexpr int SH = G_ == 0 ? 0 : G_ == 1 ? 2 : 4, RATE = 1 << SH;
    const int r = lane & 31, hh = lane >> 5;
    const int tq = rho + 16 * (32 * ut + r);
    const int res = rho & (RATE - 1);
    const int wq = (tq - res) >> SH;
    const int wq0 = ((rho - res) >> SH) + (16 >> SH) * (32 * ut), wq31 = wq0 + (16 >> SH) * 31;
    const int kt_hi = wq31 >> 5; int kt_lo = (wq0 - 128) >> 5; kt_lo = kt_lo < 0 ? 0 : kt_lo;
    const float slope2 = __builtin_amdgcn_exp2f(-(float)(4 * h + 2 + G_) * 0.25f) * LOG2E * (float)RATE;
    const bf16* qp = NAT + (tok0 + tq) * NIN + C_DLQ + G_ * 1024 + h * 128 + 8 * hh;
    bf16x8 qf[8];
#pragma unroll
    for (int s = 0; s < 8; ++s) qf[s] = ld8(qp + 16 * s);
    const int bb = (int)(tok0 / SEQ);
    const bf16* kg = DLK + ((size_t)((G_ * 2 + bb) * 8 + h) * SEQ + (size_t)res * (SEQ >> SH)) * 128 + 8 * lane;
    const bf16* vg = VT + (size_t)VT_DLV * M + ((size_t)((G_ * 2 + bb) * 8 + h) * SEQ + (size_t)res * (SEQ >> SH)) * 128 + 8 * lane;
    LAS unsigned char* kw = wl + (lane >> 4) * DL_KROW + (lane & 15) * 16;
    LAS unsigned char* vw = wl + DL_KBUF + (lane >> 2) * DL_VROW + (lane & 3) * 16;
    v4u gk[8], gv[8];
#define DL_LOAD(KT) do { _Pragma("unroll") for (int i_ = 0; i_ < 8; ++i_) { gk[i_] = *(const v4u*)(kg + (size_t)(KT) * 4096 + 512 * i_); gv[i_] = *(const v4u*)(vg + (size_t)(KT) * 4096 + 512 * i_); } } while (0)
#define DL_STORE() do { _Pragma("unroll") for (int i_ = 0; i_ < 8; ++i_) { *(LAS v4u*)(kw + 4 * i_ * DL_KROW) = gk[i_]; \
        *(LAS v2u*)(vw + 16 * i_ * DL_VROW) = (v2u){gv[i_].x, gv[i_].y}; *(LAS v2u*)(vw + 16 * i_ * DL_VROW + 8) = (v2u){gv[i_].z, gv[i_].w}; } } while (0)
    DL_LOAD(kt_hi); DL_STORE();
    const LAS unsigned char* ka = wl + r * DL_KROW + 16 * hh;
    const LAS unsigned char* va = wl + DL_KBUF + r * DL_VROW + 8 * hh;
    for (int kt = kt_hi; kt >= kt_lo; --kt) {
        const int w0 = kt * 32;
        if (kt > kt_lo) DL_LOAD(kt - 1);
        f32x16 s = zero16();
#pragma unroll
        for (int ks = 0; ks < 8; ++ks) s = mfma32(lds8(ka + 32 * ks), qf[ks], s);
        float mx = -INFINITY;
        const int dq = wq - w0 - 4 * hh;
#pragma unroll
        for (int i = 0; i < 16; ++i) { const int d = dq - ROWOFF(i); const float v = (d >= 0 && d <= 128) ? s[i] - slope2 * (float)d : -INFINITY; s[i] = v; mx = fmaxf(mx, v); }
        mx = half_max(mx);
        const float mn = fmaxf(m, mx), mu = (mn == -INFINITY) ? 0.f : mn, al = __builtin_amdgcn_exp2f(m - mu); m = mn;
        float ps = 0.f;
#pragma unroll
        for (int i = 0; i < 16; ++i) { const float p = __builtin_amdgcn_exp2f(s[i] - mu); s[i] = p; ps += p; }
        l = l * al + half_sum(ps);
        if (!__all(al == 1.f)) {
#pragma unroll
            for (int d = 0; d < 4; ++d) O[d] *= al; }
        const bf16x8 pf0 = pack8<0>(s), pf1 = pack8<1>(s);
#pragma unroll
        for (int d = 0; d < 4; ++d) { O[d] = mfma32(lds44(va + d * 32 * DL_VROW), pf0, O[d]); O[d] = mfma32(lds44(va + d * 32 * DL_VROW + 32), pf1, O[d]); }
        if (kt > kt_lo) DL_STORE();
    }
#undef DL_LOAD
#undef DL_STORE
}
__device__ __forceinline__ void dil_unit(LAS unsigned char* wl, const bf16* NAT, const bf16* DLK, const bf16* VT, bf16* YD, int b, int h, int rho, int ut, int lane) {
    const int r = lane & 31, hh = lane >> 5;
    const size_t tok0 = (size_t)b * SEQ;
    f32x16 O[4];
#pragma unroll
    for (int d = 0; d < 4; ++d) O[d] = zero16();
    float m = -INFINITY, l = 0.f;
    dil_group<2>(wl, NAT, DLK, VT, tok0, h, rho, ut, lane, O, m, l);
    dil_group<1>(wl, NAT, DLK, VT, tok0, h, rho, ut, lane, O, m, l);
    dil_group<0>(wl, NAT, DLK, VT, tok0, h, rho, ut, lane, O, m, l);
    const float il = 1.f / l;
    const int tq = rho + 16 * (32 * ut + r);
    bf16* yp = YD + (tok0 + tq) * 1024 + h * 128 + 4 * hh;
#pragma unroll
    for (int d = 0; d < 4; ++d)
#pragma unroll
        for (int g = 0; g < 4; ++g) { v2u w; w.x = pg8::cvt_pk_bf16(O[d][4 * g] * il, O[d][4 * g + 1] * il); w.y = pg8::cvt_pk_bf16(O[d][4 * g + 2] * il, O[d][4 * g + 3] * il);
            *(v2u*)(yp + 32 * d + 8 * g) = w; }
}

__device__ __forceinline__ float ret_log2g(int h) { return __builtin_amdgcn_logf(1.f - __builtin_amdgcn_exp2f(-(float)(5 + h))); }
constexpr int RU_ROW = 132, RU_WAVE = 128 * RU_ROW;
__device__ __forceinline__ void retu_unit(LAS unsigned char* wl, const bf16* NAT, const bf16* VT, float* UR, int bh, int n, int lane) {
    const int r = lane & 31, hh = lane >> 5, b = bh >> 3, h = bh & 7;
    const size_t tokc = (size_t)b * SEQ + 128 * n;
    {   const bf16* kg = NAT + (tokc + (lane >> 3)) * NIN + C_RTK + h * 64 + 8 * (lane & 7);
        LAS unsigned* kw = (LAS unsigned*)(wl + (lane >> 3) * RU_ROW + (lane & 7) * 16);
#pragma unroll 1
        for (int i0 = 0; i0 < 16; i0 += 8) { v4u kv[8];
#pragma unroll
            for (int i = 0; i < 8; ++i) kv[i] = *(const v4u*)(kg + (size_t)8 * (i0 + i) * NIN);
#pragma unroll
            for (int i = 0; i < 8; ++i) { LAS unsigned* d = kw + 8 * (i0 + i) * (RU_ROW / 4); d[0] = kv[i].x; d[1] = kv[i].y; d[2] = kv[i].z; d[3] = kv[i].w; } } }
    bf16x8 kf[2][8];
    const float l2g = ret_log2g(h);
    float ge[8];
#pragma unroll
    for (int e = 0; e < 8; ++e) ge[e] = __builtin_amdgcn_exp2f(-(float)e * l2g);
#pragma unroll
    for (int s = 0; s < 8; ++s) { const float fs = __builtin_amdgcn_exp2f((float)(127 - 16 * s - 8 * hh) * l2g);
#pragma unroll
        for (int dt = 0; dt < 2; ++dt) { const LAS unsigned short* p = (const LAS unsigned short*)(wl + (16 * s + 8 * hh) * RU_ROW + (32 * dt + r) * 2);
            v4u w;
            w.x = pg8::cvt_pk_bf16(bf1(p[0 * (RU_ROW / 2)]) * (fs * ge[0]), bf1(p[1 * (RU_ROW / 2)]) * (fs * ge[1])); w.y = pg8::cvt_pk_bf16(bf1(p[2 * (RU_ROW / 2)]) * (fs * ge[2]), bf1(p[3 * (RU_ROW / 2)]) * (fs * ge[3]));
            w.z = pg8::cvt_pk_bf16(bf1(p[4 * (RU_ROW / 2)]) * (fs * ge[4]), bf1(p[5 * (RU_ROW / 2)]) * (fs * ge[5])); w.w = pg8::cvt_pk_bf16(bf1(p[6 * (RU_ROW / 2)]) * (fs * ge[6]), bf1(p[7 * (RU_ROW / 2)]) * (fs * ge[7]));
            kf[dt][s] = __builtin_bit_cast(bf16x8, w); __builtin_amdgcn_sched_barrier(0); } }
#pragma unroll 1
    for (int et = 0; et < 4; ++et) {
        const bf16* ap = VT + (size_t)(VT_RTV + h * 128 + 32 * et + r) * M + tokc + 8 * hh;
        f32x16 a0 = zero16(), a1 = zero16();
#pragma unroll
        for (int s = 0; s < 8; ++s) { const bf16x8 af = ld8(ap + 16 * s); a0 = mfma32(af, kf[0][s], a0); a1 = mfma32(af, kf[1][s], a1); }
        float* up = UR + ((size_t)(bh * 64 + n) * 128 + 32 * et + 4 * hh) * 64 + r;
#pragma unroll
        for (int i = 0; i < 16; ++i) { up[ROWOFF(i) * 64] = a0[i]; up[ROWOFF(i) * 64 + 32] = a1[i]; }
    }
}
__device__ __forceinline__ void ret_out_unit(LAS unsigned char* wl, const bf16* NAT, const bf16* VT, const bf16* SR, bf16* YR, int bh, int n, int it, int lane) {
    const int r = lane & 31, hh = lane >> 5, b = bh >> 3, h = bh & 7;
    const size_t tok0 = (size_t)b * SEQ + 128 * n;
    const int il = 32 * it + r;
    const float l2g = ret_log2g(h);
    const bf16* qp = NAT + (tok0 + il) * NIN + C_RTQ + h * 64 + 8 * hh;
    bf16x8 qf[4];
#pragma unroll
    for (int s = 0; s < 4; ++s) qf[s] = ld8(qp + 16 * s);
    f32x16 O[4];
    const bf16* sp = SR + ((size_t)(bh * 64 + n) * 128 + r) * 64 + 8 * hh;
    const float qd = __builtin_amdgcn_exp2f((float)(il + 1) * l2g);
#pragma unroll
    for (int e = 0; e < 4; ++e) { f32x16 a = zero16();
#pragma unroll
        for (int s = 0; s < 4; ++s) a = mfma32(ld8(sp + e * 32 * 64 + 16 * s), qf[s], a);
        O[e] = a * qd; }
    for (int jt = 0; jt <= it; ++jt) {
        const bf16* kp = NAT + (tok0 + 32 * jt + r) * NIN + C_RTK + h * 64 + 8 * hh;
        f32x16 s = zero16();
#pragma unroll
        for (int ks = 0; ks < 4; ++ks) s = mfma32(ld8(kp + 16 * ks), qf[ks], s);
        const int dq = il - 32 * jt - 4 * hh;
#pragma unroll
        for (int i = 0; i < 16; ++i) { const int d = dq - ROWOFF(i); s[i] = d >= 0 ? s[i] * __builtin_amdgcn_exp2f((float)d * l2g) : 0.f; }
        const bf16x8 pf0 = pack8<0>(s), pf1 = pack8<1>(s);
        const bf16* vp = VT + (size_t)(VT_RTV + h * 128 + r) * M + tok0 + 32 * jt + 4 * hh;
#pragma unroll
        for (int e = 0; e < 4; ++e) { O[e] = mfma32(ld44(vp + (size_t)e * 32 * M), pf0, O[e]); O[e] = mfma32(ld44(vp + (size_t)e * 32 * M + 16), pf1, O[e]); }
    }
    float sm = 0.f;
#pragma unroll
    for (int e = 0; e < 4; ++e)
#pragma unroll
        for (int i = 0; i < 16; ++i) sm += O[e][i];
    const float mean = half_sum(sm) * (1.f / 128.f);
    float sq = 0.f;
#pragma unroll
    for (int e = 0; e < 4; ++e)
#pragma unroll
        for (int i = 0; i < 16; ++i) { const float d = O[e][i] - mean; O[e][i] = d; sq += d * d; }
    const float rs = __builtin_amdgcn_rsqf(half_sum(sq) * (1.f / 128.f) + EPS);
    const bf16* gp = NAT + (tok0 + il) * NIN + C_RTG + h * 128 + 4 * hh;
#pragma unroll
    for (int e = 0; e < 4; ++e)
#pragma unroll
        for (int g = 0; g < 4; ++g) { const int d0 = 32 * e + 8 * g; const v2u gw = *(const v2u*)(gp + d0);
            const float g0 = bflo(gw.x), g1 = bfhi(gw.x), g2 = bflo(gw.y), g3 = bfhi(gw.y);
            v2u w; w.x = pg8::cvt_pk_bf16(O[e][4 * g] * rs * g0 * fsigmoid(g0), O[e][4 * g + 1] * rs * g1 * fsigmoid(g1));
            w.y = pg8::cvt_pk_bf16(O[e][4 * g + 2] * rs * g2 * fsigmoid(g2), O[e][4 * g + 3] * rs * g3 * fsigmoid(g3));
            ot_put(wl, r, hh, d0, w); }
    ot_emit(wl, YR + (tok0 + 32 * it) * 1024 + h * 128, 1, lane);
}

constexpr int HP_ROW = 136, HP_WAVE = 128 * HP_ROW;
static_assert(8 * HP_WAVE <= LDSCTL_OFF, "HGRN prep LDS map");
__device__ __forceinline__ float lb_of(const float* lbl, int layer, int c) {
    if (layer == 0) return 0.f;
    float mx = -INFINITY; for (int d = 0; d < DEPTH; ++d) mx = fmaxf(mx, lbl[d * 1024 + c]);
    float den = 0.f, num = 0.f;
    for (int d = 0; d < DEPTH; ++d) { const float e = __expf(lbl[d * 1024 + c] - mx); den += e; if (d >= 1 && d <= layer) num += e; }
    return num / den;
}
__device__ __forceinline__ void hgpu_unit(LAS unsigned char* wl, const bf16* NAT, const bf16* VT, const float* lbl, int layer, bf16* QT, bf16* KT, bf16* QC, float* DEC, float* UH, int bh, int n, int lane) {
    const int r = lane & 31, hh = lane >> 5, b = bh >> 3, h = bh & 7;
    const size_t t0 = (size_t)b * SEQ + 64 * n;
    const int c2 = h * 128 + 2 * lane;
    const float lb0 = lb_of(lbl, layer, c2), lb1 = lb_of(lbl, layer, c2 + 1), om0 = 1.f - lb0, om1 = 1.f - lb1;
    const unsigned* fp = (const unsigned*)(NAT + t0 * NIN + C_HGF + c2); const unsigned* qp = (const unsigned*)(NAT + t0 * NIN + C_HGQ + c2);
    float run0 = 0.f, run1 = 0.f, ref0 = 0.f, ref1 = 0.f;
#pragma unroll 1
    for (int jb = 0; jb < 4; ++jb) { unsigned fv[16];
#pragma unroll
        for (int k = 0; k < 16; ++k) fv[k] = fp[(size_t)(16 * jb + k) * (NIN / 2)];
#pragma unroll
        for (int k = 0; k < 16; ++k) { run0 += __logf(lb0 + om0 / (1.f + __expf(-bflo(fv[k])))); run1 += __logf(lb1 + om1 / (1.f + __expf(-bfhi(fv[k])))); }
        if (jb == 1) { ref0 = run0; ref1 = run1; } }
    const float bl0 = run0, bl1 = run1; run0 = 0.f; run1 = 0.f;
    unsigned* const QTu = (unsigned*)QT + (t0 * 1024 + c2) / 2; unsigned* const KTu = (unsigned*)KT + (t0 * 1024 + c2) / 2; unsigned* const QCu = (unsigned*)QC + (t0 * 1024 + c2) / 2;
    LAS unsigned char* kw = wl + (2 * lane) * HP_ROW;
#pragma unroll 1
    for (int jb = 0; jb < 4; ++jb) { unsigned fv[16], qv[16];
#pragma unroll
        for (int k = 0; k < 16; ++k) { fv[k] = fp[(size_t)(16 * jb + k) * (NIN / 2)]; qv[k] = qp[(size_t)(16 * jb + k) * (NIN / 2)]; }
        unsigned kp0 = 0u, kp1 = 0u;
#pragma unroll
        for (int k = 0; k < 16; ++k) { const int j = 16 * jb + k;
            const float lf0 = __logf(lb0 + om0 / (1.f + __expf(-bflo(fv[k])))), lf1 = __logf(lb1 + om1 / (1.f + __expf(-bfhi(fv[k]))));
            run0 += lf0; run1 += lf1;
            const float q0 = bflo(qv[k]), q1 = bfhi(qv[k]);
            const float qs0 = q0 / (1.f + __expf(-q0)), qs1 = q1 / (1.f + __expf(-q1)), kin0 = 1.f - __expf(lf0), kin1 = 1.f - __expf(lf1);
            QTu[(size_t)j * 512] = pk2(qs0 * __expf(run0 - ref0), qs1 * __expf(run1 - ref1));
            KTu[(size_t)j * 512] = pk2(kin0 * __expf(ref0 - run0), kin1 * __expf(ref1 - run1));
            QCu[(size_t)j * 512] = pk2(qs0 * __expf(run0), qs1 * __expf(run1));
            const unsigned k0b = f2bf(kin0 * __expf(bl0 - run0)), k1b = f2bf(kin1 * __expf(bl1 - run1));
            if (k & 1) { *(LAS unsigned*)(kw + 2 * (j - 1)) = kp0 | (k0b << 16); *(LAS unsigned*)(kw + HP_ROW + 2 * (j - 1)) = kp1 | (k1b << 16); } else { kp0 = k0b; kp1 = k1b; } } }
    { float2 dv; dv.x = __expf(bl0); dv.y = __expf(bl1); *(float2*)(DEC + (size_t)(b * 128 + n) * 1024 + c2) = dv; }
    const LAS unsigned char* kr = wl + r * HP_ROW + 16 * hh;
#pragma unroll 1
    for (int et = 0; et < 4; ++et) {
        const bf16* ap = VT + (size_t)(VT_HGI + h * 128 + 32 * et + r) * M + t0 + 8 * hh;
        bf16x8 af[4];
#pragma unroll
        for (int s2 = 0; s2 < 4; ++s2) af[s2] = ld8(ap + 16 * s2);
        float* up = UH + ((size_t)(bh * 128 + n) * 128 + 32 * et + 4 * hh) * 128 + r;
#pragma unroll
        for (int ct = 0; ct < 4; ++ct) { f32x16 a = zero16();
#pragma unroll
            for (int s2 = 0; s2 < 4; ++s2) { const LAS unsigned char* p = kr + ct * 32 * HP_ROW + 32 * s2;
                const bf16x4 lo = *(const LAS bf16x4*)p, hi = *(const LAS bf16x4*)(p + 8);
                a = mfma32(af[s2], __builtin_shufflevector(lo, hi, 0, 1, 2, 3, 4, 5, 6, 7), a); }
#pragma unroll
            for (int i = 0; i < 16; ++i) up[ROWOFF(i) * 128 + 32 * ct] = a[i]; }
    }
}
__device__ __forceinline__ void hg_out_unit(LAS unsigned char* wl, const bf16* NAT, const bf16* VT, const bf16* QT, const bf16* KT, const bf16* QC, const bf16* SH, const float* normg, bf16* YC, int bh, int n, int it, int lane) {
    const int r = lane & 31, hh = lane >> 5, b = bh >> 3, h = bh & 7;
    const size_t tok0 = (size_t)b * SEQ + 64 * n;
    const int il = 32 * it + r;
    f32x16 O[4];
#pragma unroll
    for (int e = 0; e < 4; ++e) O[e] = zero16();
    {
        const bf16* sp = SH + ((size_t)(bh * 128 + n) * 128 + r) * 128 + 8 * hh;
        const bf16* qc = QC + (tok0 + il) * 1024 + h * 128 + 8 * hh;
#pragma unroll
        for (int s = 0; s < 8; ++s) { const bf16x8 qf = ld8(qc + 16 * s);
#pragma unroll
            for (int e = 0; e < 4; ++e) O[e] = mfma32(ld8(sp + e * 32 * 128 + 16 * s), qf, O[e]); }
    }
    const bf16* qp = QT + (tok0 + il) * 1024 + h * 128 + 8 * hh;
    bf16x8 qf[8];
#pragma unroll
    for (int s = 0; s < 8; ++s) qf[s] = ld8(qp + 16 * s);
    for (int jt = 0; jt <= it; ++jt) {
        const bf16* kp = KT + (tok0 + 32 * jt + r) * 1024 + h * 128 + 8 * hh;
        f32x16 s = zero16();
#pragma unroll
        for (int ks = 0; ks < 8; ++ks) s = mfma32(ld8(kp + 16 * ks), qf[ks], s);
        const int dq = il - 32 * jt - 4 * hh;
#pragma unroll
        for (int i = 0; i < 16; ++i) s[i] = (dq - ROWOFF(i) >= 0) ? s[i] : 0.f;
        const bf16x8 pf0 = pack8<0>(s), pf1 = pack8<1>(s);
        const bf16* vp = VT + (size_t)(VT_HGI + h * 128 + r) * M + tok0 + 32 * jt + 4 * hh;
#pragma unroll
        for (int e = 0; e < 4; ++e) { O[e] = mfma32(ld44(vp + (size_t)e * 32 * M), pf0, O[e]); O[e] = mfma32(ld44(vp + (size_t)e * 32 * M + 16), pf1, O[e]); }
    }
    float sq = 0.f;
#pragma unroll
    for (int e = 0; e < 4; ++e)
#pragma unroll
        for (int i = 0; i < 16; ++i) sq += O[e][i] * O[e][i];
    const float rs = __builtin_amdgcn_rsqf(half_sum(sq) * (1.f / 128.f) + EPS);
    const bf16* gp = NAT + (tok0 + il) * NIN + C_HGG + h * 128 + 4 * hh;
#pragma unroll
    for (int e = 0; e < 4; ++e)
#pragma unroll
        for (int g = 0; g < 4; ++g) { const int d0 = 32 * e + 8 * g; const v2u gw = *(const v2u*)(gp + d0); const f32x4 ng = *(const f32x4*)(normg + d0 + 4 * hh);
            const float g0 = bflo(gw.x), g1 = bfhi(gw.x), g2 = bflo(gw.y), g3 = bfhi(gw.y);
            v2u w; w.x = pg8::cvt_pk_bf16(O[e][4 * g] * rs * ng.x * g0 * fsigmoid(g0), O[e][4 * g + 1] * rs * ng.y * g1 * fsigmoid(g1));
            w.y = pg8::cvt_pk_bf16(O[e][4 * g + 2] * rs * ng.z * g2 * fsigmoid(g2), O[e][4 * g + 3] * rs * ng.w * g3 * fsigmoid(g3));
            ot_put(wl, r, hh, d0, w); }
    ot_emit(wl, YC + (tok0 + 32 * it) * 1024 + h * 128, 1, lane);
}

__device__ __forceinline__ void ln_stage_gb(LAS unsigned char* lds, const float* g, const float* bb, int tid) {
    const GAS f32x4* gs = (const GAS f32x4*)g; const GAS f32x4* bs = (const GAS f32x4*)bb;
#pragma unroll
    for (int j = 0; j < 2; ++j) { ((LAS f32x4*)lds)[tid + 512 * j] = gs[tid + 512 * j]; ((LAS f32x4*)(lds + DM * 4))[tid + 512 * j] = bs[tid + 512 * j]; }
    __syncthreads();
}
__device__ __forceinline__ void unpack8(const v4u a, f32x4& lo, f32x4& hi) { lo = (f32x4){bflo(a.x), bfhi(a.x), bflo(a.y), bfhi(a.y)}; hi = (f32x4){bflo(a.z), bfhi(a.z), bflo(a.w), bfhi(a.w)}; }
template <bool HBF>
__device__ __forceinline__ void ln_row(const LAS unsigned char* lds, const void* hin, const bf16* add, float* of, bf16* ob, bf16* op4, bf16* op16, int lane) {
    const GAS v4u* ar = (const GAS v4u*)add + lane;
    f32x4 v[16]; float s = 0.f;
    if constexpr (HBF) { const GAS v4u* hr = (const GAS v4u*)hin + lane;
        v4u ha[8], aa[8];
#pragma unroll
        for (int j = 0; j < 8; ++j) { ha[j] = __builtin_nontemporal_load(hr + 64 * j); aa[j] = __builtin_nontemporal_load(ar + 64 * j); }
#pragma unroll
        for (int j = 0; j < 8; ++j) { f32x4 h0, h1, a0, a1; unpack8(ha[j], h0, h1); unpack8(aa[j], a0, a1); v[2 * j] = h0 * ALPHA + a0; v[2 * j + 1] = h1 * ALPHA + a1; }
    } else { const GAS f32x4* hr = (const GAS f32x4*)hin + 2 * lane;
        v4u aa[8];
#pragma unroll
        for (int j = 0; j < 8; ++j) { v[2 * j] = __builtin_nontemporal_load(hr + 128 * j); v[2 * j + 1] = __builtin_nontemporal_load(hr + 128 * j + 1); aa[j] = __builtin_nontemporal_load(ar + 64 * j); }
#pragma unroll
        for (int j = 0; j < 8; ++j) { f32x4 a0, a1; unpack8(aa[j], a0, a1); v[2 * j] = v[2 * j] * ALPHA + a0; v[2 * j + 1] = v[2 * j + 1] * ALPHA + a1; }
    }
#pragma unroll
    for (int j = 0; j < 16; ++j) s += (v[j].x + v[j].y) + (v[j].z + v[j].w);
    const float mean = wave_sum(s, lane) * (1.f / DM); float s2 = 0.f;
#pragma unroll
    for (int j = 0; j < 16; ++j) { v[j] = v[j] - mean; s2 += (v[j].x * v[j].x + v[j].y * v[j].y) + (v[j].z * v[j].z + v[j].w * v[j].w); }
    const float rstd = 1.f / sqrtf(wave_sum(s2, lane) * (1.f / DM) + EPS);
    const LAS f32x4* gr = (const LAS f32x4*)lds + 2 * lane; const LAS f32x4* br = (const LAS f32x4*)(lds + DM * 4) + 2 * lane;
#pragma unroll
    for (int j = 0; j < 8; ++j) { const f32x4 o0 = v[2 * j] * rstd * gr[128 * j] + br[128 * j], o1 = v[2 * j + 1] * rstd * gr[128 * j + 1] + br[128 * j + 1];
        if (of) { ((GAS f32x4*)of + 2 * lane)[128 * j] = o0; ((GAS f32x4*)of + 2 * lane)[128 * j + 1] = o1; }
        v4u w; w.x = pk2(o0.x, o0.y); w.y = pk2(o0.z, o0.w); w.z = pk2(o1.x, o1.y); w.w = pk2(o1.z, o1.w);
        if (ob) ((GAS v4u*)ob + lane)[64 * j] = w;
        if (op4) { ((GAS v4u*)op4 + lane)[64 * j] = w; ((GAS v4u*)op16 + lane)[64 * j] = w; }
        if (j & 1) __builtin_amdgcn_sched_barrier(0); }
}

constexpr int WPRIV = 17920;
static_assert(WPRIV >= DL_WAVE && WPRIV >= HP_WAVE && WPRIV >= RU_WAVE && 8 * WPRIV <= LDSCTL_OFF, "wave-private LDS stride");
__global__ void __launch_bounds__(NWAVES * 64, 2) mk_fwd(Args args) {
    extern __shared__ __attribute__((aligned(16))) unsigned char lds[];
    Frame F;
    F.lds = (LAS unsigned char*)lds;
    volatile LAS unsigned* MISC = (volatile LAS unsigned*)(F.lds + MISC_OFF);
    F.tid = threadIdx.x; F.lane = F.tid & 63; F.wave = __builtin_amdgcn_readfirstlane(F.tid >> 6);
    F.G = gridDim.x; { const int bx = blockIdx.x; F.vcu = (F.G % 8 == 0) ? (bx % 8) * (F.G / 8) + bx / 8 : bx; }
    F.ws = args.ws; F.ctl = (gu32*)(args.ws + WS_CTL);
    unsigned char* ws = args.ws;
    for (int u = F.tid; u < (LDS_BYTES - LDSCTL_OFF) / 4; u += NWAVES * 64) ((LAS unsigned*)(F.lds + LDSCTL_OFF))[u] = 0u;
    __syncthreads();
#if MK_PER_PHASE
    XcdBarrier bar; bar.bar = nullptr; bar.x = 0; bar.st = nullptr;
#define GRID_BAR() do { } while (0)
#else
    XcdBarrier bar = xcd_barrier_post((unsigned*)(F.ctl + CW_BAR), MISC + 8);
#define GRID_BAR() do { xcd_barrier(bar); if (DUP_BAR) xcd_barrier(bar); } while (0)
#endif
    const int lo = args.ph_lo, hi = args.ph_hi;
#define IN(k) (lo <= (k) && (k) < hi)
#define SEAM(k) do { if (IN(k) && IN((k) + 1)) GRID_BAR(); } while (0)
    const int NGW = F.G * NWAVES;
#define PHASE_IDS() int tid = threadIdx.x; asm volatile("" : "+v"(tid)); const int lane = tid & 63; const int gw = F.vcu * NWAVES + __builtin_amdgcn_readfirstlane(tid >> 6); (void)lane; (void)gw

#define AB   ((bf16*)(ws + WS_AB))
#define XP4  ((bf16*)(ws + WS_XP4))
#define XP16 ((bf16*)(ws + WS_XP16))
#define NAT  ((bf16*)(ws + WS_NAT))
#define VT   ((bf16*)(ws + WS_VT))
#define HQT  ((bf16*)(ws + WS_HQT))
#define HKT  ((bf16*)(ws + WS_HKT))
#define HQC  ((bf16*)(ws + WS_HQC))
#define HKH  ((bf16*)(ws + WS_HKH))
#define DEC  ((float*)(ws + WS_DEC))
#define UR   ((float*)(ws + WS_UR))
#define UH   ((float*)(ws + WS_UH))
#define SR   ((bf16*)(ws + WS_SR))
#define SH   ((bf16*)(ws + WS_SH))
#define YB   ((bf16*)(ws + WS_Y))
#define MRG  ((bf16*)(ws + WS_MRG))
#define MRGB ((bf16*)(ws + WS_MRGB))
#define H1   ((float*)(ws + WS_H1))
#define H2   ((float*)(ws + WS_H2))
#define EDG  ((float*)(ws + WS_UUP))
#define ACT  ((bf16*)(ws + WS_ACT))

    if (PHEN(0) && IN(0)) { for (int rep = 0; rep < NREP(0); ++rep) {
        if (F.G == 256) p0_convert<0>(F, F.vcu * NWAVES + F.wave, F.G * NWAVES);
        else { p0_convert<0>(F, F.vcu * NWAVES + F.wave, F.G * NWAVES); p0_convert<1>(F, F.vcu * NWAVES + F.wave, F.G * NWAVES); }
        if (rep + 1 < NREP(0)) GRID_BAR(); } }
    SEAM(0);
    if (PHEN(0) && IN(1) && F.G == 256 && (int)blockIdx.x >= F.G - NCONV) { p0_convert<1>(F, ((int)blockIdx.x - (F.G - NCONV)) * NWAVES + F.wave, NCONV * NWAVES); __syncthreads(); }

    for (int l = 0; l < DEPTH; ++l) {
        const int pb = 1 + 12 * l;


        if (PHEN(1) && IN(pb + 0)) for (int rep = 0; rep < NREP(1); ++rep) { PHASE_IDS(); if (rep) GRID_BAR();
            EpiInProj E{NAT, VT, (bf16*)(ws + WS_DAK), (bf16*)(ws + WS_DLK)};
            const bool split = (l == 0) && (F.G == 256);
            { InProjSched<0> S{F.G, (int)blockIdx.x, AB, (const bf16*)(ws + WS_WIN + l * WIN_L), split ? CONV_S1 : 0}; pg8::gemm_phase<EpiInProj, InProjSched<0>, true, true, 1>(F.lds, DM, S, E, tid); }
            { InProjSched<1> S{F.G, (int)blockIdx.x, AB, (const bf16*)(ws + WS_WIN + l * WIN_L), 0}; pg8::gemm_phase<EpiInProj, InProjSched<1>, true, true, 4>(F.lds, DM, S, E, tid); }
            { InProjSched<2> S{F.G, (int)blockIdx.x, AB, (const bf16*)(ws + WS_WIN + l * WIN_L), 0}; pg8::gemm_phase<EpiInProj, InProjSched<2>, true, true, 16>(F.lds, DM, S, E, tid); }
        }
        SEAM(pb + 0);

        if (PHEN(2) && IN(pb + 1)) for (int rep = 0; rep < NREP(2); ++rep) { PHASE_IDS(); if (rep) GRID_BAR();
            for (int it = gw; it < 16 * 128; it += NGW) hgpu_unit(F.lds + (tid >> 6) * WPRIV, NAT, VT, INP(4), l, HQT, HKT, HQC, DEC, UH, it >> 7, it & 127, lane);
            if ((gw & 7) < 4)
                for (int it = (gw >> 3) * 4 + (gw & 7); it < 16 * 64; it += (NGW >> 1)) retu_unit(F.lds + (tid >> 6) * WPRIV, NAT, VT, UR, it >> 6, it & 63, lane);
            {
                float mq = 0.f, mk = 0.f;
                for (int m0 = gw; m0 < M; m0 += 4 * NGW) {
                    v4u a0[4], a1[4], b0[4], b1[4];
#pragma unroll
                    for (int i = 0; i < 4; ++i) { const int m = (m0 + i * NGW) < M ? m0 + i * NGW : m0;
                        const bf16* qr = NAT + (size_t)m * NIN + C_DAQ + 16 * lane;
                        const bf16* kr = (const bf16*)(ws + WS_DAK) + ((size_t)((m / SEQ) * 8 + (lane >> 3)) * SEQ + (m % SEQ)) * 128 + 16 * (lane & 7);
                        a0[i] = *(const v4u*)qr; a1[i] = *(const v4u*)(qr + 8); b0[i] = *(const v4u*)kr; b1[i] = *(const v4u*)(kr + 8); }
#pragma unroll
                    for (int i = 0; i < 4; ++i) { float sq = 0.f, sk = 0.f;
#pragma unroll
                        for (int e = 0; e < 4; ++e) { sq += bflo(a0[i][e]) * bflo(a0[i][e]) + bfhi(a0[i][e]) * bfhi(a0[i][e]) + bflo(a1[i][e]) * bflo(a1[i][e]) + bfhi(a1[i][e]) * bfhi(a1[i][e]);
                                                      sk += bflo(b0[i][e]) * bflo(b0[i][e]) + bfhi(b0[i][e]) * bfhi(b0[i][e]) + bflo(b1[i][e]) * bflo(b1[i][e]) + bfhi(b1[i][e]) * bfhi(b1[i][e]); }
                        sq += lane_xor(sq, 1, lane); sq += lane_xor(sq, 2, lane); sk += lane_xor(sk, 1, lane); sk += lane_xor(sk, 2, lane);
                        mq = fmaxf(mq, sq); mk = fmaxf(mk, sk); }
                }
                if ((lane & 3) == 0) { gu32* nb = F.ctl + CW_NRM + 64 * l + (lane >> 3) * 4 + ((lane >> 2) & 1);
                    __hip_atomic_fetch_max(nb, __float_as_uint(mq), RLX_AGENT); __hip_atomic_fetch_max(nb + 2, __float_as_uint(mk), RLX_AGENT); }
            }
        }
        SEAM(pb + 1);

        if ((PHEN(3) || PHEN(4)) && IN(pb + 2)) for (int rep = 0; rep < NREP(3); ++rep) { PHASE_IDS(); if (rep) GRID_BAR();
            for (int e = F.vcu * 512 + tid; e < 16 * 8192; e += F.G * 512) {
                const int bh = e >> 13, h = bh & 7; const float cd = __builtin_amdgcn_exp2f(128.f * ret_log2g(h));
                const float* up = UR + (size_t)bh * 64 * 8192 + (e & 8191); bf16* sp = SR + (size_t)bh * 64 * 8192 + (e & 8191);
                float s = 0.f;
                for (int n0 = 0; n0 < 64; n0 += 32) { float uv[32];
#pragma unroll
                    for (int k = 0; k < 32; ++k) uv[k] = __builtin_nontemporal_load(up + (size_t)(n0 + k) * 8192);
#pragma unroll
                    for (int k = 0; k < 32; ++k) { sp[(size_t)(n0 + k) * 8192] = (bf16)f2bf(s); s = cd * s + uv[k]; } }
            }
            {
                const int stride = F.G * 512;
                for (int e = F.vcu * 512 + tid; e < 16 * 16384; e += 2 * stride) {
                    const bool two = (e + stride) < 16 * 16384; const int e1 = two ? e + stride : e;
                    const int bh0 = e >> 14, bh1 = e1 >> 14;
                    const float* up0 = UH + (size_t)bh0 * 128 * 16384 + (e & 16383); bf16* sp0 = SH + (size_t)bh0 * 128 * 16384 + (e & 16383);
                    const float* up1 = UH + (size_t)bh1 * 128 * 16384 + (e1 & 16383); bf16* sp1 = SH + (size_t)bh1 * 128 * 16384 + (e1 & 16383);
                    const float* dp0 = DEC + (size_t)(bh0 >> 3) * 128 * 1024 + (bh0 & 7) * 128 + (e & 127);
                    const float* dp1 = DEC + (size_t)(bh1 >> 3) * 128 * 1024 + (bh1 & 7) * 128 + (e1 & 127);
                    float s0 = 0.f, s1 = 0.f;
                    for (int n0 = 0; n0 < 128; n0 += 32) { float u0[32], d0[32], u1[32], d1[32];
#pragma unroll
                        for (int k = 0; k < 32; ++k) { u0[k] = __builtin_nontemporal_load(up0 + (size_t)(n0 + k) * 16384); d0[k] = dp0[(size_t)(n0 + k) * 1024]; u1[k] = __builtin_nontemporal_load(up1 + (size_t)(n0 + k) * 16384); d1[k] = dp1[(size_t)(n0 + k) * 1024]; }
#pragma unroll
                        for (int k = 0; k < 32; ++k) { sp0[(size_t)(n0 + k) * 16384] = (bf16)f2bf(s0); s0 = d0[k] * s0 + u0[k];
                            if (two) sp1[(size_t)(n0 + k) * 16384] = (bf16)f2bf(s1); s1 = d1[k] * s1 + u1[k]; } }
                }
            }
        }
        SEAM(pb + 2); if (IN(pb + 2) && !IN(pb + 3) && IN(pb + 4)) GRID_BAR();

        if (PHEN(5) && IN(pb + 4)) for (int rep = 0; rep < NREP(5); ++rep) { PHASE_IDS(); if (rep) GRID_BAR();
            gu32* wq = F.ctl + CW_WQ + 64 * 4 * (l + 2 * rep);
            {
                const float* lv = INP(2) + l * 256;
                const float p01 = wave_sum(lv[lane] * lv[64 + lane], lane), p23 = wave_sum(lv[128 + lane] * lv[192 + lane], lane);
                const float lam_init = 0.8f - 0.6f * __expf(-0.3f * (float)l);
                const float lam = __expf(p01) - __expf(p23) + lam_init;
                const float* ng = INP(3) + l * 128;
                volatile LAS unsigned* wqw = (volatile LAS unsigned*)(F.lds + MISC_OFF);
                for (int rp = 0; rp < NMIX(0); ++rp)
                for (;;) {
                    if (tid == 0) wqw[0] = __hip_atomic_fetch_add(wq + 2048 * rp, 1u, RLX_AGENT);
                    __syncthreads();
                    const int it = (int)wqw[0];
                    if (it >= 16 * 32) break;
                    diff_block(F.lds, (volatile LAS unsigned*)(F.lds + MISC_OFF + 64), (const unsigned*)(F.ctl + CW_NRM + 64 * l), NAT, (const bf16*)(ws + WS_DAK), VT, YB, ng, lam, 1.f - lam_init, (it & 15) >> 3, it & 7, 31 - (it >> 4), tid);
                }
            }
            __syncthreads();
            for (int rp = 0; rp < NMIX(1); ++rp)
            for (;;) { const int it = wq_pull(wq + 64 + 2048 * rp, lane); if (it >= 16 * 256) break;
                dil_unit(F.lds + (tid >> 6) * WPRIV, NAT, (const bf16*)(ws + WS_DLK), VT, YB + (size_t)3 * M * 1024, it >> 11, (it >> 8) & 7, (it >> 4) & 15, it & 15, lane); }
            for (int rp = 0; rp < NMIX(2); ++rp)
            for (;;) { const int it = wq_pull(wq + 128 + 2048 * rp, lane); if (it >= 16 * 64 * 4) break;
                ret_out_unit(F.lds + (tid >> 6) * WPRIV, NAT, VT, SR, YB + (size_t)1 * M * 1024, it >> 8, (it >> 2) & 63, it & 3, lane); }
            {   const float* ng = INP(5) + l * 128;
                for (int rp = 0; rp < NMIX(3); ++rp)
                for (;;) { const int it = wq_pull(wq + 192 + 2048 * rp, lane); if (it >= 16 * 128 * 2) break;
                    hg_out_unit(F.lds + (tid >> 6) * WPRIV, NAT, VT, HQT, HKT, HQC, SH, ng, YB + (size_t)2 * M * 1024, it >> 8, (it >> 1) & 127, it & 1, lane); } }
        }
        SEAM(pb + 4);

        if (PHEN(6) && IN(pb + 5)) for (int rep = 0; rep < NREP(6); ++rep) { PHASE_IDS(); if (rep) GRID_BAR();
            MergeSched S{F.G, (int)blockIdx.x, YB, (const bf16*)(ws + WS_WBR + l * WBR_L)};
            EpiMerge E{NAT, MRGB};
            pg8::gemm_phase<EpiMerge, MergeSched, true, true>(F.lds, 1024, S, E, tid);
        }
        SEAM(pb + 5);

        if (PHEN(7) && IN(pb + 6)) for (int rep = 0; rep < NREP(7); ++rep) { PHASE_IDS(); if (rep) GRID_BAR();
            PlainSched S{F.G, (int)blockIdx.x, 16, DM, MRGB, (const bf16*)(ws + WS_WO + l * WO_L)};
            EpiBf16 E{MRG, DM};
            pg8::gemm_phase<EpiBf16, PlainSched, true, true>(F.lds, DM, S, E, tid);
        }
        SEAM(pb + 6);

        if (PHEN(8) && IN(pb + 7)) for (int rep = 0; rep < NREP(8); ++rep) { PHASE_IDS(); if (rep) GRID_BAR();
            const float* g = INP(8) + l * DM; const float* bb = INP(9) + l * DM;
            ln_stage_gb(F.lds, g, bb, tid);
            if (l == 0) { const float* hin = INP(0);
                for (int m = gw; m < M; m += NGW) ln_row<false>(F.lds, hin + (size_t)m * DM, MRG + (size_t)m * DM, nullptr, AB + (size_t)m * DM, nullptr, nullptr, lane);
            } else {
                for (int m = gw; m < M; m += NGW) ln_row<true>(F.lds, AB + (size_t)m * DM, MRG + (size_t)m * DM, nullptr, AB + (size_t)m * DM, nullptr, nullptr, lane); }
        }
        SEAM(pb + 7);

        if (PHEN(9) && IN(pb + 8)) for (int rep = 0; rep < NREP(9); ++rep) { PHASE_IDS(); if (rep) GRID_BAR();
            PlainSched S{F.G, (int)blockIdx.x, NUP / 256, DM, AB, (const bf16*)(ws + WS_WUP + l * WUP_L)};
            EpiAct E{ACT, INP(11) + (size_t)l * 3 * DFF, INP(12) + (size_t)l * DFF, EDG, EDG + (size_t)256 * DFF, EDG + (size_t)512 * DFF};
            pg8::gemm_phase<EpiAct, PlainSched, true, true>(F.lds, DM, S, E, tid);
        }
        SEAM(pb + 8);

        if (PHEN(10) && IN(pb + 9)) for (int rep = 0; rep < NREP(10); ++rep) { PHASE_IDS(); if (rep) GRID_BAR();
            const float* cw = INP(11) + (size_t)l * 3 * DFF; const float* cb = INP(12) + (size_t)l * DFF;
            const float* EA = EDG; const float* EG = EDG + (size_t)256 * DFF; const float* EL = EDG + (size_t)512 * DFF;
            constexpr int NC4 = DFF / 4;
            for (int it = F.vcu * 512 + tid; it < 128 * NC4; it += F.G * 512) {
                const int seg = it / NC4, c = 4 * (it % NC4); const bool first = (seg % (SEQ / 128)) == 0;
                const f32x4 z = (f32x4){0.f, 0.f, 0.f, 0.f};
                const f32x4 am2 = first ? z : *(const f32x4*)(EL + (size_t)(seg * 2 - 2) * DFF + c), am1 = first ? z : *(const f32x4*)(EL + (size_t)(seg * 2 - 1) * DFF + c);
                const f32x4 a0 = *(const f32x4*)(EA + (size_t)(seg * 2) * DFF + c), a1 = *(const f32x4*)(EA + (size_t)(seg * 2 + 1) * DFF + c);
                const f32x4 g0 = *(const f32x4*)(EG + (size_t)(seg * 2) * DFF + c), g1 = *(const f32x4*)(EG + (size_t)(seg * 2 + 1) * DFF + c);
                const f32x4 w0 = *(const f32x4*)(cw + c), w1 = *(const f32x4*)(cw + DFF + c), w2 = *(const f32x4*)(cw + 2 * DFF + c), bc = *(const f32x4*)(cb + c);
                const f32x4 c0v = bc + w0 * am2 + w1 * am1 + w2 * a0, c1v = bc + w0 * am1 + w1 * a0 + w2 * a1;
                v2u o0, o1;
                o0.x = pk2(gelu1(c0v.x) * g0.x, gelu1(c0v.y) * g0.y); o0.y = pk2(gelu1(c0v.z) * g0.z, gelu1(c0v.w) * g0.w);
                o1.x = pk2(gelu1(c1v.x) * g1.x, gelu1(c1v.y) * g1.y); o1.y = pk2(gelu1(c1v.z) * g1.z, gelu1(c1v.w) * g1.w);
                *(v2u*)(ACT + (size_t)(seg * 128) * DFF + c) = o0; *(v2u*)(ACT + (size_t)(seg * 128 + 1) * DFF + c) = o1;
            }
        }
        SEAM(pb + 9);

        if (PHEN(11) && IN(pb + 10)) for (int rep = 0; rep < NREP(11); ++rep) { PHASE_IDS(); if (rep) GRID_BAR();
            PlainSched S{F.G, (int)blockIdx.x, 16, DFF, ACT, (const bf16*)(ws + WS_WDN + l * WDN_L)};
            EpiBf16 E{MRG, DM};
            pg8::gemm_phase<EpiBf16, PlainSched, true, true>(F.lds, DFF, S, E, tid);
        }
        SEAM(pb + 10);

        if (PHEN(12) && IN(pb + 11)) for (int rep = 0; rep < NREP(12); ++rep) { PHASE_IDS(); if (rep) GRID_BAR();
            const float* g = INP(14) + l * DM; const float* bb = INP(15) + l * DM;
            const bool lastl = (l == DEPTH - 1); float* hout = (float*)INP(16);
            ln_stage_gb(F.lds, g, bb, tid);
            for (int m = gw; m < M; m += NGW)
                ln_row<true>(F.lds, AB + (size_t)m * DM, MRG + (size_t)m * DM, lastl ? hout + (size_t)m * DM : nullptr, lastl ? nullptr : AB + (size_t)m * DM, nullptr, nullptr, lane);
        }
        if (l + 1 < DEPTH) SEAM(pb + 11);
    }
#undef IN
#undef SEAM
}

constexpr int N_PHASES = 1 + 12 * DEPTH;
extern "C" void kernel_launch(void* const* d_in, const int* in_sizes, int n_in, void* d_out, int out_size, void* d_ws, size_t ws_size, hipStream_t stream) {
    static int grid = 0;
    if (grid == 0) {
        if (n_in != 16 || in_sizes[0] != M * DM || out_size != M * DM || ws_size < WS_END) { fprintf(stderr, "kernel_launch: unexpected shapes / workspace (n_in %d, ws %zu < %zu)\n", n_in, ws_size, (size_t)WS_END); grid = -1; return; }
        int dev = 0, cus = 0, per_cu = 0;
        if (hipGetDevice(&dev) != hipSuccess || hipDeviceGetAttribute(&cus, hipDeviceAttributeMultiprocessorCount, dev) != hipSuccess) { grid = -1; return; }
        if (hipFuncSetAttribute((const void*)mk_fwd, hipFuncAttributeMaxDynamicSharedMemorySize, LDS_BYTES) != hipSuccess) { fprintf(stderr, "kernel_launch: hipFuncSetAttribute failed\n"); grid = -1; return; }
        if (hipOccupancyMaxActiveBlocksPerMultiprocessor(&per_cu, (const void*)mk_fwd, NWAVES * 64, LDS_BYTES) != hipSuccess || per_cu < 1)
            fprintf(stderr, "kernel_launch: note: occupancy query reports %d workgroups per CU\n", per_cu);
        (void)hipGetLastError();
        grid = cus;
    }
    if (grid < 0) return;
    if (hipMemsetAsync((char*)d_ws + WS_CTL, 0, CTL_ZERO_BYTES, stream) != hipSuccess) { fprintf(stderr, "kernel_launch: memset failed\n"); return; }
    Args a{};
    for (int i = 0; i < 16; ++i) a.in[i] = (const float*)d_in[i];
    a.out = (float*)d_out; a.ws = (unsigned char*)d_ws;
#if MK_PER_PHASE
    for (int p = 0; p < N_PHASES; ++p) { a.ph_lo = p; a.ph_hi = p + 1; hipLaunchKernelGGL(mk_fwd, dim3(grid), dim3(NWAVES * 64), LDS_BYTES, stream, a); }
#else
    a.ph_lo = 0; a.ph_hi = N_PHASES;
    hipLaunchKernelGGL(mk_fwd, dim3(grid), dim3(NWAVES * 64), LDS_BYTES, stream, a);
#endif
    const hipError_t le = hipPeekAtLastError();
    if (le != hipSuccess) fprintf(stderr, "kernel_launch: launch failed: %s\n", hipGetErrorName(le));
}
```
